# Optimizing an MI355X kernel written in HIP

```python
import math
import jax, jax.numpy as jnp
from jax import lax
import numpy as np

D_MODEL = 1024
BATCH = 4
SEQ = 8192
DEPTH = 1

EXPAND = 2
D_MIX = EXPAND * D_MODEL
RET_WIDTH = D_MIX // 2
MLA_WIDTH = D_MIX - RET_WIDTH
RET_V_DIM = 128
RET_QK_DIM = 64
RET_HEADS = RET_WIDTH // RET_V_DIM
MLA_V = 128
MLA_NOPE = 64
MLA_ROPE = 32
MLA_HEADS = MLA_WIDTH // MLA_V
Q_LORA = 384
KV_LORA = 256
CHUNK = 128
Q_BLOCK = 128
ROPE_BASE = 10000.0
EPS = 1e-6

SPLIT_SIZES = (
    RET_HEADS * RET_QK_DIM,
    RET_HEADS * RET_QK_DIM,
    RET_WIDTH,
    RET_WIDTH,
    Q_LORA,
    KV_LORA,
    MLA_ROPE,
    MLA_WIDTH,
)
D_IN = sum(SPLIT_SIZES)

kernel_name = "hybrid_retention_mla_block"


def rms_norm(x, w):
    xf = x.astype(jnp.float32)
    y = xf * lax.rsqrt(jnp.mean(xf * xf, axis=-1, keepdims=True) + EPS)
    return (y * w.astype(jnp.float32)).astype(x.dtype)


def rope(x, positions):
    d = x.shape[-1]
    inv_freq = ROPE_BASE ** (-jnp.arange(0, d, 2, dtype=jnp.float32) / d)
    ang = positions.astype(jnp.float32)[:, :, None] * inv_freq
    if x.ndim == 4:
        ang = ang[:, :, None, :]
    cos, sin = jnp.cos(ang), jnp.sin(ang)
    xf = x.astype(jnp.float32)
    x1, x2 = xf[..., : d // 2], xf[..., d // 2:]
    return jnp.concatenate([x1 * cos - x2 * sin, x2 * cos + x1 * sin], axis=-1).astype(x.dtype)


def split_cols(t, sizes):
    out, off = [], 0
    for s in sizes:
        out.append(t[..., off:off + s])
        off += s
    return out


def retention_dir(q, k, v, log_gamma, include_diag):
    B, H, S, dk = q.shape
    dv = v.shape[-1]
    n = S // CHUNK
    qc = q.reshape(B, H, n, CHUNK, dk)
    kc = k.reshape(B, H, n, CHUNK, dk)
    vc = v.reshape(B, H, n, CHUNK, dv)
    idx = jnp.arange(CHUNK, dtype=jnp.float32)
    diff = idx[:, None] - idx[None, :]
    mask = diff >= 0 if include_diag else diff > 0
    lg = log_gamma[:, None, None]
    decay_intra = jnp.where(mask[None], jnp.exp(lg * jnp.maximum(diff, 0.0)[None]), 0.0)
    scores = jnp.einsum('bhnik,bhnjk->bhnij', qc, kc) * decay_intra[None, :, None]
    intra = jnp.einsum('bhnij,bhnjv->bhniv', scores, vc)
    k_decay = jnp.exp(log_gamma[:, None] * (CHUNK - 1 - idx)[None])
    kv_chunk = jnp.einsum('bhnjk,bhnjv->bhnkv', kc * k_decay[None, :, None, :, None], vc)
    chunk_decay = jnp.exp(log_gamma * CHUNK)[None, :, None, None]

    def step(state, kv):
        return state * chunk_decay + kv, state

    init = jnp.zeros((B, H, dk, dv), jnp.float32)
    _, states = lax.scan(step, init, jnp.moveaxis(kv_chunk, 2, 0))
    states = jnp.moveaxis(states, 0, 2)
    q_decay = jnp.exp(log_gamma[:, None] * (idx + 1.0)[None])
    cross = jnp.einsum('bhnik,bhnkv->bhniv', qc * q_decay[None, :, None, :, None], states)
    return (intra + cross).reshape(B, H, S, dv)


def setup_inputs(seed: int = 0) -> dict:
    key = jax.random.key(seed)
    ks = jax.random.split(key, 24)
    f32 = jnp.float32

    def nrm(k, shape, scale):
        return jax.random.normal(k, shape, f32) * scale

    def gain(k, shape):
        return 1.0 + 0.02 * jax.random.normal(k, shape, f32)

    x = jax.random.normal(ks[0], (BATCH, SEQ, D_MODEL), f32)
    c = jax.random.normal(ks[1], (BATCH, D_MODEL), f32)
    offsets = jax.random.randint(ks[2], (BATCH, 1), 0, 4096, dtype=jnp.int32)
    positions = jnp.arange(SEQ, dtype=jnp.int32)[None, :] + offsets
    heads = np.arange(RET_HEADS, dtype=np.float32)
    base_logit = jnp.asarray(np.log(2.0 ** (5.0 + heads) - 1.0), f32)
    return {
        "x": x,
        "c": c,
        "positions": positions,
        "norm_w": gain(ks[3], (D_MODEL,)),
        "w_ada": nrm(ks[4], (D_MODEL, 3 * D_MODEL), 0.2 * D_MODEL ** -0.5),
        "b_ada": nrm(ks[5], (3 * D_MODEL,), 0.02),
        "w_in": nrm(ks[6], (D_MODEL, D_IN), D_MODEL ** -0.5),
        "ret_decay_logit_fwd": base_logit + 0.1 * jax.random.normal(ks[7], (RET_HEADS,), f32),
        "ret_decay_logit_bwd": base_logit + 0.1 * jax.random.normal(ks[8], (RET_HEADS,), f32),
        "ret_gn_w": gain(ks[9], (RET_HEADS, RET_V_DIM)),
        "q_norm_w": gain(ks[10], (Q_LORA,)),
        "w_uq": nrm(ks[11], (Q_LORA, MLA_HEADS * (MLA_NOPE + MLA_ROPE)), Q_LORA ** -0.5),
        "kv_norm_w": gain(ks[12], (KV_LORA,)),
        "w_ukv": nrm(ks[13], (KV_LORA, MLA_HEADS * (MLA_NOPE + MLA_V)), KV_LORA ** -0.5),
        "qn_nope_w": gain(ks[14], (MLA_NOPE,)),
        "qn_rope_w": gain(ks[15], (MLA_ROPE,)),
        "kn_nope_w": gain(ks[16], (MLA_NOPE,)),
        "kn_rope_w": gain(ks[17], (MLA_ROPE,)),
        "mla_out_norm_w": gain(ks[18], (MLA_WIDTH,)),
        "w_out": nrm(ks[19], (D_MIX, D_MODEL), D_MIX ** -0.5),
    }


def reference(x, c, positions, norm_w, w_ada, b_ada, w_in, ret_decay_logit_fwd,
              ret_decay_logit_bwd, ret_gn_w, q_norm_w, w_uq, kv_norm_w, w_ukv,
              qn_nope_w, qn_rope_w, kn_nope_w, kn_rope_w, mla_out_norm_w, w_out):
    f32 = jnp.float32
    B, S, _ = x.shape
    for _layer in range(DEPTH):
        mod = jax.nn.silu(c) @ w_ada + b_ada
        shift, scale, gate = jnp.split(mod, 3, axis=-1)
        h = rms_norm(x, norm_w) * (1.0 + scale[:, None, :]) + shift[:, None, :]

        proj = h @ w_in
        r_q, r_k, r_v, r_g, m_cq, m_ckv, m_kr, m_g = split_cols(proj, SPLIT_SIZES)

        rq = rope(r_q.reshape(B, S, RET_HEADS, RET_QK_DIM), positions)
        rk = rope(r_k.reshape(B, S, RET_HEADS, RET_QK_DIM), positions) * (RET_QK_DIM ** -0.5)
        rv = r_v.reshape(B, S, RET_HEADS, RET_V_DIM)
        rq = rq.transpose(0, 2, 1, 3).astype(f32)
        rk = rk.transpose(0, 2, 1, 3).astype(f32)
        rv = rv.transpose(0, 2, 1, 3).astype(f32)
        lg_f = jax.nn.log_sigmoid(ret_decay_logit_fwd.astype(f32))
        lg_b = jax.nn.log_sigmoid(ret_decay_logit_bwd.astype(f32))
        o_fwd = retention_dir(rq, rk, rv, lg_f, True)
        o_bwd = jnp.flip(retention_dir(jnp.flip(rq, 2), jnp.flip(rk, 2), jnp.flip(rv, 2),
                                       lg_b, False), 2)
        o = o_fwd + o_bwd
        mu = jnp.mean(o, axis=-1, keepdims=True)
        var = jnp.mean(jnp.square(o - mu), axis=-1, keepdims=True)
        o = (o - mu) * lax.rsqrt(var + EPS) * ret_gn_w.astype(f32)[None, :, None, :]
        o = o.transpose(0, 2, 1, 3).reshape(B, S, RET_WIDTH).astype(x.dtype)
        ret_out = o * jax.nn.silu(r_g)

        cq = rms_norm(m_cq, q_norm_w)
        q = (cq @ w_uq).reshape(B, S, MLA_HEADS, MLA_NOPE + MLA_ROPE)
        q_nope, q_rope = q[..., :MLA_NOPE], q[..., MLA_NOPE:]
        ckv = rms_norm(m_ckv, kv_norm_w)
        kv = (ckv @ w_ukv).reshape(B, S, MLA_HEADS, MLA_NOPE + MLA_V)
        k_nope, v = kv[..., :MLA_NOPE], kv[..., MLA_NOPE:]
        q_nope = rms_norm(q_nope, qn_nope_w)
        q_rope = rope(rms_norm(q_rope, qn_rope_w), positions)
        k_nope = rms_norm(k_nope, kn_nope_w)
        k_rope = rope(rms_norm(m_kr, kn_rope_w), positions)
        sm_scale = (MLA_NOPE + MLA_ROPE) ** -0.5
        nb = S // Q_BLOCK
        qn_blk = jnp.moveaxis(q_nope.reshape(B, nb, Q_BLOCK, MLA_HEADS, MLA_NOPE), 1, 0)
        qr_blk = jnp.moveaxis(q_rope.reshape(B, nb, Q_BLOCK, MLA_HEADS, MLA_ROPE), 1, 0)

        def attend(blk):
            qn, qr = blk
            s = (jnp.einsum('bqhd,bkhd->bhqk', qn, k_nope)
                 + jnp.einsum('bqhd,bkd->bhqk', qr, k_rope))
            p = jax.nn.softmax(s.astype(f32) * sm_scale, axis=-1).astype(v.dtype)
            return jnp.einsum('bhqk,bkhd->bqhd', p, v)

        att = lax.map(attend, (qn_blk, qr_blk))
        att = jnp.moveaxis(att, 0, 1).reshape(B, S, MLA_WIDTH)
        mla_out = rms_norm(att, mla_out_norm_w) * jax.nn.silu(m_g)

        y = jnp.concatenate([ret_out, mla_out], axis=-1) @ w_out
        x = x + gate[:, None, :] * y
    return x
```

```cpp
#ifndef PROBE_DUP
#define PROBE_DUP 0
#endif
#include <hip/hip_runtime.h>
#include <hip/hip_cooperative_groups.h>
#include <cstdio>
#include <cstdint>
namespace cg = cooperative_groups;

namespace pg8 {
#define PG8_LAS __attribute__((address_space(3)))
typedef unsigned short bf16_t;
typedef short bf16x8 __attribute__((ext_vector_type(8)));
typedef float f32x4 __attribute__((ext_vector_type(4)));
typedef unsigned u32x4 __attribute__((ext_vector_type(4)));
constexpr int BM = 256, BK = 64, HALF = 128, HTB = HALF * BK * 2, STAGE_BYTES = 8 * HTB, NXCD = 8, WGM = 8;

__host__ __device__ __forceinline__ int lds_byte(int r, int c) { const int st = (r >> 4) * 2 + (c >> 5), rr = r & 15, cc = c & 31, ob = rr * 64 + cc * 2; return st * 1024 + (ob ^ (((ob >> 9) & 1) << 5)); }
__host__ __device__ __forceinline__ void stage_rc(int b, int& R, int& C) { const int st = b / 1024, sb = b % 1024, swz = sb ^ (((sb >> 9) & 1) << 5); R = (st >> 1) * 16 + swz / 64; C = (st & 1) * 32 + (swz % 64) / 2; }
__host__ __device__ __forceinline__ int perm32(int rho) { const int n = rho >> 4, i = rho & 15; return 8 * (i >> 2) + 4 * n + (i & 3); }

struct Unit { int pm, pn; };
struct Gemm { const bf16_t* A; const bf16_t* Bt; int M, N, K, lda; };

struct StaticOrder {
    int nM, nN, nwg, G, c;
    __host__ __device__ void init(int M, int N, int G_, int c_) { nM = M / BM; nN = N / BM; nwg = nM * nN; G = G_; c = c_; }
    __host__ __device__ bool next(int i, Unit& u) const {
        const long L = (long)i * G + c; if (L >= nwg) return false;
        int wgid = (int)L; { const int q = nwg / NXCD, r = nwg % NXCD, xcd = wgid % NXCD, off = wgid / NXCD; wgid = (xcd < r ? xcd * (q + 1) : r * (q + 1) + (xcd - r) * q) + off; }
        const int nig = WGM * nN, gid = wgid / nig, fm = gid * WGM, gsz = (nM - fm) < WGM ? (nM - fm) : WGM;
        u.pm = fm + ((wgid % nig) % gsz); u.pn = (wgid % nig) / gsz; return true;
    }
};

typedef float f32x2_c __attribute__((ext_vector_type(2)));
typedef __bf16 bf16x2_c __attribute__((ext_vector_type(2)));
__device__ __forceinline__ unsigned cvt_pk_bf16(float lo, float hi) { const f32x2_c v = {lo, hi}; return __builtin_bit_cast(unsigned, __builtin_convertvector(v, bf16x2_c)); }

template <class Epi, class Sched>
__device__ __forceinline__ void gemm_phase(PG8_LAS unsigned char* lds, const Gemm g, const Sched& S, const Epi& E) {
    int tid_ = threadIdx.x; asm volatile("" : "+v"(tid_));
    const int tid = tid_, wid = __builtin_amdgcn_readfirstlane(tid >> 6), lane = tid & 63, wr = wid >> 2, wc = wid & 3, fr = lane & 15, fq = lane >> 4;
    const int K = g.K, nt = K / BK, lda = g.lda;
    unsigned voffA[2], voffB[2];
#pragma unroll
    for (int i = 0; i < 2; ++i) { int R, C; stage_rc(tid * 16 + i * 8192, R, C); const int Rb = Epi::PERM ? ((R & ~31) + perm32(R & 31)) : R;
        voffA[i] = (unsigned)(R * lda + C) * 2u; voffB[i] = (unsigned)(Rb * K + C) * 2u; }
    const size_t kstep = (size_t)(BK * 2);
    const size_t hstepA = (size_t)HALF * lda * 2, hstepB = (size_t)HALF * K * 2;
    const size_t tstepA = 2 * hstepA, tstepB = 2 * hstepB;
    const unsigned ldsw = (unsigned)wid * 1024u;
    const int aoff = lds_byte(wr * 64 + fr, fq * 8), boff = lds_byte(wc * 32 + fr, fq * 8);
#define PG8_SA(b, h) (((b) * 2 + (h)) * HTB)
#define PG8_SB(b, h) ((4 + (b) * 2 + (h)) * HTB)
#define PG8_STAGE(bufoff, gbase, voff) do { _Pragma("unroll") for (int _i = 0; _i < 2; ++_i) \
        __builtin_amdgcn_global_load_lds((const unsigned*)((const char*)(gbase) + (voff)[_i]), (PG8_LAS unsigned*)(lds + (bufoff) + ldsw + _i * 8192), 16, 0, 0); } while (0)
#define PG8_LDA(dst, b, h) do { _Pragma("unroll") for (int m = 0; m < 4; ++m) _Pragma("unroll") for (int k = 0; k < 2; ++k) dst[m][k] = *(const PG8_LAS bf16x8*)(lds + PG8_SA(b, h) + aoff + m * 2048 + k * 1024); } while (0)
#define PG8_LDB(dst, b, h) do { _Pragma("unroll") for (int n = 0; n < 2; ++n) _Pragma("unroll") for (int k = 0; k < 2; ++k) dst[n][k] = *(const PG8_LAS bf16x8*)(lds + PG8_SB(b, h) + boff + n * 2048 + k * 1024); } while (0)
#define PG8_MMA(ai, bj, At, Bt) do { __builtin_amdgcn_s_setprio(1); _Pragma("unroll") for (int m = 0; m < 4; ++m) _Pragma("unroll") for (int n = 0; n < 2; ++n) _Pragma("unroll") for (int k = 0; k < 2; ++k) \
        acc[ai][bj][m][n] = __builtin_amdgcn_mfma_f32_16x16x32_bf16(Bt[n][k], At[m][k], acc[ai][bj][m][n], 0, 0, 0); __builtin_amdgcn_s_setprio(0); } while (0)
#define PG8_WAIT_V(n) asm volatile("s_waitcnt vmcnt(" #n ")" ::: "memory")
#define PG8_WAIT_L(n) asm volatile("s_waitcnt lgkmcnt(" #n ")" ::: "memory")
#define PG8_BAR __builtin_amdgcn_s_barrier()
#define PG8_SCHED __builtin_amdgcn_sched_barrier(0)
    Unit cur, nxt; int ui = 0;
    if (!S.next(0, cur)) return;
    f32x4 acc[2][2][4][2];
#pragma unroll
    for (int a = 0; a < 2; ++a)
#pragma unroll
        for (int b = 0; b < 2; ++b)
#pragma unroll
            for (int m = 0; m < 4; ++m)
#pragma unroll
                for (int n = 0; n < 2; ++n) acc[a][b][m][n] = (f32x4){0.f, 0.f, 0.f, 0.f};
    bf16x8 At[4][2], B0[2][2], B1[2][2];
    const char* cA = (const char*)g.A + (size_t)cur.pm * tstepA; const char* cB = (const char*)g.Bt + (size_t)cur.pn * tstepB;
    PG8_STAGE(PG8_SB(0, 0), cB, voffB); PG8_STAGE(PG8_SB(0, 1), cB + hstepB, voffB); PG8_STAGE(PG8_SA(0, 0), cA, voffA); PG8_STAGE(PG8_SA(0, 1), cA + hstepA, voffA);
    if (wr == 1) PG8_BAR;
    PG8_WAIT_V(2); PG8_BAR;
    PG8_STAGE(PG8_SB(1, 0), cB + kstep, voffB); PG8_STAGE(PG8_SA(1, 0), cA + kstep, voffA); PG8_STAGE(PG8_SB(1, 1), cB + hstepB + kstep, voffB);
    PG8_WAIT_V(6); PG8_BAR;
    for (;;) {
        const bool has_next = S.next(ui + 1, nxt);
        const char* nA = has_next ? (const char*)g.A + (size_t)nxt.pm * tstepA : cA; const char* nB = has_next ? (const char*)g.Bt + (size_t)nxt.pn * tstepB : cB;
#pragma unroll 1
        for (int t = 0; t < nt; t += 2) {
            if constexpr (Epi::MIDSCALE) { if (t == nt / 2) E.mid(acc, cur); }
            const bool last = (t == nt - 2);
            const char* a1 = cA + (size_t)(t + 1) * kstep;
            const char* a2 = last ? nA : cA + (size_t)(t + 2) * kstep; const char* b2 = last ? nB : cB + (size_t)(t + 2) * kstep;
            const char* a3 = a2 + kstep; const char* b3 = b2 + kstep;
            PG8_LDB(B0, 0, 0); PG8_LDB(B1, 0, 1); PG8_SCHED; PG8_LDA(At, 0, 0); PG8_STAGE(PG8_SA(1, 1), a1 + hstepA, voffA);
            PG8_WAIT_V(8); PG8_WAIT_L(0); PG8_BAR; PG8_MMA(0, 0, At, B0); PG8_MMA(0, 1, At, B1); PG8_BAR; PG8_SCHED;
            PG8_LDA(At, 0, 1); PG8_STAGE(PG8_SB(0, 0), b2, voffB); PG8_STAGE(PG8_SB(0, 1), b2 + hstepB, voffB); PG8_STAGE(PG8_SA(0, 0), a2, voffA);
            PG8_WAIT_V(8); PG8_WAIT_L(0); PG8_BAR; PG8_MMA(1, 0, At, B0); PG8_MMA(1, 1, At, B1); PG8_BAR; PG8_SCHED;
            PG8_LDB(B0, 1, 0); PG8_LDB(B1, 1, 1); PG8_SCHED; PG8_LDA(At, 1, 0); PG8_STAGE(PG8_SA(0, 1), a2 + hstepA, voffA);
            PG8_WAIT_V(8); PG8_WAIT_L(0); PG8_BAR; PG8_MMA(0, 0, At, B0); PG8_MMA(0, 1, At, B1); PG8_BAR; PG8_SCHED;
            PG8_LDA(At, 1, 1); PG8_STAGE(PG8_SB(1, 0), b3, voffB); PG8_STAGE(PG8_SB(1, 1), b3 + hstepB, voffB); PG8_STAGE(PG8_SA(1, 0), a3, voffA);
            PG8_WAIT_V(8); PG8_WAIT_L(0); PG8_BAR; PG8_MMA(1, 0, At, B0); PG8_MMA(1, 1, At, B1); PG8_BAR; PG8_SCHED;
        }
        if (wr == 0) PG8_BAR;
        E(acc, cur, wr, wc, fr, fq);
        if (!has_next) break;
#pragma unroll
        for (int a = 0; a < 2; ++a)
#pragma unroll
            for (int b = 0; b < 2; ++b)
#pragma unroll
                for (int m = 0; m < 4; ++m)
#pragma unroll
                    for (int n = 0; n < 2; ++n) acc[a][b][m][n] = (f32x4){0.f, 0.f, 0.f, 0.f};
        cur = nxt; cA = nA; cB = nB; ++ui;
        if (wr == 1) PG8_BAR;
    }
    PG8_WAIT_V(0);
    PG8_BAR;
#undef PG8_SA
#undef PG8_SB
#undef PG8_STAGE
#undef PG8_LDA
#undef PG8_LDB
#undef PG8_MMA
#undef PG8_WAIT_V
#undef PG8_WAIT_L
#undef PG8_BAR
#undef PG8_SCHED
}
}

typedef unsigned short bf16;
typedef short bf16x8 __attribute__((ext_vector_type(8)));
typedef short s16x4 __attribute__((ext_vector_type(4)));
typedef float f32x16 __attribute__((ext_vector_type(16)));
typedef float f32x4 __attribute__((ext_vector_type(4)));
typedef float f32x2 __attribute__((ext_vector_type(2)));
typedef unsigned u32x4 __attribute__((ext_vector_type(4)));
typedef unsigned u32x2 __attribute__((ext_vector_type(2)));
#define LAS __attribute__((address_space(3)))

constexpr int BATCH = 4, SEQ = 8192, DM = 1024, M = BATCH * SEQ, NH = 8;
constexpr int D_IN = 4768, PITCH = 4864;
constexpr int C_RQ = 0, C_RK = 512, C_RV = 1024, C_MG = 2048, C_RG = 3072, C_CQ = 4096, C_CKV = 4480, C_KR = 4736;
constexpr float EPS = 1e-6f;
constexpr float QSC = 0.10206207261596575f * 1.4426950408889634f;
constexpr float LOG2E = 1.4426950408889634f;
constexpr int NTHREADS = 512, NWAVES = 8;

constexpr size_t MiB = 1u << 20;
constexpr size_t WS_PROJ = 0;
constexpr size_t WS_K = 304 * MiB;
constexpr size_t WS_V = 352 * MiB;
constexpr size_t WS_WIN = 416 * MiB;
constexpr size_t WS_WQ = 426 * MiB;
constexpr size_t WS_WKV = 427 * MiB;
constexpr size_t WS_WO = 428 * MiB;
constexpr size_t WS_CS64 = 432 * MiB;
constexpr size_t WS_CS32 = 440 * MiB;
constexpr size_t WS_MOD = 444 * MiB;
constexpr size_t WS_STAT = 445 * MiB;
constexpr size_t WS_SS = 447 * MiB;
constexpr size_t WS_BAR = 446 * MiB;
constexpr size_t WS_END = 448 * MiB;
constexpr size_t OUT_QO = 0, OUT_KVS = 64 * MiB;

constexpr int LDS_BYTES = 135168;
constexpr int LDS_CTL_OFF = 133120;

struct Params { const float* in[20]; float* out; unsigned char* ws; };

__device__ __forceinline__ unsigned cvtpk(float lo, float hi) { return pg8::cvt_pk_bf16(lo, hi); }
__device__ __forceinline__ float bf_lo(unsigned w) { return __uint_as_float(w << 16); }
__device__ __forceinline__ float bf_hi(unsigned w) { return __uint_as_float(w & 0xffff0000u); }
__device__ __forceinline__ float wave_sum(float v) {
#pragma unroll
    for (int o = 1; o < 64; o <<= 1) v += __shfl_xor(v, o);
    return v;
}
__device__ __forceinline__ float silu_f(float v) { return v * __builtin_amdgcn_rcpf(1.f + __builtin_amdgcn_exp2f(-v * LOG2E)); }
__device__ __forceinline__ float sumsq8(u32x4 a) {
    float s = 0.f;
#pragma unroll
    for (int i = 0; i < 4; ++i) { const float x = bf_lo(a[i]), y = bf_hi(a[i]); s += x * x + y * y; }
    return s;
}

__device__ __forceinline__ int fresh_tid() { int t = threadIdx.x; asm volatile("" : "+v"(t)); return t; }
#define EPI_LANES() const int t_ = fresh_tid(), l_ = t_ & 63, wi_ = t_ >> 6, wr = wi_ >> 2, wc = wi_ & 3, fr = l_ & 15, fq = l_ >> 4


#define RLX_AGENT __ATOMIC_RELAXED, __HIP_MEMORY_SCOPE_AGENT
#define XB_TMO      128
#define XB_XCNT(j)  (256  + 64 * (j))
#define XB_XSUB(j)  (1280 + 64 * (j))
#define XB_XGEN(j)  (2304 + 64 * (j))
#define XB_TOP      3328
#define XB_TOPGEN   3392
#define XCD_BAR_WORDS 3456
#define XB_SPIN_CAP (1u << 18)

__device__ __forceinline__ unsigned xb_ld(unsigned* p)              { return __hip_atomic_load(p, __ATOMIC_RELAXED, __HIP_MEMORY_SCOPE_AGENT); }
__device__ __forceinline__ unsigned xb_add(unsigned* p, unsigned v) { return __hip_atomic_fetch_add(p, v, __ATOMIC_RELAXED, __HIP_MEMORY_SCOPE_AGENT); }
__device__ __forceinline__ unsigned xb_xcc_id() { return (unsigned)__builtin_amdgcn_s_getreg((3 << 11) | 20) & 0xFu; }
#define XB_SPIN(cond, bar) do { unsigned _sp = 0; while (cond) { __builtin_amdgcn_s_sleep(1); \
    if ((++_sp & 255u) == 0u) { if (xb_ld(&(bar)[XB_TMO])) break; if (_sp > XB_SPIN_CAP) { atomicAdd(&(bar)[XB_TMO], 1u); break; } } } } while (0)

struct XcdBarrier {
    unsigned* bar; unsigned x;
    volatile LAS unsigned* st;
};

__device__ __forceinline__ XcdBarrier xcd_barrier_post(unsigned* bar, volatile LAS unsigned* st) {
    XcdBarrier b; b.bar = bar; b.x = xb_xcc_id(); b.st = st;
    if (threadIdx.x == 0) (void)xb_add(&bar[XB_XCNT(b.x)], 1u);
    return b;
}
__device__ __forceinline__ void xcd_barrier_complete(unsigned* bar, unsigned x, unsigned& nloc, unsigned& nx) {
    const unsigned G = gridDim.x * gridDim.y * gridDim.z;
    unsigned sum, cnt, mine, sp = 0u;
    for (;;) {
        sum = 0u; cnt = 0u; mine = 0u;
#pragma unroll
        for (unsigned j = 0; j < 16; ++j) { const unsigned c = xb_ld(&bar[XB_XCNT(j)]); sum += c; cnt += (c > 0u) ? 1u : 0u; mine = (j == x) ? c : mine; }
        if (sum == G) break;
        __builtin_amdgcn_s_sleep(1);
        if ((++sp & 255u) == 0u) { if (xb_ld(&bar[XB_TMO])) break; if (sp > XB_SPIN_CAP) { atomicAdd(&bar[XB_TMO], 1u); break; } }
    }
    nloc = mine > 0u ? mine : 1u; nx = cnt > 0u ? cnt : 1u;
}

__device__ __forceinline__ void xcd_barrier(const XcdBarrier& b) {
    asm volatile("s_waitcnt vmcnt(0)" ::: "memory");
    __syncthreads();
    if (threadIdx.x == 0) {
        unsigned* bar = b.bar;
        __builtin_amdgcn_s_waitcnt(0);
        unsigned nloc = b.st[0], nx = b.st[1];
        if (nloc == 0u) { xcd_barrier_complete(bar, b.x, nloc, nx); b.st[0] = nloc; b.st[1] = nx; }
        const unsigned old = xb_add(&bar[XB_XSUB(b.x)], 1u);
        const unsigned gen = old / nloc;
        if (old + 1u == (gen + 1u) * nloc) {
            __builtin_amdgcn_fence(__ATOMIC_RELEASE, "agent");
            asm volatile("s_waitcnt vmcnt(0)" ::: "memory");
            const unsigned og = xb_add(&bar[XB_TOP], 1u);
            const unsigned tg = og / nx;
            if (og + 1u == (tg + 1u) * nx) xb_add(&bar[XB_TOPGEN], 1u);
            else XB_SPIN(xb_ld(&bar[XB_TOPGEN]) == tg, bar);
            __builtin_amdgcn_fence(__ATOMIC_ACQUIRE, "agent");
            xb_add(&bar[XB_XGEN(b.x)], 1u);
            asm volatile("s_waitcnt vmcnt(0)" ::: "memory");
        } else {
            XB_SPIN(xb_ld(&bar[XB_XGEN(b.x)]) == gen, bar);
            __builtin_amdgcn_fence(__ATOMIC_ACQUIRE, "agent");
            asm volatile("s_waitcnt vmcnt(0)" ::: "memory");
        }
    }
    __syncthreads();
}


__device__ __forceinline__ int win_colmap(int n) {
    if (n < 1024) { const int base = n & ~63, j = n & 63; return base + (j >> 1) + 32 * (j & 1); }
    if (n < 2048) return n;
    if (n < 3072) return 3744 + (n - 2048);
    if (n < 4096) return 2048 + (n - 3072);
    if (n < 4480) return 3072 + (n - 4096);
    if (n < 4736) return 3456 + (n - 4480);
    if (n < 4768) return 3712 + (n - 4736);
    return -1;
}
__device__ __forceinline__ int nope_map(int n, int per_head) {
    const int t = n >> 8, c = n & 255, bj = c >> 7, wc = (c >> 5) & 3, j = c & 31;
    return (4 * t + wc) * per_head + 32 * bj + j;
}
__device__ __forceinline__ int wq_colmap(int n) {
    if (n < 512) return nope_map(n, 96);
    const int c = n - 512, head = c >> 5, j = c & 31; return head * 96 + 64 + (j >> 1) + 16 * (j & 1);
}
__device__ __forceinline__ int wkv_colmap(int n) {
    if (n < 512) return nope_map(n, 192);
    const int c = n - 512, head = c >> 7, dim = c & 127; return head * 192 + 64 + dim;
}

struct EpiIn {
    static constexpr bool PERM = true, MIDSCALE = false;
    bf16* P; const float* cs64;
    __device__ __forceinline__ void operator()(const pg8::f32x4 (&acc)[2][2][4][2], const pg8::Unit& u, int, int, int, int) const {
        EPI_LANES();
        const int row0 = u.pm * 256 + wr * 64 + fr, colt = u.pn * 256, cl = wc * 32 + 8 * fq;
        const int mode = u.pn < 4 ? 1 : ((u.pn >= 8 && u.pn < 16) ? 2 : 0);
        const float rs = u.pn < 2 ? 1.f : 0.125f;
        const int p0 = (wc & 1) * 16 + 4 * fq;
        f32x4 n0 = {1.f, 0.f, 1.f, 0.f}, n1 = {1.f, 0.f, 1.f, 0.f};
        if (mode == 1) { const f32x4* t = (const f32x4*)(cs64 + ((size_t)row0 * 32 + p0) * 2); n0 = t[0]; n1 = t[1]; }
#pragma unroll
        for (int ai = 0; ai < 2; ++ai)
#pragma unroll
            for (int m = 0; m < 4; ++m) {
                const int row = row0 + ai * 128 + m * 16;
                bf16* rowp = P + (size_t)row * PITCH + colt + cl;
                const f32x4 c0 = n0, c1 = n1;
                if (mode == 1 && (ai * 4 + m) < 7) { const int rown = row0 + ((ai * 4 + m + 1) >> 2) * 128 + ((ai * 4 + m + 1) & 3) * 16;
                    const f32x4* t = (const f32x4*)(cs64 + ((size_t)rown * 32 + p0) * 2); n0 = t[0]; n1 = t[1]; }
#pragma unroll
                for (int bj = 0; bj < 2; ++bj) {
                    f32x4 v0 = acc[ai][bj][m][0], v1 = acc[ai][bj][m][1];
                    if (mode == 1) {
                        f32x4 o0, o1;
                        o0[0] = (v0[0] * c0[0] - v0[1] * c0[1]) * rs; o0[1] = (v0[1] * c0[0] + v0[0] * c0[1]) * rs;
                        o0[2] = (v0[2] * c0[2] - v0[3] * c0[3]) * rs; o0[3] = (v0[3] * c0[2] + v0[2] * c0[3]) * rs;
                        o1[0] = (v1[0] * c1[0] - v1[1] * c1[1]) * rs; o1[1] = (v1[1] * c1[0] + v1[0] * c1[1]) * rs;
                        o1[2] = (v1[2] * c1[2] - v1[3] * c1[3]) * rs; o1[3] = (v1[3] * c1[2] + v1[2] * c1[3]) * rs;
                        v0 = o0; v1 = o1;
                    } else if (mode == 2) {
#pragma unroll
                        for (int i = 0; i < 4; ++i) { v0[i] = silu_f(v0[i]); v1[i] = silu_f(v1[i]); }
                    }
                    u32x4 w; w.x = cvtpk(v0[0], v0[1]); w.y = cvtpk(v0[2], v0[3]); w.z = cvtpk(v1[0], v1[1]); w.w = cvtpk(v1[2], v1[3]);
                    *(u32x4*)(rowp + bj * 128) = w;
                }
                asm volatile("" ::: "memory");
            }
    }
};

template <int MODE> struct EpiUp {
    static constexpr bool IS_Q = MODE != 2, MIDSCALE = false;
    static constexpr bool PERM = true;
    bf16* O;
    bf16* Vo;
    const f32x2* stat;
    const float* wn;
    const float* wr_;
    const float* cs32;
    __device__ __forceinline__ void operator()(const pg8::f32x4 (&acc)[2][2][4][2], const pg8::Unit& u, int, int, int, int) const {
        EPI_LANES();
        const int row0 = u.pm * 256 + wr * 64 + fr;
        const int b = row0 / SEQ;
        constexpr int OP = IS_Q ? 128 : 96;
        float ms8[8];
#pragma unroll
        for (int i = 0; i < 8; ++i) { const f32x2 st = stat[row0 + (i >> 2) * 128 + (i & 3) * 16]; ms8[i] = IS_Q ? st.x : st.y; }
        if (MODE == 0 || ((MODE == 2 || MODE == 3) && u.pn < 2)) {
            const int head = 4 * u.pn + wc;
            const f32x4 w00 = *(const f32x4*)(wn + 8 * fq), w01 = *(const f32x4*)(wn + 8 * fq + 4), w10 = *(const f32x4*)(wn + 32 + 8 * fq), w11 = *(const f32x4*)(wn + 36 + 8 * fq);
#pragma unroll
            for (int ai = 0; ai < 2; ++ai)
#pragma unroll
                for (int m = 0; m < 4; ++m) {
                    const int row = row0 + ai * 128 + m * 16;
                    const f32x4 a0 = acc[ai][0][m][0], a1 = acc[ai][0][m][1], b0 = acc[ai][1][m][0], b1 = acc[ai][1][m][1];
                    float ss = 0.f;
#pragma unroll
                    for (int i = 0; i < 4; ++i) ss += a0[i] * a0[i] + a1[i] * a1[i] + b0[i] * b0[i] + b1[i] * b1[i];
                    ss += __shfl_xor(ss, 16); ss += __shfl_xor(ss, 32);
                    const float ms = ms8[ai * 4 + m];
                    const float sc = __builtin_amdgcn_rsqf(ss * (1.f / 64.f) + EPS * (ms + EPS)) * (IS_Q ? QSC : 1.f);
                    bf16* op = O + ((size_t)(b * NH + head) * SEQ + (row - b * SEQ)) * OP;
                    const f32x4 x0 = a0 * sc * w00, x1 = a1 * sc * w01, y0 = b0 * sc * w10, y1 = b1 * sc * w11;
                    u32x4 w; w.x = cvtpk(x0[0], x0[1]); w.y = cvtpk(x0[2], x0[3]); w.z = cvtpk(x1[0], x1[1]); w.w = cvtpk(x1[2], x1[3]);
                    *(u32x4*)(op + 8 * fq) = w;
                    w.x = cvtpk(y0[0], y0[1]); w.y = cvtpk(y0[2], y0[3]); w.z = cvtpk(y1[0], y1[1]); w.w = cvtpk(y1[2], y1[3]);
                    *(u32x4*)(op + 32 + 8 * fq) = w;
                }
        } else if (MODE == 1 || MODE == 3) {
            const f32x4 wl = *(const f32x4*)(wr_ + 4 * fq), wh = *(const f32x4*)(wr_ + 16 + 4 * fq);
            f32x4 n0, n1; { const f32x4* t = (const f32x4*)(cs32 + ((size_t)row0 * 16 + 4 * fq) * 2); n0 = t[0]; n1 = t[1]; }
#pragma unroll
            for (int ai = 0; ai < 2; ++ai)
#pragma unroll
                for (int m = 0; m < 4; ++m) {
                    const int row = row0 + ai * 128 + m * 16;
                    const float epsq = EPS * (ms8[ai * 4 + m] + EPS);
                    const f32x4 c0 = n0, c1 = n1;
                    if ((ai * 4 + m) < 7) { const int rown = row0 + ((ai * 4 + m + 1) >> 2) * 128 + ((ai * 4 + m + 1) & 3) * 16;
                        const f32x4* t = (const f32x4*)(cs32 + ((size_t)rown * 16 + 4 * fq) * 2); n0 = t[0]; n1 = t[1]; }
#pragma unroll
                    for (int bj = 0; bj < 2; ++bj) {
                        const f32x4 v0 = acc[ai][bj][m][0], v1 = acc[ai][bj][m][1];
                        float ss = 0.f;
#pragma unroll
                        for (int i = 0; i < 4; ++i) ss += v0[i] * v0[i] + v1[i] * v1[i];
                        ss += __shfl_xor(ss, 16); ss += __shfl_xor(ss, 32);
                        const float sc = __builtin_amdgcn_rsqf(ss * (1.f / 32.f) + epsq) * QSC;
                        const float x1a = v0[0] * sc * wl[0], x2a = v0[1] * sc * wh[0], x1b = v0[2] * sc * wl[1], x2b = v0[3] * sc * wh[1];
                        const float x1c = v1[0] * sc * wl[2], x2c = v1[1] * sc * wh[2], x1d = v1[2] * sc * wl[3], x2d = v1[3] * sc * wh[3];
                        u32x4 w;
                        w.x = cvtpk(x1a * c0[0] - x2a * c0[1], x2a * c0[0] + x1a * c0[1]);
                        w.y = cvtpk(x1b * c0[2] - x2b * c0[3], x2b * c0[2] + x1b * c0[3]);
                        w.z = cvtpk(x1c * c1[0] - x2c * c1[1], x2c * c1[0] + x1c * c1[1]);
                        w.w = cvtpk(x1d * c1[2] - x2d * c1[3], x2d * c1[2] + x1d * c1[3]);
                        const int head = 4 * bj + wc;
                        bf16* op = O + ((size_t)(b * NH + head) * SEQ + (row - b * SEQ)) * OP;
                        *(u32x4*)(op + 64 + 8 * fq) = w;
                    }
                    asm volatile("" ::: "memory");
                }
        } else {
#pragma unroll
            for (int ai = 0; ai < 2; ++ai)
#pragma unroll
                for (int m = 0; m < 4; ++m) {
                    const int row = row0 + ai * 128 + m * 16;
                    const float sc = __builtin_amdgcn_rsqf(ms8[ai * 4 + m] + EPS);
#pragma unroll
                    for (int bj = 0; bj < 2; ++bj) {
                        const f32x4 v0 = acc[ai][bj][m][0] * sc, v1 = acc[ai][bj][m][1] * sc;
                        const int head = 2 * (u.pn - 2) + bj;
                        bf16* op = Vo + ((size_t)(b * NH + head) * SEQ + (row - b * SEQ)) * 128 + 32 * wc + 8 * fq;
                        u32x4 w; w.x = cvtpk(v0[0], v0[1]); w.y = cvtpk(v0[2], v0[3]); w.z = cvtpk(v1[0], v1[1]); w.w = cvtpk(v1[2], v1[3]);
                        *(u32x4*)op = w;
                    }
                }
        }
    }
};

struct EpiOut {
    static constexpr bool PERM = false, MIDSCALE = true;
    const float* x; float* out; const float* mod; const float* ss;
    __device__ __forceinline__ void mid(pg8::f32x4 (&acc)[2][2][4][2], const pg8::Unit& u) const {
        EPI_LANES(); (void)wc; (void)fq;
        const int row0 = u.pm * 256 + wr * 64 + fr;
#pragma unroll
        for (int ai = 0; ai < 2; ++ai)
#pragma unroll
            for (int m = 0; m < 4; ++m) {
                const f32x4* sp = (const f32x4*)(ss + (size_t)(row0 + ai * 128 + m * 16) * 8);
                const f32x4 s0 = sp[0], s1 = sp[1];
                const float rstd = __builtin_amdgcn_rsqf(((s0[0] + s0[1]) + (s0[2] + s0[3]) + (s1[0] + s1[1]) + (s1[2] + s1[3])) * (1.f / 1024.f) + EPS);
#pragma unroll
                for (int bj = 0; bj < 2; ++bj)
#pragma unroll
                    for (int n = 0; n < 2; ++n) acc[ai][bj][m][n] *= rstd;
            }
    }
    __device__ __forceinline__ void operator()(const pg8::f32x4 (&acc)[2][2][4][2], const pg8::Unit& u, int, int, int, int) const {
        EPI_LANES();
        const int row0 = u.pm * 256 + wr * 64 + fr, b = row0 / SEQ;
        const int col0 = u.pn * 256 + wc * 32 + 4 * fq;
        f32x4 gv[2][2];
#pragma unroll
        for (int bj = 0; bj < 2; ++bj)
#pragma unroll
            for (int n = 0; n < 2; ++n) gv[bj][n] = *(const f32x4*)(mod + b * 3072 + 2048 + col0 + bj * 128 + n * 16);
#pragma unroll
        for (int ai = 0; ai < 2; ++ai)
#pragma unroll
            for (int m = 0; m < 4; ++m) {
                const size_t off = (size_t)(row0 + ai * 128 + m * 16) * DM + col0;
#pragma unroll
                for (int bj = 0; bj < 2; ++bj)
#pragma unroll
                    for (int n = 0; n < 2; ++n) {
                        const f32x4 xv = *(const f32x4*)(x + off + bj * 128 + n * 16);
                        *(f32x4*)(out + off + bj * 128 + n * 16) = xv + gv[bj][n] * acc[ai][bj][m][n];
                    }
            }
    }
};

#define KSWZ(row, colB) ((row) * 256 + ((colB) ^ (((row) & 7) << 4)))
#define SBAR() __builtin_amdgcn_sched_barrier(0)
constexpr int KVBLK = 64;
constexpr size_t SHM_V = KVBLK * 128 * 2, SHM_K = KVBLK * 128 * 2;
constexpr float ATT_SCALE = 0.10206207261596575f;
constexpr float THR = 8.f;
__device__ __forceinline__ f32x16 zero16() { float z; asm volatile("v_mov_b32 %0, 0" : "=v"(z)); f32x16 r;
#pragma unroll
    for (int i = 0; i < 16; ++i) r[i] = z;
    return r; }
__device__ __forceinline__ int crow(int r, int hi) { return (r & 3) + 8 * (r >> 2) + 4 * hi; }
__device__ __forceinline__ int v_st(int k, int c) { const int kk = (k & ~0xC) | ((k & 4) << 1) | ((k & 8) >> 1); return ((kk >> 3) * 4 + (c >> 5)) * 512 + ((kk & 7) * 32 + (c & 31)) * 2; }
__device__ __forceinline__ int v_rd_base(int lane) { return ((lane & 3) << 3) | (((lane >> 2) & 3) << 6) | (((lane >> 4) & 1) << 5) | (((lane >> 5) & 1) << 8); }
constexpr int v_rd_off(int d0, int ks, int half) { return d0 * 512 + ks * 4096 + half * 2048; }
template <int OFF> __device__ __forceinline__ s16x4 tr_read(int vb) {
    s16x4 r; asm volatile("ds_read_b64_tr_b16 %0, %1 offset:%2" : "=&v"(r) : "v"(vb), "i"(OFF) : "memory"); return r;
}
#define PKF(L, H) (bf16x8){L[0], L[1], L[2], L[3], H[0], H[1], H[2], H[3]}
template <int D0> __device__ __forceinline__ void pv_one(f32x16& od, int vb, bf16x8 pa0, bf16x8 pa1, bf16x8 pa2, bf16x8 pa3) {
    const s16x4 l0 = tr_read<v_rd_off(D0, 0, 0)>(vb), h0 = tr_read<v_rd_off(D0, 0, 1)>(vb), l1 = tr_read<v_rd_off(D0, 1, 0)>(vb), h1 = tr_read<v_rd_off(D0, 1, 1)>(vb);
    const s16x4 l2 = tr_read<v_rd_off(D0, 2, 0)>(vb), h2 = tr_read<v_rd_off(D0, 2, 1)>(vb), l3 = tr_read<v_rd_off(D0, 3, 0)>(vb), h3 = tr_read<v_rd_off(D0, 3, 1)>(vb);
    asm volatile("s_waitcnt lgkmcnt(0)" ::: "memory"); SBAR();
    od = __builtin_amdgcn_mfma_f32_32x32x16_bf16(pa0, PKF(l0, h0), od, 0, 0, 0);
    od = __builtin_amdgcn_mfma_f32_32x32x16_bf16(pa1, PKF(l1, h1), od, 0, 0, 0);
    od = __builtin_amdgcn_mfma_f32_32x32x16_bf16(pa2, PKF(l2, h2), od, 0, 0, 0);
    od = __builtin_amdgcn_mfma_f32_32x32x16_bf16(pa3, PKF(l3, h3), od, 0, 0, 0);
}
__device__ __forceinline__ void pv_d0(f32x16* o, int vb, bf16x8 pa0, bf16x8 pa1, bf16x8 pa2, bf16x8 pa3) {
    pv_one<0>(o[0], vb, pa0, pa1, pa2, pa3); pv_one<1>(o[1], vb, pa0, pa1, pa2, pa3); pv_one<2>(o[2], vb, pa0, pa1, pa2, pa3); pv_one<3>(o[3], vb, pa0, pa1, pa2, pa3);
}
#define PK4(P, BASE, OUT) do { unsigned a0 = cvtpk(P[BASE + 0], P[BASE + 1]), a1 = cvtpk(P[BASE + 2], P[BASE + 3]);   \
    unsigned b0 = cvtpk(P[BASE + 4], P[BASE + 5]), b1 = cvtpk(P[BASE + 6], P[BASE + 7]);                              \
    auto r0 = __builtin_amdgcn_permlane32_swap(a0, b0, false, false); auto r1 = __builtin_amdgcn_permlane32_swap(a1, b1, false, false); \
    u32x4 w = {r0[0], r1[0], r0[1], r1[1]}; OUT = *reinterpret_cast<bf16x8*>(&w); } while (0)

__device__ __forceinline__ void partialSM(f32x16& p0, f32x16& p1) {
    (void)p1;
#pragma unroll
    for (int r = 0; r < 16; ++r) p0[r] = __builtin_amdgcn_exp2f(p0[r]);
}
__device__ __forceinline__ void finishSM(f32x16& p0, f32x16& p1, float& l_reg, bf16x8& pa0, bf16x8& pa1, bf16x8& pa2, bf16x8& pa3) {
#pragma unroll
    for (int r = 0; r < 16; ++r) p1[r] = __builtin_amdgcn_exp2f(p1[r]);
    float psa = 0.f, psb = 0.f, psc = 0.f, psd = 0.f;
#pragma unroll
    for (int r = 0; r < 16; r += 4) { psa += p0[r]; psb += p0[r + 1]; psc += p0[r + 2]; psd += p0[r + 3]; }
#pragma unroll
    for (int r = 0; r < 16; r += 4) { psa += p1[r]; psb += p1[r + 1]; psc += p1[r + 2]; psd += p1[r + 3]; }
    float ps = (psa + psb) + (psc + psd);
    { auto rr = __builtin_amdgcn_permlane32_swap(__float_as_uint(ps), __float_as_uint(ps), false, false);
      ps = __uint_as_float(rr[0]) + __uint_as_float(rr[1]); }
    l_reg += ps;
    PK4(p0, 0, pa0); PK4(p0, 8, pa1); PK4(p1, 0, pa2); PK4(p1, 8, pa3);
}
__device__ __forceinline__ void qkt6(f32x16& p0, f32x16& p1, const char* Ks, const bf16x8* qr, int r32, int hi) {
    asm volatile("" : "+v"(r32));
    p0 = f32x16{}; p1 = f32x16{};
#pragma unroll
    for (int d0 = 0; d0 < 6; ++d0) { const int cb = (d0 * 16 + hi * 8) * 2;
        const bf16x8 b0 = *reinterpret_cast<const bf16x8*>(Ks + KSWZ(r32, cb));
        const bf16x8 b1 = *reinterpret_cast<const bf16x8*>(Ks + KSWZ(32 + r32, cb));
        p0 = __builtin_amdgcn_mfma_f32_32x32x16_bf16(b0, qr[d0], p0, 0, 0, 0);
        p1 = __builtin_amdgcn_mfma_f32_32x32x16_bf16(b1, qr[d0], p1, 0, 0, 0);
        asm volatile("" :: "v"(b0), "v"(b1), "v"(qr[d0])); }
}

__device__ __forceinline__ void attn_unit(bf16* __restrict__ QOb, const bf16* __restrict__ Kh, const bf16* __restrict__ Vh, int seq, char* lds,
                                          bf16* __restrict__ mgb  , float* __restrict__ ssb  , const float* __restrict__ wnh  ) {
    constexpr int LDQ = 128, LDKK = 96, LDV = 128;
    int tid_ = threadIdx.x; asm volatile("" : "+v"(tid_));
    const int tid = tid_, wid = tid >> 6, lane = tid & 63, r32 = lane & 31, hi = lane >> 5;
    char* V_lds = lds; char* K_lds = lds + 3 * SHM_V;
    float* ws = (float*)(lds + 3 * SHM_V + 3 * SHM_K) + wid * 64; float* li_l = ws;
    float l_reg = 0; f32x16 o[4] = {}; bf16x8 qr[6];
    const bf16* Qw = QOb + (long)(wid * 32 + r32) * LDQ + hi * 8;
#pragma unroll
    for (int d0 = 0; d0 < 6; ++d0) qr[d0] = *reinterpret_cast<const bf16x8*>(Qw + d0 * 16);
    const int sr = tid >> 4, sc = (tid & 15) * 8, vst0 = v_st(sr, sc), vst1 = v_st(32 + sr, sc);
    const int sck = sc < 96 ? sc : 88;
    const int vb0 = (int)(uintptr_t)V_lds + v_rd_base(lane);
    struct { bf16x8 vs0, vs1, ks0, ks1; } sr_[2];
    const char* Vhb = (const char*)Vh; const char* Khb = (const char*)Kh;
    const unsigned voV = (unsigned)(sr * LDV + sc) * 2u, voK = (unsigned)(sr * LDKK + sck) * 2u;
#define SLOAD(i, k0) do { const char* vt_ = Vhb + (size_t)(k0) * (LDV * 2); const char* kt_ = Khb + (size_t)(k0) * (LDKK * 2); \
    sr_[i].vs0 = *(const bf16x8*)(vt_ + voV); sr_[i].vs1 = *(const bf16x8*)(vt_ + 32 * LDV * 2 + voV); \
    sr_[i].ks0 = *(const bf16x8*)(kt_ + voK); sr_[i].ks1 = *(const bf16x8*)(kt_ + 32 * LDKK * 2 + voK); } while (0)
#define SWRITE(b, i) do {   *(bf16x8*)(V_lds + (b) * SHM_V + vst0) = sr_[i].vs0; *(bf16x8*)(V_lds + (b) * SHM_V + vst1) = sr_[i].vs1; const int kc = sc * 2; \
    *(bf16x8*)(K_lds + (b) * SHM_K + KSWZ(sr, kc)) = sr_[i].ks0; *(bf16x8*)(K_lds + (b) * SHM_K + KSWZ(32 + sr, kc)) = sr_[i].ks1; } while (0)
#define SWAIT() asm volatile("s_waitcnt vmcnt(4)" ::: "memory")
    f32x16 pA0, pA1, pB0, pB1; bf16x8 pa0, pa1, pa2, pa3; const int NT = seq / KVBLK;
    constexpr int SE = 0, SO = 1;
#define ASTEP(PC0, PC1, PP0, PP1, KS, VS, WS, RW, RL, LT, LCOND) do { \
        SBAR(); qkt6(PC0, PC1, K_lds + (KS) * SHM_K, qr, r32, hi); \
        finishSM(PP0, PP1, l_reg, pa0, pa1, pa2, pa3); SBAR(); \
        if (LCOND) SLOAD(RL, (LT) * KVBLK); SBAR(); \
        pv_d0(o, vb0 + (VS) * (int)SHM_V, pa0, pa1, pa2, pa3); partialSM(PC0, PC1); \
        SWRITE(WS, RW); __syncthreads(); } while (0)
    SLOAD(0, 0); SLOAD(1, KVBLK);
    SWRITE(0, 0); __syncthreads();
    SLOAD(0, 2 * KVBLK);
    qkt6(pA0, pA1, K_lds, qr, r32, hi); partialSM(pA0, pA1);
    SWRITE(1, 1); __syncthreads();
    for (int j = 1; j + 5 < NT; j += 6) {
        ASTEP(pB0, pB1, pA0, pA1, 1, 0, 2, 0, 1, j + 2, true);
        ASTEP(pA0, pA1, pB0, pB1, 2, 1, 0, 1, 0, j + 3, true);
        ASTEP(pB0, pB1, pA0, pA1, 0, 2, 1, 0, 1, j + 4, true);
        ASTEP(pA0, pA1, pB0, pB1, 1, 0, 2, 1, 0, j + 5, true);
        ASTEP(pB0, pB1, pA0, pA1, 2, 1, 0, 0, 1, j + 6, true);
        ASTEP(pA0, pA1, pB0, pB1, 0, 2, 1, 1, 0, j + 7, j + 7 < NT);
    }
    SBAR(); qkt6(pB0, pB1, K_lds + 1 * SHM_K, qr, r32, hi);
    finishSM(pA0, pA1, l_reg, pa0, pa1, pa2, pa3); SBAR();
    pv_d0(o, vb0 + 0 * (int)SHM_V, pa0, pa1, pa2, pa3); partialSM(pB0, pB1);
    finishSM(pB0, pB1, l_reg, pa0, pa1, pa2, pa3); SBAR();
    pv_d0(o, vb0 + 1 * (int)SHM_V, pa0, pa1, pa2, pa3);
    __syncthreads();
#undef ASTEP
    { const int t2_ = fresh_tid(), wid = t2_ >> 6, lane = t2_ & 63, r32 = lane & 31, hi = lane >> 5;
      float* li_l = (float*)(lds + 3 * SHM_V + 3 * SHM_K) + wid * 64;
      char* stg = lds + wid * 8192;
      if (hi == 0) li_l[r32] = l_reg; asm volatile("s_waitcnt lgkmcnt(0)" ::: "memory");
      float wv[4];
#pragma unroll
      for (int d0 = 0; d0 < 4; ++d0) wv[d0] = wnh[d0 * 32 + r32];
#pragma unroll
      for (int r = 0; r < 16; ++r) { const int orow = crow(r, hi); const float rl = __builtin_amdgcn_rcpf(li_l[orow]);
          const float a0 = o[0][r] * rl, a1 = o[1][r] * rl, a2 = o[2][r] * rl, a3 = o[3][r] * rl;
          float sq = (a0 * a0 + a1 * a1) + (a2 * a2 + a3 * a3);
#pragma unroll
          for (int ofs = 1; ofs < 32; ofs <<= 1) sq += __shfl_xor(sq, ofs);
          if (r32 == 0) ssb[(size_t)(wid * 32 + orow) * 8] = sq;
          bf16* sp = (bf16*)(stg + orow * 256) + r32;
          sp[0] = (bf16)(cvtpk(a0 * wv[0], 0.f) & 0xffffu); sp[32] = (bf16)(cvtpk(a1 * wv[1], 0.f) & 0xffffu);
          sp[64] = (bf16)(cvtpk(a2 * wv[2], 0.f) & 0xffffu); sp[96] = (bf16)(cvtpk(a3 * wv[3], 0.f) & 0xffffu); }
      const char* gbase = (const char*)(mgb + (size_t)(wid * 32) * PITCH);
      const unsigned goff = (unsigned)((lane >> 4) * PITCH + (lane & 15) * 8) * 2u;
      u32x4 gv[8];
#pragma unroll
      for (int k = 0; k < 8; ++k) gv[k] = *(const u32x4*)(gbase + (size_t)k * (4 * PITCH * 2) + goff);
#pragma unroll
      for (int k = 0; k < 8; ++k) {
          const u32x4 nv = *(const u32x4*)(stg + (4 * k + (lane >> 4)) * 256 + (lane & 15) * 16);
          u32x4 ov;
#pragma unroll
          for (int q = 0; q < 4; ++q) ov[q] = cvtpk(bf_lo(nv[q]) * bf_lo(gv[k][q]), bf_hi(nv[q]) * bf_hi(gv[k][q]));
          *(u32x4*)((char*)gbase + (size_t)k * (4 * PITCH * 2) + goff) = ov;
      } }
#undef SLOAD
#undef SWRITE
#undef SWAIT
}

__device__ __forceinline__ const char* uptr(const char* p) { const unsigned long long a = (unsigned long long)p;
    const unsigned lo = __builtin_amdgcn_readfirstlane((unsigned)a), hi = __builtin_amdgcn_readfirstlane((unsigned)(a >> 32));
    return (const char*)(((unsigned long long)hi << 32) | lo); }

__device__ __forceinline__ void ret_state_phase(const bf16* __restrict__ proj, bf16* __restrict__ kvs, const float* __restrict__ dl_f, const float* __restrict__ dl_b, int bid, int G, char* lds) {
    const int tid = fresh_tid(), wid = tid >> 6, lane = tid & 63, r32 = lane & 31, hi = lane >> 5;
    char* KX = lds;
    char* VT = lds + 32768;
    const unsigned koff = (unsigned)((tid >> 3) * PITCH + (tid & 7) * 8) * 2u, voff = (unsigned)((tid >> 4) * PITCH + (tid & 15) * 8) * 2u;
    const int rb = wid & 3, cg2 = wid >> 2;
    const int kb = (int)(uintptr_t)KX + v_rd_base(lane) + rb * 512;
    const int vb = (int)(uintptr_t)VT + v_rd_base(lane) + cg2 * 1024;
    u32x4 kreg[2], vreg[4];
#define RS_LOAD(U) do { const int bh_ = (U) >> 6, c_ = (U) & 63, b_ = bh_ >> 3, h_ = bh_ & 7; const size_t row0_ = (size_t)b_ * SEQ + (size_t)c_ * 128; \
        const char* kbase_ = (const char*)(proj + row0_ * PITCH + C_RK + h_ * 64); const char* vbase_ = (const char*)(proj + row0_ * PITCH + C_RV + h_ * 128); \
        _Pragma("unroll") for (int i = 0; i < 2; ++i) kreg[i] = *(const u32x4*)(uptr(kbase_ + (size_t)i * (64 * PITCH * 2)) + koff); \
        _Pragma("unroll") for (int i = 0; i < 4; ++i) vreg[i] = *(const u32x4*)(uptr(vbase_ + (size_t)i * (32 * PITCH * 2)) + voff); } while (0)
    int u = bid;
    if (u < BATCH * NH * 64) RS_LOAD(u);
    for (; u < BATCH * NH * 64; u += G) {
        const int bh = u >> 6, c = u & 63, h = bh & 7;
        const float lgf2 = -log1pf(expf(-dl_f[h])) * LOG2E, lgb2 = -log1pf(expf(-dl_b[h])) * LOG2E;
#pragma unroll
        for (int i = 0; i < 2; ++i) {
            const int key = (tid >> 3) + 64 * i, ch = tid & 7;
            const float df = __builtin_amdgcn_exp2f(lgf2 * (float)(127 - key)), db = __builtin_amdgcn_exp2f(lgb2 * (float)key);
            u32x4 wf, wb;
#pragma unroll
            for (int q = 0; q < 4; ++q) { const float x = bf_lo(kreg[i][q]), y = bf_hi(kreg[i][q]); wf[q] = cvtpk(x * df, y * df); wb[q] = cvtpk(x * db, y * db); }
            char* t = KX + (key >> 6) * 16384;
            *(u32x4*)(t + v_st(key & 63, ch * 8)) = wf;
            *(u32x4*)(t + v_st(key & 63, 64 + ch * 8)) = wb;
        }
#pragma unroll
        for (int i = 0; i < 4; ++i) {
            const int key = (tid >> 4) + 32 * i, ch = tid & 15;
            *(u32x4*)(VT + (key >> 6) * 16384 + v_st(key & 63, ch * 8)) = vreg[i];
        }
        __syncthreads();
        if (u + G < BATCH * NH * 64) RS_LOAD(u + G);
        f32x16 acc0 = {}, acc1 = {};
#define RS_STEP(T, KS) do { \
        const s16x4 al = tr_read<(T) * 16384 + (KS) * 4096>(kb), ah = tr_read<(T) * 16384 + (KS) * 4096 + 2048>(kb); \
        const s16x4 bl0 = tr_read<(T) * 16384 + (KS) * 4096>(vb), bh0 = tr_read<(T) * 16384 + (KS) * 4096 + 2048>(vb); \
        const s16x4 bl1 = tr_read<(T) * 16384 + (KS) * 4096 + 512>(vb), bh1 = tr_read<(T) * 16384 + (KS) * 4096 + 2048 + 512>(vb); \
        asm volatile("s_waitcnt lgkmcnt(0)" ::: "memory"); SBAR(); \
        acc0 = __builtin_amdgcn_mfma_f32_32x32x16_bf16(PKF(al, ah), PKF(bl0, bh0), acc0, 0, 0, 0); \
        acc1 = __builtin_amdgcn_mfma_f32_32x32x16_bf16(PKF(al, ah), PKF(bl1, bh1), acc1, 0, 0, 0); } while (0)
        RS_STEP(0, 0); RS_STEP(0, 1); RS_STEP(0, 2); RS_STEP(0, 3); RS_STEP(1, 0); RS_STEP(1, 1); RS_STEP(1, 2); RS_STEP(1, 3);
#undef RS_STEP
        const int dir = rb >> 1;
        bf16* op = kvs + (((size_t)(bh * 64 + c) * 2 + dir) * 64) * 128;
#pragma unroll
        for (int r = 0; r < 16; ++r) { const int dk = 32 * (rb & 1) + crow(r, hi);
            op[dk * 128 + (2 * cg2) * 32 + r32] = (bf16)(cvtpk(acc0[r], 0.f) & 0xffffu);
            op[dk * 128 + (2 * cg2 + 1) * 32 + r32] = (bf16)(cvtpk(acc1[r], 0.f) & 0xffffu); }
        __syncthreads();
    }
#undef RS_LOAD
}

__device__ __forceinline__ void ret_main_phase(bf16* __restrict__ proj, const bf16* __restrict__ kvs, const float* __restrict__ gnw, const float* __restrict__ dl_f, const float* __restrict__ dl_b, int bid, int G, char* lds) {
    const int tid = fresh_tid(), wid = tid >> 6, lane = tid & 63, r32 = lane & 31, hi = lane >> 5;
    char* KT = lds;
    char* VT = lds + 32768;
    const unsigned koff = (unsigned)((tid >> 3) * PITCH + (tid & 7) * 8) * 2u, voff = (unsigned)((tid >> 4) * PITCH + (tid & 15) * 8) * 2u;
    const int c = wid >> 2, iloc = 32 * (wid & 3) + r32;
    const unsigned qoff = (unsigned)((128 * c + iloc) * PITCH + hi * 8) * 2u;
    const int vb0 = (int)(uintptr_t)VT + v_rd_base(lane);
    u32x4 kreg[4], vreg[8]; bf16x8 qr[4];
#define RM_LOAD(U) do { const int bh_ = (U) >> 5, cp_ = (U) & 31, b_ = bh_ >> 3, h_ = bh_ & 7; const size_t row0_ = (size_t)b_ * SEQ + (size_t)cp_ * 256; \
        const char* kbase_ = (const char*)(proj + row0_ * PITCH + C_RK + h_ * 64); const char* vbase_ = (const char*)(proj + row0_ * PITCH + C_RV + h_ * 128); \
        const char* qbase_ = (const char*)(proj + row0_ * PITCH + C_RQ + h_ * 64); \
        _Pragma("unroll") for (int i = 0; i < 4; ++i) kreg[i] = *(const u32x4*)(uptr(kbase_ + (size_t)i * (64 * PITCH * 2)) + koff); \
        _Pragma("unroll") for (int i = 0; i < 8; ++i) vreg[i] = *(const u32x4*)(uptr(vbase_ + (size_t)i * (32 * PITCH * 2)) + voff); \
        _Pragma("unroll") for (int d0 = 0; d0 < 4; ++d0) qr[d0] = *(const bf16x8*)(uptr(qbase_ + d0 * 32) + qoff); } while (0)
    int u = bid;
    if (u < 1024) RM_LOAD(u);
    for (; u < 1024; u += G) {
        const int bh = u >> 5, cp = u & 31, b = bh >> 3, h = bh & 7;
        const float lgf2 = -log1pf(expf(-dl_f[h])) * LOG2E, lgb2 = -log1pf(expf(-dl_b[h])) * LOG2E;
        const size_t row0 = (size_t)b * SEQ + (size_t)cp * 256;
        int iloc_l = iloc, hi_l = hi; asm volatile("" : "+v"(iloc_l), "+v"(hi_l));
#pragma unroll
        for (int i = 0; i < 4; ++i) { const int key = (tid >> 3) + 64 * i, ch = tid & 7; *(u32x4*)(KT + key * 128 + ((ch ^ (key & 7)) << 4)) = kreg[i]; }
#pragma unroll
        for (int i = 0; i < 8; ++i) { const int key = (tid >> 4) + 32 * i, ch = tid & 15; *(u32x4*)(VT + (key >> 6) * 16384 + v_st(key & 63, ch * 8)) = vreg[i]; }
        __syncthreads();
        u32x4 sreg[8];
        { const char* sbase = (const char*)(kvs + (size_t)(bh * 64 + 2 * cp) * (128 * 128));
#pragma unroll
          for (int i = 0; i < 8; ++i) sreg[i] = *(const u32x4*)(uptr(sbase + (size_t)i * 8192) + (unsigned)tid * 16u); }
        f32x16 o[4] = {};
#pragma unroll
        for (int kt = 0; kt < 2; ++kt) {
            const int T = 2 * c + kt;
            f32x16 p0 = {}, p1 = {};
#pragma unroll
            for (int d0 = 0; d0 < 4; ++d0) { const int ch = d0 * 2 + hi; const int k0 = T * 64 + r32, k1 = k0 + 32;
                const bf16x8 b0 = *(const bf16x8*)(KT + k0 * 128 + ((ch ^ (k0 & 7)) << 4));
                const bf16x8 b1 = *(const bf16x8*)(KT + k1 * 128 + ((ch ^ (k1 & 7)) << 4));
                p0 = __builtin_amdgcn_mfma_f32_32x32x16_bf16(b0, qr[d0], p0, 0, 0, 0);
                p1 = __builtin_amdgcn_mfma_f32_32x32x16_bf16(b1, qr[d0], p1, 0, 0, 0); }
#pragma unroll
            for (int r = 0; r < 16; ++r) {
                const int j0 = 64 * kt + crow(r, hi_l), d0_ = iloc_l - j0, d1_ = d0_ - 32;
                const float e0 = (d0_ >= 0 ? lgf2 : -lgb2) * (float)d0_;
                const float e1 = (d1_ >= 0 ? lgf2 : -lgb2) * (float)d1_;
                p0[r] *= __builtin_amdgcn_exp2f(e0); p1[r] *= __builtin_amdgcn_exp2f(e1);
            }
            bf16x8 pa0, pa1, pa2, pa3;
            PK4(p0, 0, pa0); PK4(p0, 8, pa1); PK4(p1, 0, pa2); PK4(p1, 8, pa3);
            pv_d0(o, vb0 + T * 16384, pa0, pa1, pa2, pa3);
        }
        __syncthreads();
#pragma unroll
        for (int i = 0; i < 8; ++i) { const int trow = (tid >> 4) + 32 * i, ch = tid & 15, tile = trow >> 6, dk = trow & 63;
            *(u32x4*)(VT + tile * 16384 + v_st(dk, ch * 8)) = sreg[i]; }
        __syncthreads();
#pragma unroll
        for (int dir = 0; dir < 2; ++dir) {
            const float dec = dir == 0 ? __builtin_amdgcn_exp2f(lgf2 * (float)(iloc_l + 1)) : __builtin_amdgcn_exp2f(lgb2 * (float)(128 - iloc_l));
            bf16x8 pa[4];
#pragma unroll
            for (int k = 0; k < 4; ++k) { const u32x4 w = *reinterpret_cast<const u32x4*>(&qr[k]); u32x4 o4;
#pragma unroll
                for (int q = 0; q < 4; ++q) o4[q] = cvtpk(bf_lo(w[q]) * dec, bf_hi(w[q]) * dec);
                pa[k] = *reinterpret_cast<bf16x8*>(&o4); }
            pv_d0(o, vb0 + (2 * c + dir) * 16384, pa[0], pa[1], pa[2], pa[3]);
        }
        if (u + G < 1024) RM_LOAD(u + G);
        __syncthreads();
        char* stg = VT + wid * 8192;
        float gw[4];
#pragma unroll
        for (int d0 = 0; d0 < 4; ++d0) gw[d0] = gnw[h * 128 + d0 * 32 + r32];
#pragma unroll
        for (int r = 0; r < 16; ++r) {
            float s1 = (o[0][r] + o[1][r]) + (o[2][r] + o[3][r]);
            float s2 = (o[0][r] * o[0][r] + o[1][r] * o[1][r]) + (o[2][r] * o[2][r] + o[3][r] * o[3][r]);
#pragma unroll
            for (int ofs = 1; ofs < 32; ofs <<= 1) { s1 += __shfl_xor(s1, ofs); s2 += __shfl_xor(s2, ofs); }
            const float mu = s1 * (1.f / 128.f), var = fmaxf(s2 * (1.f / 128.f) - mu * mu, 0.f), rs = __builtin_amdgcn_rsqf(var + EPS);
            bf16* sp = (bf16*)(stg + crow(r, hi_l) * 256) + r32;
#pragma unroll
            for (int d0 = 0; d0 < 4; ++d0) sp[d0 * 32] = (bf16)(cvtpk((o[d0][r] - mu) * rs * gw[d0], 0.f) & 0xffffu);
        }
        { const char* gbase = (const char*)(proj + (row0 + 128 * c + 32 * (wid & 3)) * PITCH + C_RG + h * 128);
          const unsigned goff = (unsigned)((lane >> 4) * PITCH + (lane & 15) * 8) * 2u;
          u32x4 gv[8];
#pragma unroll
          for (int k = 0; k < 8; ++k) gv[k] = *(const u32x4*)(uptr(gbase + (size_t)k * (4 * PITCH * 2)) + goff);
#pragma unroll
          for (int k = 0; k < 8; ++k) {
              const u32x4 nv = *(const u32x4*)(stg + (4 * k + (lane >> 4)) * 256 + (lane & 15) * 16);
              u32x4 ov;
#pragma unroll
              for (int q = 0; q < 4; ++q) ov[q] = cvtpk(bf_lo(nv[q]) * bf_lo(gv[k][q]), bf_hi(nv[q]) * bf_hi(gv[k][q]));
              *(u32x4*)((char*)uptr(gbase + (size_t)k * (4 * PITCH * 2)) + goff) = ov;
          } }
        __syncthreads();
    }
#undef RM_LOAD
}

__global__ void __launch_bounds__(NTHREADS) fwd_megakernel(Params p) {
    extern __shared__ __attribute__((aligned(16))) unsigned char lds[];
    cg::grid_group grid = cg::this_grid();
    const int G = gridDim.x, bid = blockIdx.x;
    const int NGW = G * NWAVES; const long NGT = (long)G * NTHREADS;
#define PHASE_IDS() const int tid = fresh_tid(), lane = tid & 63, wave = tid >> 6, gw = bid * NWAVES + wave; const long gt = (long)bid * NTHREADS + tid; (void)lane; (void)gw; (void)gt
    unsigned char* ws = p.ws;
    const float* x = p.in[0]; const float* cvec = p.in[1]; const int* positions = (const int*)p.in[2];
    const float* norm_w = p.in[3]; const float* w_ada = p.in[4]; const float* b_ada = p.in[5]; const float* w_in = p.in[6];
    const float* dl_f = p.in[7]; const float* dl_b = p.in[8]; const float* gn_w = p.in[9];
    const float* q_norm_w = p.in[10]; const float* w_uq = p.in[11]; const float* kv_norm_w = p.in[12]; const float* w_ukv = p.in[13];
    const float* qn_nope_w = p.in[14]; const float* qn_rope_w = p.in[15]; const float* kn_nope_w = p.in[16]; const float* kn_rope_w = p.in[17];
    const float* mla_norm_w = p.in[18]; const float* w_out = p.in[19];
    bf16* PROJ = (bf16*)(ws + WS_PROJ); bf16* KB = (bf16*)(ws + WS_K); bf16* VB = (bf16*)(ws + WS_V);
    bf16* WIN = (bf16*)(ws + WS_WIN); bf16* WQ = (bf16*)(ws + WS_WQ); bf16* WKV = (bf16*)(ws + WS_WKV); bf16* WO = (bf16*)(ws + WS_WO);
    float* CS64 = (float*)(ws + WS_CS64); float* CS32 = (float*)(ws + WS_CS32); float* MOD = (float*)(ws + WS_MOD); f32x2* STAT = (f32x2*)(ws + WS_STAT);
    float* SSB = (float*)(ws + WS_SS);
    bf16* HB = (bf16*)p.out; bf16* QO = (bf16*)((unsigned char*)p.out + OUT_QO); bf16* KVS = (bf16*)((unsigned char*)p.out + OUT_KVS);

    if (threadIdx.x < 4) ((volatile LAS unsigned*)((LAS unsigned char*)lds + LDS_CTL_OFF))[threadIdx.x] = 0u;
    __syncthreads();
    const XcdBarrier xbar = xcd_barrier_post((unsigned*)(ws + WS_BAR), (volatile LAS unsigned*)((LAS unsigned char*)lds + LDS_CTL_OFF));
#define GRID_BAR() xcd_barrier(xbar)
    {
        PHASE_IDS();
        float* sc = (float*)lds; float* red = (float*)(lds + 16384);
        for (int it = bid; it < 192; it += G) {
            for (int i = tid; i < 4096; i += NTHREADS) sc[i] = silu_f(cvec[i]);
            __syncthreads();
            const int ks4 = lane >> 4, col = lane & 15, kb0 = wave * 128 + ks4 * 32;
            const float* wp = w_ada + (size_t)kb0 * 3072 + it * 16 + col;
            float a0 = 0.f, a1 = 0.f, a2 = 0.f, a3 = 0.f;
#pragma unroll 8
            for (int i = 0; i < 32; ++i) { const float wv = wp[(size_t)i * 3072]; const int k = kb0 + i;
                a0 += sc[k] * wv; a1 += sc[1024 + k] * wv; a2 += sc[2048 + k] * wv; a3 += sc[3072 + k] * wv; }
            a0 += __shfl_xor(a0, 16); a0 += __shfl_xor(a0, 32); a1 += __shfl_xor(a1, 16); a1 += __shfl_xor(a1, 32);
            a2 += __shfl_xor(a2, 16); a2 += __shfl_xor(a2, 32); a3 += __shfl_xor(a3, 16); a3 += __shfl_xor(a3, 32);
            if (lane < 16) { red[(wave * 4 + 0) * 16 + lane] = a0; red[(wave * 4 + 1) * 16 + lane] = a1; red[(wave * 4 + 2) * 16 + lane] = a2; red[(wave * 4 + 3) * 16 + lane] = a3; }
            __syncthreads();
            if (tid < 64) { const int bb = tid >> 4, l = tid & 15; float s = b_ada[it * 16 + l];
#pragma unroll
                for (int w = 0; w < 8; ++w) s += red[(w * 4 + bb) * 16 + l];
                MOD[bb * 3072 + it * 16 + l] = s; }
            __syncthreads();
        }
    }
    grid.sync();
#if PROBE_DUP == 4
    for (int rep_ = 0; rep_ < 2; ++rep_)
#endif
    {
    {
        PHASE_IDS();
        constexpr long I1 = 4864L * 128, I2 = 768L * 48, I3 = 1536L * 32, I4 = 1024L * 256;
        for (long it = gt; it < I1 + I2 + I3 + I4; it += NGT) {
            long r = it; const float* W; const float* ksc = nullptr; int n, kc, Kd, No, oc; bf16* WT;
            if (r < I1) { n = (int)(r % 4864); kc = (int)(r / 4864); W = w_in; Kd = 1024; No = D_IN; oc = win_colmap(n); WT = WIN; }
            else if ((r -= I1) < I2) { n = (int)(r % 768); kc = (int)(r / 768); W = w_uq; Kd = 384; No = 768; oc = wq_colmap(n); WT = WQ; ksc = q_norm_w; }
            else if ((r -= I2) < I3) { n = (int)(r % 1536); kc = (int)(r / 1536); W = w_ukv; Kd = 256; No = 1536; oc = wkv_colmap(n); WT = WKV; ksc = kv_norm_w; }
            else { r -= I3; n = (int)(r % 1024); kc = (int)(r / 1024); W = w_out; Kd = 2048; No = 1024; oc = n; WT = WO; }
            float v[8];
#pragma unroll
            for (int i = 0; i < 8; ++i) { const int k = kc * 8 + i; const int ks_ = (W == w_out) ? (k < 1024 ? k + 1024 : k - 1024) : k;
                float t = oc >= 0 ? W[(size_t)ks_ * No + oc] : 0.f; if (ksc) t *= ksc[k]; v[i] = t; }
            u32x4 w; w.x = cvtpk(v[0], v[1]); w.y = cvtpk(v[2], v[3]); w.z = cvtpk(v[4], v[5]); w.w = cvtpk(v[6], v[7]);
            *(u32x4*)(WT + (size_t)n * Kd + kc * 8) = w;
        }
        for (long it = gt; it < (long)M * 48; it += NGT) {
            const int m = (int)(it / 48), i = (int)(it % 48);
            const float pos = (float)positions[m];
            const float fe = i < 32 ? (float)(2 * i) * (1.f / 64.f) : (float)(2 * (i - 32)) * (1.f / 32.f);
            const float invf = exp2f(-fe * 13.287712379549449f);
            const float ang = pos * invf;
            double rev = (double)ang * 0.15915494309189535; rev -= floor(rev);
            const float rf = (float)rev;
            const float cs = __builtin_amdgcn_cosf(rf), sn = __builtin_amdgcn_sinf(rf);
            float* dst = i < 32 ? CS64 + ((size_t)m * 32 + i) * 2 : CS32 + ((size_t)m * 16 + (i - 32)) * 2;
            *(f32x2*)dst = (f32x2){cs, sn};
        }
    }
    { PHASE_IDS();
    for (int m0 = gw; m0 < M; m0 += 2 * NGW) {
        const int m1 = m0 + NGW; const bool has1 = m1 < M;
        const f32x4* xr0 = (const f32x4*)(x + (size_t)m0 * DM) + lane; const f32x4* xr1 = (const f32x4*)(x + (size_t)(has1 ? m1 : m0) * DM) + lane;
        f32x4 v0[4], v1[4]; float s0 = 0.f, s1 = 0.f;
#pragma unroll
        for (int j = 0; j < 4; ++j) { v0[j] = xr0[64 * j]; v1[j] = xr1[64 * j]; }
#pragma unroll
        for (int j = 0; j < 4; ++j) { s0 += (v0[j].x * v0[j].x + v0[j].y * v0[j].y) + (v0[j].z * v0[j].z + v0[j].w * v0[j].w);
                                      s1 += (v1[j].x * v1[j].x + v1[j].y * v1[j].y) + (v1[j].z * v1[j].z + v1[j].w * v1[j].w); }
        const float rstd0 = __builtin_amdgcn_rsqf(wave_sum(s0) * (1.f / DM) + EPS), rstd1 = __builtin_amdgcn_rsqf(wave_sum(s1) * (1.f / DM) + EPS);
        const int b0 = m0 / SEQ, b1 = (has1 ? m1 : m0) / SEQ;
        u32x2* o80 = (u32x2*)(HB + (size_t)m0 * DM) + lane; u32x2* o81 = (u32x2*)(HB + (size_t)m1 * DM) + lane;
#pragma unroll
        for (int j = 0; j < 4; ++j) {
            const int col = 4 * lane + 256 * j;
            const f32x4 nw = *(const f32x4*)(norm_w + col);
            { const f32x4 sh = *(const f32x4*)(MOD + b0 * 3072 + col), scl = *(const f32x4*)(MOD + b0 * 3072 + 1024 + col);
              const f32x4 hv = v0[j] * rstd0 * nw * (scl + 1.f) + sh; o80[64 * j] = (u32x2){cvtpk(hv.x, hv.y), cvtpk(hv.z, hv.w)}; }
            if (has1) { const f32x4 sh = *(const f32x4*)(MOD + b1 * 3072 + col), scl = *(const f32x4*)(MOD + b1 * 3072 + 1024 + col);
              const f32x4 hv = v1[j] * rstd1 * nw * (scl + 1.f) + sh; o81[64 * j] = (u32x2){cvtpk(hv.x, hv.y), cvtpk(hv.z, hv.w)}; }
        }
    } }
    }
    GRID_BAR();

    {
        pg8::Gemm g{HB, WIN, M, PITCH, DM, DM}; pg8::StaticOrder S; S.init(M, PITCH, G, bid);
        EpiIn E{PROJ, CS64};
        pg8::gemm_phase<EpiIn, pg8::StaticOrder>((LAS unsigned char*)lds, g, S, E);
    }
    GRID_BAR();

#if PROBE_DUP == 1
    for (int rep_ = 0; rep_ < 2; ++rep_)
#endif
    {
    { PHASE_IDS();
    const int sub = lane >> 4, l16 = lane & 15;
    for (int m0 = gw * 4; m0 < M; m0 += NGW * 4) {
        const int m = m0 + sub, b = m / SEQ, s = m - b * SEQ;
        const bf16* pr = PROJ + (size_t)m * PITCH + C_CQ + 8 * l16;
        u32x4 v[6];
#pragma unroll
        for (int i = 0; i < 5; ++i) v[i] = *(const u32x4*)(pr + 128 * i);
        v[5] = (u32x4){0u, 0u, 0u, 0u}; if (l16 < 4) v[5] = *(const u32x4*)(pr + 640);
        float s_cq = sumsq8(v[0]) + sumsq8(v[1]) + sumsq8(v[2]);
        float s_ckv = sumsq8(v[3]) + sumsq8(v[4]);
        float s_kr = sumsq8(v[5]);
#pragma unroll
        for (int ofs = 1; ofs < 16; ofs <<= 1) { s_cq += __shfl_xor(s_cq, ofs); s_ckv += __shfl_xor(s_ckv, ofs); s_kr += __shfl_xor(s_kr, ofs); }
        if (l16 == 0) STAT[m] = (f32x2){s_cq * (1.f / 384.f), s_ckv * (1.f / 256.f)};
        const float rk = __builtin_amdgcn_rsqf(s_kr * (1.f / 32.f) + EPS);
        const u32x4 b2 = v[5];
        u32x4 pw; pw.x = __shfl_xor(b2.x, 2); pw.y = __shfl_xor(b2.y, 2); pw.z = __shfl_xor(b2.z, 2); pw.w = __shfl_xor(b2.w, 2);
        if (l16 < 2) {
            const int pb = 8 * l16;
            unsigned ow[8];
#pragma unroll
            for (int q = 0; q < 4; ++q) {
#pragma unroll
                for (int e = 0; e < 2; ++e) {
                    const int pidx = pb + 2 * q + e;
                    const float x1 = (e ? bf_hi(b2[q]) : bf_lo(b2[q])) * rk * kn_rope_w[pidx];
                    const float x2 = (e ? bf_hi(pw[q]) : bf_lo(pw[q])) * rk * kn_rope_w[pidx + 16];
                    const f32x2 csv = *(const f32x2*)(CS32 + ((size_t)m * 16 + pidx) * 2);
                    ow[2 * q + e] = cvtpk(x1 * csv.x - x2 * csv.y, x2 * csv.x + x1 * csv.y);
                }
            }
            const u32x4 w0 = {ow[0], ow[1], ow[2], ow[3]}, w1 = {ow[4], ow[5], ow[6], ow[7]};
#pragma unroll
            for (int hh = 0; hh < NH; ++hh) { bf16* kp = KB + ((size_t)(b * NH + hh) * SEQ + s) * 96 + 64 + 16 * l16;
                *(u32x4*)kp = w0; *(u32x4*)(kp + 8) = w1; }
        }
    } }
    ret_state_phase(PROJ, KVS, dl_f, dl_b, bid, G, (char*)lds);
    }
    GRID_BAR();

    { PHASE_IDS();
    for (long it = gt; it < 32L * 2 * 2048; it += NGT) {
        const int e4 = (int)(it & 2047), dir = (int)((it >> 11) & 1), bh = (int)(it >> 12), h = bh & 7;
        const float lg2 = -log1pf(expf(-(dir ? dl_b[h] : dl_f[h]))) * LOG2E;
        const float gC = __builtin_amdgcn_exp2f(lg2 * 128.f);
        float s0 = 0.f, s1 = 0.f, s2 = 0.f, s3 = 0.f;
        for (int i = 0; i < 64; ++i) {
            const int c = dir ? 63 - i : i;
            u32x2* ptr = (u32x2*)(KVS + (((size_t)(bh * 64 + c) * 2 + dir) * 8192) + 4 * e4);
            const u32x2 kv = *ptr;
            *ptr = (u32x2){cvtpk(s0, s1), cvtpk(s2, s3)};
            s0 = s0 * gC + bf_lo(kv.x); s1 = s1 * gC + bf_hi(kv.x); s2 = s2 * gC + bf_lo(kv.y); s3 = s3 * gC + bf_hi(kv.y);
        }
    } }
#if PROBE_DUP == 2
    for (int rep_ = 0; rep_ < 2; ++rep_)
#endif
    {
    {
        pg8::Gemm g{PROJ + C_CQ, WQ, M, 768, 384, PITCH}; pg8::StaticOrder S; S.init(M, 768, G, G - 1 - bid);
        EpiUp<3> E{QO, nullptr, STAT, qn_nope_w, qn_rope_w, CS32};
        pg8::gemm_phase<EpiUp<3>, pg8::StaticOrder>((LAS unsigned char*)lds, g, S, E);
    }
    {
        pg8::Gemm g{PROJ + C_CKV, WKV, M, 1536, 256, PITCH}; pg8::StaticOrder S; S.init(M, 1536, G, bid);
        EpiUp<2> E{KB, VB, STAT, kn_nope_w, nullptr, nullptr};
        pg8::gemm_phase<EpiUp<2>, pg8::StaticOrder>((LAS unsigned char*)lds, g, S, E);
    }
    }
    GRID_BAR();

    for (int i = 0; i * G < 1024; ++i) {
        int u = i * G + bid; if (u >= 1024) break;
        int bh, qb;
        if (G == 256) { bh = (bid & 7) * 4 + i; qb = bid >> 3; } else { bh = u >> 5; qb = u & 31; }
        bf16* qo = QO + ((size_t)bh * SEQ + (size_t)qb * 256) * 128;
        { const int b_ = bh >> 3, h_ = bh & 7; const size_t row_ = (size_t)b_ * SEQ + (size_t)qb * 256;
          attn_unit(qo, KB + (size_t)bh * SEQ * 96, VB + (size_t)bh * SEQ * 128, SEQ, (char*)lds,
                    PROJ + row_ * PITCH + C_MG + h_ * 128, SSB + row_ * 8 + h_, mla_norm_w + h_ * 128); }
        __syncthreads();
    }
    ret_main_phase(PROJ, KVS, gn_w, dl_f, dl_b, bid, G, (char*)lds);
    GRID_BAR();

    {
        pg8::Gemm g{PROJ + C_MG, WO, M, DM, 2048, PITCH}; pg8::StaticOrder S; S.init(M, DM, G, bid);
        EpiOut E{x, p.out, MOD, SSB};
        pg8::gemm_phase<EpiOut, pg8::StaticOrder>((LAS unsigned char*)lds, g, S, E);
    }
}

extern "C" void kernel_launch(void* const* d_in, const int* in_sizes, int n_in, void* d_out, int out_size, void* d_ws, size_t ws_size, hipStream_t stream) {
    static int grid_blocks = 0;
    if (grid_blocks == 0) {
        if (n_in != 20 || out_size != M * DM || ws_size < WS_END) { fprintf(stderr, "kernel_launch: unexpected shapes (n_in %d out %d ws %zu)\n", n_in, out_size, ws_size); grid_blocks = -1; return; }
        int dev = 0, cus = 0, per_cu = 0;
        hipGetDevice(&dev);
        hipDeviceGetAttribute(&cus, hipDeviceAttributeMultiprocessorCount, dev);
        if (hipFuncSetAttribute((const void*)fwd_megakernel, hipFuncAttributeMaxDynamicSharedMemorySize, LDS_BYTES) != hipSuccess) { fprintf(stderr, "kernel_launch: hipFuncSetAttribute failed\n"); grid_blocks = -1; return; }
        if (hipOccupancyMaxActiveBlocksPerMultiprocessor(&per_cu, (const void*)fwd_megakernel, NTHREADS, LDS_BYTES) != hipSuccess || per_cu < 1) { fprintf(stderr, "kernel_launch: occupancy query failed (%d)\n", per_cu); per_cu = 1; }
        (void)hipGetLastError();
        grid_blocks = cus * per_cu;
    }
    if (grid_blocks < 0) return;
    if (hipMemsetAsync((char*)d_ws + WS_BAR, 0, XCD_BAR_WORDS * 4, stream) != hipSuccess) { fprintf(stderr, "kernel_launch: memset failed\n"); return; }
    Params p{};
    for (int i = 0; i < 20; ++i) p.in[i] = (const float*)d_in[i];
    p.out = (float*)d_out; p.ws = (unsigned char*)d_ws;
    void* args[] = {&p};
    hipError_t e = hipLaunchCooperativeKernel((const void*)fwd_megakernel, dim3(grid_blocks), dim3(NTHREADS), args, LDS_BYTES, stream);
    if (e != hipSuccess) fprintf(stderr, "cooperative launch failed: %s (grid %d)\n", hipGetErrorString(e), grid_blocks);
}
```

```cpp
#ifndef PROBE_DUP
#define PROBE_DUP 0
#endif
#include <hip/hip_runtime.h>
#include <hip/hip_cooperative_groups.h>
#include <cstdio>
#include <cstdint>
namespace cg = cooperative_groups;

namespace pg8 {
#define PG8_LAS __attribute__((address_space(3)))
typedef unsigned short bf16_t;
typedef short bf16x8 __attribute__((ext_vector_type(8)));
typedef float f32x4 __attribute__((ext_vector_type(4)));
typedef unsigned u32x4 __attribute__((ext_vector_type(4)));
constexpr int BM = 256, BK = 64, HALF = 128, HTB = HALF * BK * 2, STAGE_BYTES = 8 * HTB, NXCD = 8, WGM = 8;

__host__ __device__ __forceinline__ int lds_byte(int r, int c) { const int st = (r >> 4) * 2 + (c >> 5), rr = r & 15, cc = c & 31, ob = rr * 64 + cc * 2; return st * 1024 + (ob ^ (((ob >> 9) & 1) << 5)); }
__host__ __device__ __forceinline__ void stage_rc(int b, int& R, int& C) { const int st = b / 1024, sb = b % 1024, swz = sb ^ (((sb >> 9) & 1) << 5); R = (st >> 1) * 16 + swz / 64; C = (st & 1) * 32 + (swz % 64) / 2; }
__host__ __device__ __forceinline__ int perm32(int rho) { const int n = rho >> 4, i = rho & 15; return 8 * (i >> 2) + 4 * n + (i & 3); }

struct Unit { int pm, pn; };
struct Gemm { const bf16_t* A; const bf16_t* Bt; int M, N, K, lda; };

struct StaticOrder {
    int nM, nN, nwg, G, c;
    __host__ __device__ void init(int M, int N, int G_, int c_) { nM = M / BM; nN = N / BM; nwg = nM * nN; G = G_; c = c_; }
    __host__ __device__ bool next(int i, Unit& u) const {
        const long L = (long)i * G + c; if (L >= nwg) return false;
        int wgid = (int)L; { const int q = nwg / NXCD, r = nwg % NXCD, xcd = wgid % NXCD, off = wgid / NXCD; wgid = (xcd < r ? xcd * (q + 1) : r * (q + 1) + (xcd - r) * q) + off; }
        const int nig = WGM * nN, gid = wgid / nig, fm = gid * WGM, gsz = (nM - fm) < WGM ? (nM - fm) : WGM;
        u.pm = fm + ((wgid % nig) % gsz); u.pn = (wgid % nig) / gsz; return true;
    }
};

typedef float f32x2_c __attribute__((ext_vector_type(2)));
typedef __bf16 bf16x2_c __attribute__((ext_vector_type(2)));
__device__ __forceinline__ unsigned cvt_pk_bf16(float lo, float hi) { const f32x2_c v = {lo, hi}; return __builtin_bit_cast(unsigned, __builtin_convertvector(v, bf16x2_c)); }

template <class Epi, class Sched>
__device__ __forceinline__ void gemm_phase(PG8_LAS unsigned char* lds, const Gemm g, const Sched& S, const Epi& E) {
    int tid_ = threadIdx.x; asm volatile("" : "+v"(tid_));
    const int tid = tid_, wid = __builtin_amdgcn_readfirstlane(tid >> 6), lane = tid & 63, wr = wid >> 2, wc = wid & 3, fr = lane & 15, fq = lane >> 4;
    const int K = g.K, nt = K / BK, lda = g.lda;
    unsigned voffA[2], voffB[2];
#pragma unroll
    for (int i = 0; i < 2; ++i) { int R, C; stage_rc(tid * 16 + i * 8192, R, C); const int Rb = Epi::PERM ? ((R & ~31) + perm32(R & 31)) : R;
        voffA[i] = (unsigned)(R * lda + C) * 2u; voffB[i] = (unsigned)(Rb * K + C) * 2u; }
    const size_t kstep = (size_t)(BK * 2);
    const size_t hstepA = (size_t)HALF * lda * 2, hstepB = (size_t)HALF * K * 2;
    const size_t tstepA = 2 * hstepA, tstepB = 2 * hstepB;
    const unsigned ldsw = (unsigned)wid * 1024u;
    const int aoff = lds_byte(wr * 64 + fr, fq * 8), boff = lds_byte(wc * 32 + fr, fq * 8);
#define PG8_SA(b, h) (((b) * 2 + (h)) * HTB)
#define PG8_SB(b, h) ((4 + (b) * 2 + (h)) * HTB)
#define PG8_STAGE(bufoff, gbase, voff) do { _Pragma("unroll") for (int _i = 0; _i < 2; ++_i) \
        __builtin_amdgcn_global_load_lds((const unsigned*)((const char*)(gbase) + (voff)[_i]), (PG8_LAS unsigned*)(lds + (bufoff) + ldsw + _i * 8192), 16, 0, 0); } while (0)
#define PG8_LDA(dst, b, h) do { _Pragma("unroll") for (int m = 0; m < 4; ++m) _Pragma("unroll") for (int k = 0; k < 2; ++k) dst[m][k] = *(const PG8_LAS bf16x8*)(lds + PG8_SA(b, h) + aoff + m * 2048 + k * 1024); } while (0)
#define PG8_LDB(dst, b, h) do { _Pragma("unroll") for (int n = 0; n < 2; ++n) _Pragma("unroll") for (int k = 0; k < 2; ++k) dst[n][k] = *(const PG8_LAS bf16x8*)(lds + PG8_SB(b, h) + boff + n * 2048 + k * 1024); } while (0)
#define PG8_MMA(ai, bj, At, Bt) do { __builtin_amdgcn_s_setprio(1); _Pragma("unroll") for (int m = 0; m < 4; ++m) _Pragma("unroll") for (int n = 0; n < 2; ++n) _Pragma("unroll") for (int k = 0; k < 2; ++k) \
        acc[ai][bj][m][n] = __builtin_amdgcn_mfma_f32_16x16x32_bf16(Bt[n][k], At[m][k], acc[ai][bj][m][n], 0, 0, 0); __builtin_amdgcn_s_setprio(0); } while (0)
#define PG8_WAIT_V(n) asm volatile("s_waitcnt vmcnt(" #n ")" ::: "memory")
#define PG8_WAIT_L(n) asm volatile("s_waitcnt lgkmcnt(" #n ")" ::: "memory")
#define PG8_BAR __builtin_amdgcn_s_barrier()
#define PG8_SCHED __builtin_amdgcn_sched_barrier(0)
    Unit cur, nxt; int ui = 0;
    if (!S.next(0, cur)) return;
    f32x4 acc[2][2][4][2];
#pragma unroll
    for (int a = 0; a < 2; ++a)
#pragma unroll
        for (int b = 0; b < 2; ++b)
#pragma unroll
            for (int m = 0; m < 4; ++m)
#pragma unroll
                for (int n = 0; n < 2; ++n) acc[a][b][m][n] = (f32x4){0.f, 0.f, 0.f, 0.f};
    bf16x8 At[4][2], B0[2][2], B1[2][2];
    const char* cA = (const char*)g.A + (size_t)cur.pm * tstepA; const char* cB = (const char*)g.Bt + (size_t)cur.pn * tstepB;
    PG8_STAGE(PG8_SB(0, 0), cB, voffB); PG8_STAGE(PG8_SB(0, 1), cB + hstepB, voffB); PG8_STAGE(PG8_SA(0, 0), cA, voffA); PG8_STAGE(PG8_SA(0, 1), cA + hstepA, voffA);
    if (wr == 1) PG8_BAR;
    PG8_WAIT_V(2); PG8_BAR;
    PG8_STAGE(PG8_SB(1, 0), cB + kstep, voffB); PG8_STAGE(PG8_SA(1, 0), cA + kstep, voffA); PG8_STAGE(PG8_SB(1, 1), cB + hstepB + kstep, voffB);
    PG8_WAIT_V(6); PG8_BAR;
    for (;;) {
        const bool has_next = S.next(ui + 1, nxt);
        const char* nA = has_next ? (const char*)g.A + (size_t)nxt.pm * tstepA : cA; const char* nB = has_next ? (const char*)g.Bt + (size_t)nxt.pn * tstepB : cB;
#pragma unroll 1
        for (int t = 0; t < nt; t += 2) {
            if constexpr (Epi::MIDSCALE) { if (t == nt / 2) E.mid(acc, cur); }
            const bool last = (t == nt - 2);
            const char* a1 = cA + (size_t)(t + 1) * kstep;
            const char* a2 = last ? nA : cA + (size_t)(t + 2) * kstep; const char* b2 = last ? nB : cB + (size_t)(t + 2) * kstep;
            const char* a3 = a2 + kstep; const char* b3 = b2 + kstep;
            PG8_LDB(B0, 0, 0); PG8_LDB(B1, 0, 1); PG8_SCHED; PG8_LDA(At, 0, 0); PG8_STAGE(PG8_SA(1, 1), a1 + hstepA, voffA);
            PG8_WAIT_V(8); PG8_WAIT_L(0); PG8_BAR; PG8_MMA(0, 0, At, B0); PG8_MMA(0, 1, At, B1); PG8_BAR; PG8_SCHED;
            PG8_LDA(At, 0, 1); PG8_STAGE(PG8_SB(0, 0), b2, voffB); PG8_STAGE(PG8_SB(0, 1), b2 + hstepB, voffB); PG8_STAGE(PG8_SA(0, 0), a2, voffA);
            PG8_WAIT_V(8); PG8_WAIT_L(0); PG8_BAR; PG8_MMA(1, 0, At, B0); PG8_MMA(1, 1, At, B1); PG8_BAR; PG8_SCHED;
            PG8_LDB(B0, 1, 0); PG8_LDB(B1, 1, 1); PG8_SCHED; PG8_LDA(At, 1, 0); PG8_STAGE(PG8_SA(0, 1), a2 + hstepA, voffA);
            PG8_WAIT_V(8); PG8_WAIT_L(0); PG8_BAR; PG8_MMA(0, 0, At, B0); PG8_MMA(0, 1, At, B1); PG8_BAR; PG8_SCHED;
            PG8_LDA(At, 1, 1); PG8_STAGE(PG8_SB(1, 0), b3, voffB); PG8_STAGE(PG8_SB(1, 1), b3 + hstepB, voffB); PG8_STAGE(PG8_SA(1, 0), a3, voffA);
            PG8_WAIT_V(8); PG8_WAIT_L(0); PG8_BAR; PG8_MMA(1, 0, At, B0); PG8_MMA(1, 1, At, B1); PG8_BAR; PG8_SCHED;
        }
        if (wr == 0) PG8_BAR;
        E(acc, cur, wr, wc, fr, fq);
        if (!has_next) break;
#pragma unroll
        for (int a = 0; a < 2; ++a)
#pragma unroll
            for (int b = 0; b < 2; ++b)
#pragma unroll
                for (int m = 0; m < 4; ++m)
#pragma unroll
                    for (int n = 0; n < 2; ++n) acc[a][b][m][n] = (f32x4){0.f, 0.f, 0.f, 0.f};
        cur = nxt; cA = nA; cB = nB; ++ui;
        if (wr == 1) PG8_BAR;
    }
    PG8_WAIT_V(0);
    PG8_BAR;
#undef PG8_SA
#undef PG8_SB
#undef PG8_STAGE
#undef PG8_LDA
#undef PG8_LDB
#undef PG8_MMA
#undef PG8_WAIT_V
#undef PG8_WAIT_L
#undef PG8_BAR
#undef PG8_SCHED
}
}

typedef unsigned short bf16;
typedef short bf16x8 __attribute__((ext_vector_type(8)));
typedef short s16x4 __attribute__((ext_vector_type(4)));
typedef float f32x16 __attribute__((ext_vector_type(16)));
typedef float f32x4 __attribute__((ext_vector_type(4)));
typedef float f32x2 __attribute__((ext_vector_type(2)));
typedef unsigned u32x4 __attribute__((ext_vector_type(4)));
typedef unsigned u32x2 __attribute__((ext_vector_type(2)));
#define LAS __attribute__((address_space(3)))

constexpr int BATCH = 4, SEQ = 8192, DM = 1024, M = BATCH * SEQ, NH = 8;
constexpr int D_IN = 4768, PITCH = 4864;
constexpr int C_RQ = 0, C_RK = 512, C_RV = 1024, C_MG = 2048, C_RG = 3072, C_CQ = 4096, C_CKV = 4480, C_KR = 4736;
constexpr float EPS = 1e-6f;
constexpr float QSC = 0.10206207261596575f * 1.4426950408889634f;
constexpr float LOG2E = 1.4426950408889634f;
constexpr int NTHREADS = 512, NWAVES = 8;

constexpr size_t MiB = 1u << 20;
constexpr size_t WS_PROJ = 0;
constexpr size_t WS_K = 304 * MiB;
constexpr size_t WS_V = 352 * MiB;
constexpr size_t WS_WIN = 416 * MiB;
constexpr size_t WS_WQ = 426 * MiB;
constexpr size_t WS_WKV = 427 * MiB;
constexpr size_t WS_WO = 428 * MiB;
constexpr size_t WS_CS64 = 432 * MiB;
constexpr size_t WS_CS32 = 440 * MiB;
constexpr size_t WS_MOD = 444 * MiB;
constexpr size_t WS_STAT = 445 * MiB;
constexpr size_t WS_SS = 447 * MiB;
constexpr size_t WS_BAR = 446 * MiB;
constexpr size_t WS_END = 448 * MiB;
constexpr size_t OUT_QO = 0, OUT_KVS = 64 * MiB;

constexpr int LDS_BYTES = 135168;
constexpr int LDS_CTL_OFF = 133120;

struct Params { const float* in[20]; float* out; unsigned char* ws; };

__device__ __forceinline__ unsigned cvtpk(float lo, float hi) { return pg8::cvt_pk_bf16(lo, hi); }
__device__ __forceinline__ float bf_lo(unsigned w) { return __uint_as_float(w << 16); }
__device__ __forceinline__ float bf_hi(unsigned w) { return __uint_as_float(w & 0xffff0000u); }
__device__ __forceinline__ float wave_sum(float v) {
#pragma unroll
    for (int o = 1; o < 64; o <<= 1) v += __shfl_xor(v, o);
    return v;
}
template <int MASK> __device__ __forceinline__ float swz_xor(float v) { return __uint_as_float(__builtin_amdgcn_ds_swizzle(__float_as_uint(v), (MASK << 10) | 0x1f)); }
__device__ __forceinline__ float silu_f(float v) { return v * __builtin_amdgcn_rcpf(1.f + __builtin_amdgcn_exp2f(-v * LOG2E)); }
__device__ __forceinline__ float sumsq8(u32x4 a) {
    float s = 0.f;
#pragma unroll
    for (int i = 0; i < 4; ++i) { const float x = bf_lo(a[i]), y = bf_hi(a[i]); s += x * x + y * y; }
    return s;
}

__device__ __forceinline__ int fresh_tid() { int t = threadIdx.x; asm volatile("" : "+v"(t)); return t; }
#define EPI_LANES() const int t_ = fresh_tid(), l_ = t_ & 63, wi_ = t_ >> 6, wr = wi_ >> 2, wc = wi_ & 3, fr = l_ & 15, fq = l_ >> 4


#define RLX_AGENT __ATOMIC_RELAXED, __HIP_MEMORY_SCOPE_AGENT
#define XB_TMO      128
#define XB_XCNT(j)  (256  + 64 * (j))
#define XB_XSUB(j)  (1280 + 64 * (j))
#define XB_XGEN(j)  (2304 + 64 * (j))
#define XB_TOP      3328
#define XB_TOPGEN   3392
#define XCD_BAR_WORDS 3456
#define XB_SPIN_CAP (1u << 18)

__device__ __forceinline__ unsigned xb_ld(unsigned* p)              { return __hip_atomic_load(p, __ATOMIC_RELAXED, __HIP_MEMORY_SCOPE_AGENT); }
__device__ __forceinline__ unsigned xb_add(unsigned* p, unsigned v) { return __hip_atomic_fetch_add(p, v, __ATOMIC_RELAXED, __HIP_MEMORY_SCOPE_AGENT); }
__device__ __forceinline__ unsigned xb_xcc_id() { return (unsigned)__builtin_amdgcn_s_getreg((3 << 11) | 20) & 0xFu; }
#define XB_SPIN(cond, bar) do { unsigned _sp = 0; while (cond) { __builtin_amdgcn_s_sleep(1); \
    if ((++_sp & 255u) == 0u) { if (xb_ld(&(bar)[XB_TMO])) break; if (_sp > XB_SPIN_CAP) { atomicAdd(&(bar)[XB_TMO], 1u); break; } } } } while (0)

struct XcdBarrier {
    unsigned* bar; unsigned x;
    volatile LAS unsigned* st;
};

__device__ __forceinline__ XcdBarrier xcd_barrier_post(unsigned* bar, volatile LAS unsigned* st) {
    XcdBarrier b; b.bar = bar; b.x = xb_xcc_id(); b.st = st;
    if (threadIdx.x == 0) (void)xb_add(&bar[XB_XCNT(b.x)], 1u);
    return b;
}
__device__ __forceinline__ void xcd_barrier_complete(unsigned* bar, unsigned x, unsigned& nloc, unsigned& nx) {
    const unsigned G = gridDim.x * gridDim.y * gridDim.z;
    unsigned sum, cnt, mine, sp = 0u;
    for (;;) {
        sum = 0u; cnt = 0u; mine = 0u;
#pragma unroll
        for (unsigned j = 0; j < 16; ++j) { const unsigned c = xb_ld(&bar[XB_XCNT(j)]); sum += c; cnt += (c > 0u) ? 1u : 0u; mine = (j == x) ? c : mine; }
        if (sum == G) break;
        __builtin_amdgcn_s_sleep(1);
        if ((++sp & 255u) == 0u) { if (xb_ld(&bar[XB_TMO])) break; if (sp > XB_SPIN_CAP) { atomicAdd(&bar[XB_TMO], 1u); break; } }
    }
    nloc = mine > 0u ? mine : 1u; nx = cnt > 0u ? cnt : 1u;
}

__device__ __forceinline__ void xcd_barrier(const XcdBarrier& b) {
    asm volatile("s_waitcnt vmcnt(0)" ::: "memory");
    __syncthreads();
    if (threadIdx.x == 0) {
        unsigned* bar = b.bar;
        __builtin_amdgcn_s_waitcnt(0);
        unsigned nloc = b.st[0], nx = b.st[1];
        if (nloc == 0u) { xcd_barrier_complete(bar, b.x, nloc, nx); b.st[0] = nloc; b.st[1] = nx; }
        const unsigned old = xb_add(&bar[XB_XSUB(b.x)], 1u);
        const unsigned gen = old / nloc;
        if (old + 1u == (gen + 1u) * nloc) {
            __builtin_amdgcn_fence(__ATOMIC_RELEASE, "agent");
            asm volatile("s_waitcnt vmcnt(0)" ::: "memory");
            const unsigned og = xb_add(&bar[XB_TOP], 1u);
            const unsigned tg = og / nx;
            if (og + 1u == (tg + 1u) * nx) xb_add(&bar[XB_TOPGEN], 1u);
            else XB_SPIN(xb_ld(&bar[XB_TOPGEN]) == tg, bar);
            __builtin_amdgcn_fence(__ATOMIC_ACQUIRE, "agent");
            xb_add(&bar[XB_XGEN(b.x)], 1u);
            asm volatile("s_waitcnt vmcnt(0)" ::: "memory");
        } else {
            XB_SPIN(xb_ld(&bar[XB_XGEN(b.x)]) == gen, bar);
            __builtin_amdgcn_fence(__ATOMIC_ACQUIRE, "agent");
            asm volatile("s_waitcnt vmcnt(0)" ::: "memory");
        }
    }
    __syncthreads();
}


__device__ __forceinline__ int win_colmap(int n) {
    if (n < 1024) { const int base = n & ~63, j = n & 63; return base + (j >> 1) + 32 * (j & 1); }
    if (n < 2048) return n;
    if (n < 3072) return 3744 + (n - 2048);
    if (n < 4096) return 2048 + (n - 3072);
    if (n < 4480) return 3072 + (n - 4096);
    if (n < 4736) return 3456 + (n - 4480);
    if (n < 4768) return 3712 + (n - 4736);
    return -1;
}
__device__ __forceinline__ int nope_map(int n, int per_head) {
    const int t = n >> 8, c = n & 255, bj = c >> 7, wc = (c >> 5) & 3, j = c & 31;
    return (4 * t + wc) * per_head + 32 * bj + j;
}
__device__ __forceinline__ int wq_colmap(int n) {
    if (n < 512) return nope_map(n, 96);
    const int c = n - 512, head = c >> 5, j = c & 31; return head * 96 + 64 + (j >> 1) + 16 * (j & 1);
}
__device__ __forceinline__ int wkv_colmap(int n) {
    if (n < 512) return nope_map(n, 192);
    const int c = n - 512, head = c >> 7, dim = c & 127; return head * 192 + 64 + dim;
}

struct EpiIn {
    static constexpr bool PERM = true, MIDSCALE = false;
    bf16* P; const float* cs64;
    __device__ __forceinline__ void operator()(const pg8::f32x4 (&acc)[2][2][4][2], const pg8::Unit& u, int, int, int, int) const {
        EPI_LANES();
        const int row0 = u.pm * 256 + wr * 64 + fr, colt = u.pn * 256, cl = wc * 32 + 8 * fq;
        const int mode = u.pn < 4 ? 1 : ((u.pn >= 8 && u.pn < 16) ? 2 : 0);
        const float rs = u.pn < 2 ? 1.f : 0.125f;
        const int p0 = (wc & 1) * 16 + 4 * fq;
        f32x4 n0 = {1.f, 0.f, 1.f, 0.f}, n1 = {1.f, 0.f, 1.f, 0.f};
        if (mode == 1) { const f32x4* t = (const f32x4*)(cs64 + ((size_t)row0 * 32 + p0) * 2); n0 = t[0]; n1 = t[1]; }
#pragma unroll
        for (int ai = 0; ai < 2; ++ai)
#pragma unroll
            for (int m = 0; m < 4; ++m) {
                const int row = row0 + ai * 128 + m * 16;
                bf16* rowp = P + (size_t)row * PITCH + colt + cl;
                const f32x4 c0 = n0, c1 = n1;
                if (mode == 1 && (ai * 4 + m) < 7) { const int rown = row0 + ((ai * 4 + m + 1) >> 2) * 128 + ((ai * 4 + m + 1) & 3) * 16;
                    const f32x4* t = (const f32x4*)(cs64 + ((size_t)rown * 32 + p0) * 2); n0 = t[0]; n1 = t[1]; }
#pragma unroll
                for (int bj = 0; bj < 2; ++bj) {
                    f32x4 v0 = acc[ai][bj][m][0], v1 = acc[ai][bj][m][1];
                    if (mode == 1) {
                        f32x4 o0, o1;
                        o0[0] = (v0[0] * c0[0] - v0[1] * c0[1]) * rs; o0[1] = (v0[1] * c0[0] + v0[0] * c0[1]) * rs;
                        o0[2] = (v0[2] * c0[2] - v0[3] * c0[3]) * rs; o0[3] = (v0[3] * c0[2] + v0[2] * c0[3]) * rs;
                        o1[0] = (v1[0] * c1[0] - v1[1] * c1[1]) * rs; o1[1] = (v1[1] * c1[0] + v1[0] * c1[1]) * rs;
                        o1[2] = (v1[2] * c1[2] - v1[3] * c1[3]) * rs; o1[3] = (v1[3] * c1[2] + v1[2] * c1[3]) * rs;
                        v0 = o0; v1 = o1;
                    } else if (mode == 2) {
#pragma unroll
                        for (int i = 0; i < 4; ++i) { v0[i] = silu_f(v0[i]); v1[i] = silu_f(v1[i]); }
                    }
                    u32x4 w; w.x = cvtpk(v0[0], v0[1]); w.y = cvtpk(v0[2], v0[3]); w.z = cvtpk(v1[0], v1[1]); w.w = cvtpk(v1[2], v1[3]);
                    *(u32x4*)(rowp + bj * 128) = w;
                }
                asm volatile("" ::: "memory");
            }
    }
};

template <int MODE> struct EpiUp {
    static constexpr bool IS_Q = MODE != 2, MIDSCALE = false;
    static constexpr bool PERM = true;
    bf16* O;
    bf16* Vo;
    const f32x2* stat;
    const float* wn;
    const float* wr_;
    const float* cs32;
    __device__ __forceinline__ void operator()(const pg8::f32x4 (&acc)[2][2][4][2], const pg8::Unit& u, int, int, int, int) const {
        EPI_LANES();
        const int row0 = u.pm * 256 + wr * 64 + fr;
        const int b = row0 / SEQ;
        constexpr int OP = IS_Q ? 128 : 96;
        float ms8[8];
#pragma unroll
        for (int i = 0; i < 8; ++i) { const f32x2 st = stat[row0 + (i >> 2) * 128 + (i & 3) * 16]; ms8[i] = IS_Q ? st.x : st.y; }
        if (MODE == 0 || ((MODE == 2 || MODE == 3) && u.pn < 2)) {
            const int head = 4 * u.pn + wc;
            const f32x4 w00 = *(const f32x4*)(wn + 8 * fq), w01 = *(const f32x4*)(wn + 8 * fq + 4), w10 = *(const f32x4*)(wn + 32 + 8 * fq), w11 = *(const f32x4*)(wn + 36 + 8 * fq);
#pragma unroll
            for (int ai = 0; ai < 2; ++ai)
#pragma unroll
                for (int m = 0; m < 4; ++m) {
                    const int row = row0 + ai * 128 + m * 16;
                    const f32x4 a0 = acc[ai][0][m][0], a1 = acc[ai][0][m][1], b0 = acc[ai][1][m][0], b1 = acc[ai][1][m][1];
                    float ss = 0.f;
#pragma unroll
                    for (int i = 0; i < 4; ++i) ss += a0[i] * a0[i] + a1[i] * a1[i] + b0[i] * b0[i] + b1[i] * b1[i];
                    ss += __shfl_xor(ss, 16); ss += __shfl_xor(ss, 32);
                    const float ms = ms8[ai * 4 + m];
                    const float sc = __builtin_amdgcn_rsqf(ss * (1.f / 64.f) + EPS * (ms + EPS)) * (IS_Q ? QSC : 1.f);
                    bf16* op = O + ((size_t)(b * NH + head) * SEQ + (row - b * SEQ)) * OP;
                    const f32x4 x0 = a0 * sc * w00, x1 = a1 * sc * w01, y0 = b0 * sc * w10, y1 = b1 * sc * w11;
                    u32x4 w; w.x = cvtpk(x0[0], x0[1]); w.y = cvtpk(x0[2], x0[3]); w.z = cvtpk(x1[0], x1[1]); w.w = cvtpk(x1[2], x1[3]);
                    *(u32x4*)(op + 8 * fq) = w;
                    w.x = cvtpk(y0[0], y0[1]); w.y = cvtpk(y0[2], y0[3]); w.z = cvtpk(y1[0], y1[1]); w.w = cvtpk(y1[2], y1[3]);
                    *(u32x4*)(op + 32 + 8 * fq) = w;
                }
        } else if (MODE == 1 || MODE == 3) {
            const f32x4 wl = *(const f32x4*)(wr_ + 4 * fq), wh = *(const f32x4*)(wr_ + 16 + 4 * fq);
            f32x4 n0, n1; { const f32x4* t = (const f32x4*)(cs32 + ((size_t)row0 * 16 + 4 * fq) * 2); n0 = t[0]; n1 = t[1]; }
#pragma unroll
            for (int ai = 0; ai < 2; ++ai)
#pragma unroll
                for (int m = 0; m < 4; ++m) {
                    const int row = row0 + ai * 128 + m * 16;
                    const float epsq = EPS * (ms8[ai * 4 + m] + EPS);
                    const f32x4 c0 = n0, c1 = n1;
                    if ((ai * 4 + m) < 7) { const int rown = row0 + ((ai * 4 + m + 1) >> 2) * 128 + ((ai * 4 + m + 1) & 3) * 16;
                        const f32x4* t = (const f32x4*)(cs32 + ((size_t)rown * 16 + 4 * fq) * 2); n0 = t[0]; n1 = t[1]; }
#pragma unroll
                    for (int bj = 0; bj < 2; ++bj) {
                        const f32x4 v0 = acc[ai][bj][m][0], v1 = acc[ai][bj][m][1];
                        float ss = 0.f;
#pragma unroll
                        for (int i = 0; i < 4; ++i) ss += v0[i] * v0[i] + v1[i] * v1[i];
                        ss += __shfl_xor(ss, 16); ss += __shfl_xor(ss, 32);
                        const float sc = __builtin_amdgcn_rsqf(ss * (1.f / 32.f) + epsq) * QSC;
                        const float x1a = v0[0] * sc * wl[0], x2a = v0[1] * sc * wh[0], x1b = v0[2] * sc * wl[1], x2b = v0[3] * sc * wh[1];
                        const float x1c = v1[0] * sc * wl[2], x2c = v1[1] * sc * wh[2], x1d = v1[2] * sc * wl[3], x2d = v1[3] * sc * wh[3];
                        u32x4 w;
                        w.x = cvtpk(x1a * c0[0] - x2a * c0[1], x2a * c0[0] + x1a * c0[1]);
                        w.y = cvtpk(x1b * c0[2] - x2b * c0[3], x2b * c0[2] + x1b * c0[3]);
                        w.z = cvtpk(x1c * c1[0] - x2c * c1[1], x2c * c1[0] + x1c * c1[1]);
                        w.w = cvtpk(x1d * c1[2] - x2d * c1[3], x2d * c1[2] + x1d * c1[3]);
                        const int head = 4 * bj + wc;
                        bf16* op = O + ((size_t)(b * NH + head) * SEQ + (row - b * SEQ)) * OP;
                        *(u32x4*)(op + 64 + 8 * fq) = w;
                    }
                    asm volatile("" ::: "memory");
                }
        } else {
#pragma unroll
            for (int ai = 0; ai < 2; ++ai)
#pragma unroll
                for (int m = 0; m < 4; ++m) {
                    const int row = row0 + ai * 128 + m * 16;
                    const float sc = __builtin_amdgcn_rsqf(ms8[ai * 4 + m] + EPS);
#pragma unroll
                    for (int bj = 0; bj < 2; ++bj) {
                        const f32x4 v0 = acc[ai][bj][m][0] * sc, v1 = acc[ai][bj][m][1] * sc;
                        const int head = 2 * (u.pn - 2) + bj;
                        bf16* op = Vo + ((size_t)(b * NH + head) * SEQ + (row - b * SEQ)) * 128 + 32 * wc + 8 * fq;
                        u32x4 w; w.x = cvtpk(v0[0], v0[1]); w.y = cvtpk(v0[2], v0[3]); w.z = cvtpk(v1[0], v1[1]); w.w = cvtpk(v1[2], v1[3]);
                        *(u32x4*)op = w;
                    }
                }
        }
    }
};

struct EpiOut {
    static constexpr bool PERM = false, MIDSCALE = true;
    const float* x; float* out; const float* mod; const float* ss;
    __device__ __forceinline__ void mid(pg8::f32x4 (&acc)[2][2][4][2], const pg8::Unit& u) const {
        EPI_LANES(); (void)wc; (void)fq;
        const int row0 = u.pm * 256 + wr * 64 + fr;
#pragma unroll
        for (int ai = 0; ai < 2; ++ai)
#pragma unroll
            for (int m = 0; m < 4; ++m) {
                const f32x4* sp = (const f32x4*)(ss + (size_t)(row0 + ai * 128 + m * 16) * 8);
                const f32x4 s0 = sp[0], s1 = sp[1];
                const float rstd = __builtin_amdgcn_rsqf(((s0[0] + s0[1]) + (s0[2] + s0[3]) + (s1[0] + s1[1]) + (s1[2] + s1[3])) * (1.f / 1024.f) + EPS);
#pragma unroll
                for (int bj = 0; bj < 2; ++bj)
#pragma unroll
                    for (int n = 0; n < 2; ++n) acc[ai][bj][m][n] *= rstd;
            }
    }
    __device__ __forceinline__ void operator()(const pg8::f32x4 (&acc)[2][2][4][2], const pg8::Unit& u, int, int, int, int) const {
        EPI_LANES();
        const int row0 = u.pm * 256 + wr * 64 + fr, b = row0 / SEQ;
        const int col0 = u.pn * 256 + wc * 32 + 4 * fq;
        f32x4 gv[2][2];
#pragma unroll
        for (int bj = 0; bj < 2; ++bj)
#pragma unroll
            for (int n = 0; n < 2; ++n) gv[bj][n] = *(const f32x4*)(mod + b * 3072 + 2048 + col0 + bj * 128 + n * 16);
#pragma unroll
        for (int ai = 0; ai < 2; ++ai)
#pragma unroll
            for (int m = 0; m < 4; ++m) {
                const size_t off = (size_t)(row0 + ai * 128 + m * 16) * DM + col0;
#pragma unroll
                for (int bj = 0; bj < 2; ++bj)
#pragma unroll
                    for (int n = 0; n < 2; ++n) {
                        const f32x4 xv = *(const f32x4*)(x + off + bj * 128 + n * 16);
                        *(f32x4*)(out + off + bj * 128 + n * 16) = xv + gv[bj][n] * acc[ai][bj][m][n];
                    }
            }
    }
};

#define KSWZ(row, colB) ((row) * 256 + ((colB) ^ (((row) & 7) << 4)))
#define SBAR() __builtin_amdgcn_sched_barrier(0)
constexpr int KVBLK = 64;
constexpr size_t SHM_V = KVBLK * 128 * 2, SHM_K = KVBLK * 128 * 2;
constexpr float ATT_SCALE = 0.10206207261596575f;
constexpr float THR = 8.f;
__device__ __forceinline__ f32x16 zero16() { float z; asm volatile("v_mov_b32 %0, 0" : "=v"(z)); f32x16 r;
#pragma unroll
    for (int i = 0; i < 16; ++i) r[i] = z;
    return r; }
__device__ __forceinline__ int crow(int r, int hi) { return (r & 3) + 8 * (r >> 2) + 4 * hi; }
__device__ __forceinline__ int v_st(int k, int c) { const int kk = (k & ~0xC) | ((k & 4) << 1) | ((k & 8) >> 1); return ((kk >> 3) * 4 + (c >> 5)) * 512 + ((kk & 7) * 32 + (c & 31)) * 2; }
__device__ __forceinline__ int v_rd_base(int lane) { return ((lane & 3) << 3) | (((lane >> 2) & 3) << 6) | (((lane >> 4) & 1) << 5) | (((lane >> 5) & 1) << 8); }
constexpr int v_rd_off(int d0, int ks, int half) { return d0 * 512 + ks * 4096 + half * 2048; }
template <int OFF> __device__ __forceinline__ s16x4 tr_read(int vb) {
    s16x4 r; asm volatile("ds_read_b64_tr_b16 %0, %1 offset:%2" : "=&v"(r) : "v"(vb), "i"(OFF) : "memory"); return r;
}
#define PKF(L, H) (bf16x8){L[0], L[1], L[2], L[3], H[0], H[1], H[2], H[3]}
template <int D0> __device__ __forceinline__ void pv_one(f32x16& od, int vb, bf16x8 pa0, bf16x8 pa1, bf16x8 pa2, bf16x8 pa3) {
    const s16x4 l0 = tr_read<v_rd_off(D0, 0, 0)>(vb), h0 = tr_read<v_rd_off(D0, 0, 1)>(vb), l1 = tr_read<v_rd_off(D0, 1, 0)>(vb), h1 = tr_read<v_rd_off(D0, 1, 1)>(vb);
    const s16x4 l2 = tr_read<v_rd_off(D0, 2, 0)>(vb), h2 = tr_read<v_rd_off(D0, 2, 1)>(vb), l3 = tr_read<v_rd_off(D0, 3, 0)>(vb), h3 = tr_read<v_rd_off(D0, 3, 1)>(vb);
    asm volatile("s_waitcnt lgkmcnt(0)" ::: "memory"); SBAR();
    od = __builtin_amdgcn_mfma_f32_32x32x16_bf16(pa0, PKF(l0, h0), od, 0, 0, 0);
    od = __builtin_amdgcn_mfma_f32_32x32x16_bf16(pa1, PKF(l1, h1), od, 0, 0, 0);
    od = __builtin_amdgcn_mfma_f32_32x32x16_bf16(pa2, PKF(l2, h2), od, 0, 0, 0);
    od = __builtin_amdgcn_mfma_f32_32x32x16_bf16(pa3, PKF(l3, h3), od, 0, 0, 0);
}
__device__ __forceinline__ void pv_d0(f32x16* o, int vb, bf16x8 pa0, bf16x8 pa1, bf16x8 pa2, bf16x8 pa3) {
    pv_one<0>(o[0], vb, pa0, pa1, pa2, pa3); pv_one<1>(o[1], vb, pa0, pa1, pa2, pa3); pv_one<2>(o[2], vb, pa0, pa1, pa2, pa3); pv_one<3>(o[3], vb, pa0, pa1, pa2, pa3);
}
#define PK4(P, BASE, OUT) do { unsigned a0 = cvtpk(P[BASE + 0], P[BASE + 1]), a1 = cvtpk(P[BASE + 2], P[BASE + 3]);   \
    unsigned b0 = cvtpk(P[BASE + 4], P[BASE + 5]), b1 = cvtpk(P[BASE + 6], P[BASE + 7]);                              \
    auto r0 = __builtin_amdgcn_permlane32_swap(a0, b0, false, false); auto r1 = __builtin_amdgcn_permlane32_swap(a1, b1, false, false); \
    u32x4 w = {r0[0], r1[0], r0[1], r1[1]}; OUT = *reinterpret_cast<bf16x8*>(&w); } while (0)

__device__ __forceinline__ void partialSM(f32x16& p0, f32x16& p1) {
    (void)p1;
#pragma unroll
    for (int r = 0; r < 16; ++r) p0[r] = __builtin_amdgcn_exp2f(p0[r]);
}
__device__ __forceinline__ void finishSM(f32x16& p0, f32x16& p1, float& l_reg, bf16x8& pa0, bf16x8& pa1, bf16x8& pa2, bf16x8& pa3) {
#pragma unroll
    for (int r = 0; r < 16; ++r) p1[r] = __builtin_amdgcn_exp2f(p1[r]);
    float ps = 0;
#pragma unroll
    for (int r = 0; r < 16; ++r) ps += p0[r];
#pragma unroll
    for (int r = 0; r < 16; ++r) ps += p1[r];
    { auto rr = __builtin_amdgcn_permlane32_swap(__float_as_uint(ps), __float_as_uint(ps), false, false);
      ps = __uint_as_float(rr[0]) + __uint_as_float(rr[1]); }
    l_reg += ps;
    PK4(p0, 0, pa0); PK4(p0, 8, pa1); PK4(p1, 0, pa2); PK4(p1, 8, pa3);
}
__device__ __forceinline__ void qkt6(f32x16& p0, f32x16& p1, const char* Ks, const bf16x8* qr, int r32, int hi) {
    asm volatile("" : "+v"(r32));
    p0 = f32x16{}; p1 = f32x16{};
#pragma unroll
    for (int d0 = 0; d0 < 6; ++d0) { const int cb = (d0 * 16 + hi * 8) * 2;
        const bf16x8 b0 = *reinterpret_cast<const bf16x8*>(Ks + KSWZ(r32, cb));
        const bf16x8 b1 = *reinterpret_cast<const bf16x8*>(Ks + KSWZ(32 + r32, cb));
        p0 = __builtin_amdgcn_mfma_f32_32x32x16_bf16(b0, qr[d0], p0, 0, 0, 0);
        p1 = __builtin_amdgcn_mfma_f32_32x32x16_bf16(b1, qr[d0], p1, 0, 0, 0);
        asm volatile("" :: "v"(b0), "v"(b1), "v"(qr[d0])); }
}

__device__ __forceinline__ void attn_unit(bf16* __restrict__ QOb, const bf16* __restrict__ Kh, const bf16* __restrict__ Vh, int seq, char* lds,
                                          bf16* __restrict__ mgb  , float* __restrict__ ssb  , const float* __restrict__ wnh  ) {
    constexpr int LDQ = 128, LDKK = 96, LDV = 128;
    int tid_ = threadIdx.x; asm volatile("" : "+v"(tid_));
    const int tid = tid_, wid = tid >> 6, lane = tid & 63, r32 = lane & 31, hi = lane >> 5;
    char* V_lds = lds; char* K_lds = lds + 3 * SHM_V;
    float* ws = (float*)(lds + 3 * SHM_V + 3 * SHM_K) + wid * 64; float* li_l = ws;
    float l_reg = 0; f32x16 o[4] = {}; bf16x8 qr[6];
    const bf16* Qw = QOb + (long)(wid * 32 + r32) * LDQ + hi * 8;
#pragma unroll
    for (int d0 = 0; d0 < 6; ++d0) qr[d0] = *reinterpret_cast<const bf16x8*>(Qw + d0 * 16);
    const int sr = tid >> 4, sc = (tid & 15) * 8, vst0 = v_st(sr, sc), vst1 = v_st(32 + sr, sc);
    const int sck = sc < 96 ? sc : 88;
    const int vb0 = (int)(uintptr_t)V_lds + v_rd_base(lane);
    struct { bf16x8 vs0, vs1, ks0, ks1; } sr_[2];
    const char* Vhb = (const char*)Vh; const char* Khb = (const char*)Kh;
    const unsigned voV = (unsigned)(sr * LDV + sc) * 2u, voK = (unsigned)(sr * LDKK + sck) * 2u;
#define SLOAD(i, k0) do { const char* vt_ = Vhb + (size_t)(k0) * (LDV * 2); const char* kt_ = Khb + (size_t)(k0) * (LDKK * 2); \
    sr_[i].vs0 = *(const bf16x8*)(vt_ + voV); sr_[i].vs1 = *(const bf16x8*)(vt_ + 32 * LDV * 2 + voV); \
    sr_[i].ks0 = *(const bf16x8*)(kt_ + voK); sr_[i].ks1 = *(const bf16x8*)(kt_ + 32 * LDKK * 2 + voK); } while (0)
#define SWRITE(b, i) do {   *(bf16x8*)(V_lds + (b) * SHM_V + vst0) = sr_[i].vs0; *(bf16x8*)(V_lds + (b) * SHM_V + vst1) = sr_[i].vs1; const int kc = sc * 2; \
    *(bf16x8*)(K_lds + (b) * SHM_K + KSWZ(sr, kc)) = sr_[i].ks0; *(bf16x8*)(K_lds + (b) * SHM_K + KSWZ(32 + sr, kc)) = sr_[i].ks1; } while (0)
#define SWAIT() asm volatile("s_waitcnt vmcnt(4)" ::: "memory")
    f32x16 pA0, pA1, pB0, pB1; bf16x8 pa0, pa1, pa2, pa3; const int NT = seq / KVBLK;
    constexpr int SE = 0, SO = 1;
#define ASTEP(PC0, PC1, PP0, PP1, KS, VS, WS, RW, RL, LT, LCOND) do { \
        SBAR(); qkt6(PC0, PC1, K_lds + (KS) * SHM_K, qr, r32, hi); \
        finishSM(PP0, PP1, l_reg, pa0, pa1, pa2, pa3); SBAR(); \
        if (LCOND) SLOAD(RL, (LT) * KVBLK); SBAR(); \
        pv_d0(o, vb0 + (VS) * (int)SHM_V, pa0, pa1, pa2, pa3); partialSM(PC0, PC1); \
        SWRITE(WS, RW); __syncthreads(); } while (0)
    SLOAD(0, 0); SLOAD(1, KVBLK);
    SWRITE(0, 0); __syncthreads();
    SLOAD(0, 2 * KVBLK);
    qkt6(pA0, pA1, K_lds, qr, r32, hi); partialSM(pA0, pA1);
    SWRITE(1, 1); __syncthreads();
    for (int j = 1; j + 5 < NT; j += 6) {
        ASTEP(pB0, pB1, pA0, pA1, 1, 0, 2, 0, 1, j + 2, true);
        ASTEP(pA0, pA1, pB0, pB1, 2, 1, 0, 1, 0, j + 3, true);
        ASTEP(pB0, pB1, pA0, pA1, 0, 2, 1, 0, 1, j + 4, true);
        ASTEP(pA0, pA1, pB0, pB1, 1, 0, 2, 1, 0, j + 5, true);
        ASTEP(pB0, pB1, pA0, pA1, 2, 1, 0, 0, 1, j + 6, true);
        ASTEP(pA0, pA1, pB0, pB1, 0, 2, 1, 1, 0, j + 7, j + 7 < NT);
    }
    SBAR(); qkt6(pB0, pB1, K_lds + 1 * SHM_K, qr, r32, hi);
    finishSM(pA0, pA1, l_reg, pa0, pa1, pa2, pa3); SBAR();
    pv_d0(o, vb0 + 0 * (int)SHM_V, pa0, pa1, pa2, pa3); partialSM(pB0, pB1);
    finishSM(pB0, pB1, l_reg, pa0, pa1, pa2, pa3); SBAR();
    pv_d0(o, vb0 + 1 * (int)SHM_V, pa0, pa1, pa2, pa3);
    __syncthreads();
#undef ASTEP
    { const int t2_ = fresh_tid(), wid = t2_ >> 6, lane = t2_ & 63, r32 = lane & 31, hi = lane >> 5;
      float* li_l = (float*)(lds + 3 * SHM_V + 3 * SHM_K) + wid * 64;
      char* stg = lds + wid * 8192;
      if (hi == 0) li_l[r32] = l_reg; asm volatile("s_waitcnt lgkmcnt(0)" ::: "memory");
      float wv[4];
#pragma unroll
      for (int d0 = 0; d0 < 4; ++d0) wv[d0] = wnh[d0 * 32 + r32];
#pragma unroll
      for (int r = 0; r < 16; ++r) { const int orow = crow(r, hi); const float rl = __builtin_amdgcn_rcpf(li_l[orow]);
          const float a0 = o[0][r] * rl, a1 = o[1][r] * rl, a2 = o[2][r] * rl, a3 = o[3][r] * rl;
          float sq = (a0 * a0 + a1 * a1) + (a2 * a2 + a3 * a3);
          sq += swz_xor<1>(sq); sq += swz_xor<2>(sq); sq += swz_xor<4>(sq); sq += swz_xor<8>(sq); sq += swz_xor<16>(sq);
          if (r32 == 0) ssb[(size_t)(wid * 32 + orow) * 8] = sq;
          bf16* sp = (bf16*)(stg + orow * 256) + r32;
          sp[0] = (bf16)(cvtpk(a0 * wv[0], 0.f) & 0xffffu); sp[32] = (bf16)(cvtpk(a1 * wv[1], 0.f) & 0xffffu);
          sp[64] = (bf16)(cvtpk(a2 * wv[2], 0.f) & 0xffffu); sp[96] = (bf16)(cvtpk(a3 * wv[3], 0.f) & 0xffffu); }
      const char* gbase = (const char*)(mgb + (size_t)(wid * 32) * PITCH);
      const unsigned goff = (unsigned)((lane >> 4) * PITCH + (lane & 15) * 8) * 2u;
      u32x4 gv[8];
#pragma unroll
      for (int k = 0; k < 8; ++k) gv[k] = *(const u32x4*)(gbase + (size_t)k * (4 * PITCH * 2) + goff);
#pragma unroll
      for (int k = 0; k < 8; ++k) {
          const u32x4 nv = *(const u32x4*)(stg + (4 * k + (lane >> 4)) * 256 + (lane & 15) * 16);
          u32x4 ov;
#pragma unroll
          for (int q = 0; q < 4; ++q) ov[q] = cvtpk(bf_lo(nv[q]) * bf_lo(gv[k][q]), bf_hi(nv[q]) * bf_hi(gv[k][q]));
          *(u32x4*)((char*)gbase + (size_t)k * (4 * PITCH * 2) + goff) = ov;
      } }
#undef SLOAD
#undef SWRITE
#undef SWAIT
}

__device__ __forceinline__ const char* uptr(const char* p) { const unsigned long long a = (unsigned long long)p;
    const unsigned lo = __builtin_amdgcn_readfirstlane((unsigned)a), hi = __builtin_amdgcn_readfirstlane((unsigned)(a >> 32));
    return (const char*)(((unsigned long long)hi << 32) | lo); }

__device__ __forceinline__ void ret_state_phase(const bf16* __restrict__ proj, bf16* __restrict__ kvs, const float* __restrict__ dl_f, const float* __restrict__ dl_b, int bid, int G, char* lds) {
    const int tid = fresh_tid(), wid = tid >> 6, lane = tid & 63, r32 = lane & 31, hi = lane >> 5;
    char* KX = lds;
    char* VT = lds + 32768;
    const unsigned koff = (unsigned)((tid >> 3) * PITCH + (tid & 7) * 8) * 2u, voff = (unsigned)((tid >> 4) * PITCH + (tid & 15) * 8) * 2u;
    const int rb = wid & 3, cg2 = wid >> 2;
    const int kb = (int)(uintptr_t)KX + v_rd_base(lane) + rb * 512;
    const int vb = (int)(uintptr_t)VT + v_rd_base(lane) + cg2 * 1024;
    u32x4 kreg[2], vreg[4];
#define RS_LOAD(U) do { const int bh_ = (U) >> 6, c_ = (U) & 63, b_ = bh_ >> 3, h_ = bh_ & 7; const size_t row0_ = (size_t)b_ * SEQ + (size_t)c_ * 128; \
        const char* kbase_ = (const char*)(proj + row0_ * PITCH + C_RK + h_ * 64); const char* vbase_ = (const char*)(proj + row0_ * PITCH + C_RV + h_ * 128); \
        _Pragma("unroll") for (int i = 0; i < 2; ++i) kreg[i] = *(const u32x4*)(uptr(kbase_ + (size_t)i * (64 * PITCH * 2)) + koff); \
        _Pragma("unroll") for (int i = 0; i < 4; ++i) vreg[i] = *(const u32x4*)(uptr(vbase_ + (size_t)i * (32 * PITCH * 2)) + voff); } while (0)
    int u = bid;
    if (u < BATCH * NH * 64) RS_LOAD(u);
    for (; u < BATCH * NH * 64; u += G) {
        const int bh = u >> 6, c = u & 63, h = bh & 7;
        const float lgf2 = -log1pf(expf(-dl_f[h])) * LOG2E, lgb2 = -log1pf(expf(-dl_b[h])) * LOG2E;
#pragma unroll
        for (int i = 0; i < 2; ++i) {
            const int key = (tid >> 3) + 64 * i, ch = tid & 7;
            const float df = __builtin_amdgcn_exp2f(lgf2 * (float)(127 - key)), db = __builtin_amdgcn_exp2f(lgb2 * (float)key);
            u32x4 wf, wb;
#pragma unroll
            for (int q = 0; q < 4; ++q) { const float x = bf_lo(kreg[i][q]), y = bf_hi(kreg[i][q]); wf[q] = cvtpk(x * df, y * df); wb[q] = cvtpk(x * db, y * db); }
            char* t = KX + (key >> 6) * 16384;
            *(u32x4*)(t + v_st(key & 63, ch * 8)) = wf;
            *(u32x4*)(t + v_st(key & 63, 64 + ch * 8)) = wb;
        }
#pragma unroll
        for (int i = 0; i < 4; ++i) {
            const int key = (tid >> 4) + 32 * i, ch = tid & 15;
            *(u32x4*)(VT + (key >> 6) * 16384 + v_st(key & 63, ch * 8)) = vreg[i];
        }
        __syncthreads();
        if (u + G < BATCH * NH * 64) RS_LOAD(u + G);
        f32x16 acc0 = {}, acc1 = {};
#define RS_STEP(T, KS) do { \
        const s16x4 al = tr_read<(T) * 16384 + (KS) * 4096>(kb), ah = tr_read<(T) * 16384 + (KS) * 4096 + 2048>(kb); \
        const s16x4 bl0 = tr_read<(T) * 16384 + (KS) * 4096>(vb), bh0 = tr_read<(T) * 16384 + (KS) * 4096 + 2048>(vb); \
        const s16x4 bl1 = tr_read<(T) * 16384 + (KS) * 4096 + 512>(vb), bh1 = tr_read<(T) * 16384 + (KS) * 4096 + 2048 + 512>(vb); \
        asm volatile("s_waitcnt lgkmcnt(0)" ::: "memory"); SBAR(); \
        acc0 = __builtin_amdgcn_mfma_f32_32x32x16_bf16(PKF(al, ah), PKF(bl0, bh0), acc0, 0, 0, 0); \
        acc1 = __builtin_amdgcn_mfma_f32_32x32x16_bf16(PKF(al, ah), PKF(bl1, bh1), acc1, 0, 0, 0); } while (0)
        RS_STEP(0, 0); RS_STEP(0, 1); RS_STEP(0, 2); RS_STEP(0, 3); RS_STEP(1, 0); RS_STEP(1, 1); RS_STEP(1, 2); RS_STEP(1, 3);
#undef RS_STEP
        const int dir = rb >> 1;
        bf16* op = kvs + (((size_t)(bh * 64 + c) * 2 + dir) * 64) * 128;
#pragma unroll
        for (int r = 0; r < 16; ++r) { const int dk = 32 * (rb & 1) + crow(r, hi);
            op[dk * 128 + (2 * cg2) * 32 + r32] = (bf16)(cvtpk(acc0[r], 0.f) & 0xffffu);
            op[dk * 128 + (2 * cg2 + 1) * 32 + r32] = (bf16)(cvtpk(acc1[r], 0.f) & 0xffffu); }
        __syncthreads();
    }
#undef RS_LOAD
}

__device__ __forceinline__ void ret_main_phase(bf16* __restrict__ proj, const bf16* __restrict__ kvs, const float* __restrict__ gnw, const float* __restrict__ dl_f, const float* __restrict__ dl_b, int bid, int G, char* lds) {
    const int tid = fresh_tid(), wid = tid >> 6, lane = tid & 63, r32 = lane & 31, hi = lane >> 5;
    char* KT = lds;
    char* VT = lds + 32768;
    const unsigned koff = (unsigned)((tid >> 3) * PITCH + (tid & 7) * 8) * 2u, voff = (unsigned)((tid >> 4) * PITCH + (tid & 15) * 8) * 2u;
    const int c = wid >> 2, iloc = 32 * (wid & 3) + r32;
    const unsigned qoff = (unsigned)((128 * c + iloc) * PITCH + hi * 8) * 2u;
    const int vb0 = (int)(uintptr_t)VT + v_rd_base(lane);
    u32x4 kreg[4], vreg[8]; bf16x8 qr[4];
#define RM_LOAD(U) do { const int bh_ = (U) >> 5, cp_ = (U) & 31, b_ = bh_ >> 3, h_ = bh_ & 7; const size_t row0_ = (size_t)b_ * SEQ + (size_t)cp_ * 256; \
        const char* kbase_ = (const char*)(proj + row0_ * PITCH + C_RK + h_ * 64); const char* vbase_ = (const char*)(proj + row0_ * PITCH + C_RV + h_ * 128); \
        const char* qbase_ = (const char*)(proj + row0_ * PITCH + C_RQ + h_ * 64); \
        _Pragma("unroll") for (int i = 0; i < 4; ++i) kreg[i] = *(const u32x4*)(uptr(kbase_ + (size_t)i * (64 * PITCH * 2)) + koff); \
        _Pragma("unroll") for (int i = 0; i < 8; ++i) vreg[i] = *(const u32x4*)(uptr(vbase_ + (size_t)i * (32 * PITCH * 2)) + voff); \
        _Pragma("unroll") for (int d0 = 0; d0 < 4; ++d0) qr[d0] = *(const bf16x8*)(uptr(qbase_ + d0 * 32) + qoff); } while (0)
    int u = bid;
    if (u < 1024) RM_LOAD(u);
    for (; u < 1024; u += G) {
        const int bh = u >> 5, cp = u & 31, b = bh >> 3, h = bh & 7;
        const float lgf2 = -log1pf(expf(-dl_f[h])) * LOG2E, lgb2 = -log1pf(expf(-dl_b[h])) * LOG2E;
        const size_t row0 = (size_t)b * SEQ + (size_t)cp * 256;
        int iloc_l = iloc, hi_l = hi; asm volatile("" : "+v"(iloc_l), "+v"(hi_l));
#pragma unroll
        for (int i = 0; i < 4; ++i) { const int key = (tid >> 3) + 64 * i, ch = tid & 7; *(u32x4*)(KT + key * 128 + ((ch ^ (key & 7)) << 4)) = kreg[i]; }
#pragma unroll
        for (int i = 0; i < 8; ++i) { const int key = (tid >> 4) + 32 * i, ch = tid & 15; *(u32x4*)(VT + (key >> 6) * 16384 + v_st(key & 63, ch * 8)) = vreg[i]; }
        __syncthreads();
        u32x4 sreg[8];
        { const char* sbase = (const char*)(kvs + (size_t)(bh * 64 + 2 * cp) * (128 * 128));
#pragma unroll
          for (int i = 0; i < 8; ++i) sreg[i] = *(const u32x4*)(uptr(sbase + (size_t)i * 8192) + (unsigned)tid * 16u); }
        f32x16 o[4] = {};
#pragma unroll
        for (int kt = 0; kt < 2; ++kt) {
            const int T = 2 * c + kt;
            f32x16 p0 = {}, p1 = {};
#pragma unroll
            for (int d0 = 0; d0 < 4; ++d0) { const int ch = d0 * 2 + hi; const int k0 = T * 64 + r32, k1 = k0 + 32;
                const bf16x8 b0 = *(const bf16x8*)(KT + k0 * 128 + ((ch ^ (k0 & 7)) << 4));
                const bf16x8 b1 = *(const bf16x8*)(KT + k1 * 128 + ((ch ^ (k1 & 7)) << 4));
                p0 = __builtin_amdgcn_mfma_f32_32x32x16_bf16(b0, qr[d0], p0, 0, 0, 0);
                p1 = __builtin_amdgcn_mfma_f32_32x32x16_bf16(b1, qr[d0], p1, 0, 0, 0); }
#pragma unroll
            for (int r = 0; r < 16; ++r) {
                const int j0 = 64 * kt + crow(r, hi_l), d0_ = iloc_l - j0, d1_ = d0_ - 32;
                const float e0 = (d0_ >= 0 ? lgf2 : -lgb2) * (float)d0_;
                const float e1 = (d1_ >= 0 ? lgf2 : -lgb2) * (float)d1_;
                p0[r] *= __builtin_amdgcn_exp2f(e0); p1[r] *= __builtin_amdgcn_exp2f(e1);
            }
            bf16x8 pa0, pa1, pa2, pa3;
            PK4(p0, 0, pa0); PK4(p0, 8, pa1); PK4(p1, 0, pa2); PK4(p1, 8, pa3);
            pv_d0(o, vb0 + T * 16384, pa0, pa1, pa2, pa3);
        }
        __syncthreads();
#pragma unroll
        for (int i = 0; i < 8; ++i) { const int trow = (tid >> 4) + 32 * i, ch = tid & 15, tile = trow >> 6, dk = trow & 63;
            *(u32x4*)(VT + tile * 16384 + v_st(dk, ch * 8)) = sreg[i]; }
        __syncthreads();
#pragma unroll
        for (int dir = 0; dir < 2; ++dir) {
            const float dec = dir == 0 ? __builtin_amdgcn_exp2f(lgf2 * (float)(iloc_l + 1)) : __builtin_amdgcn_exp2f(lgb2 * (float)(128 - iloc_l));
            bf16x8 pa[4];
#pragma unroll
            for (int k = 0; k < 4; ++k) { const u32x4 w = *reinterpret_cast<const u32x4*>(&qr[k]); u32x4 o4;
#pragma unroll
                for (int q = 0; q < 4; ++q) o4[q] = cvtpk(bf_lo(w[q]) * dec, bf_hi(w[q]) * dec);
                pa[k] = *reinterpret_cast<bf16x8*>(&o4); }
            pv_d0(o, vb0 + (2 * c + dir) * 16384, pa[0], pa[1], pa[2], pa[3]);
        }
        if (u + G < 1024) RM_LOAD(u + G);
        __syncthreads();
        char* stg = VT + wid * 8192;
        float gw[4];
#pragma unroll
        for (int d0 = 0; d0 < 4; ++d0) gw[d0] = gnw[h * 128 + d0 * 32 + r32];
#pragma unroll
        for (int r = 0; r < 16; ++r) {
            float s1 = (o[0][r] + o[1][r]) + (o[2][r] + o[3][r]);
            float s2 = (o[0][r] * o[0][r] + o[1][r] * o[1][r]) + (o[2][r] * o[2][r] + o[3][r] * o[3][r]);
            s1 += swz_xor<1>(s1); s2 += swz_xor<1>(s2); s1 += swz_xor<2>(s1); s2 += swz_xor<2>(s2); s1 += swz_xor<4>(s1); s2 += swz_xor<4>(s2);
            s1 += swz_xor<8>(s1); s2 += swz_xor<8>(s2); s1 += swz_xor<16>(s1); s2 += swz_xor<16>(s2);
            const float mu = s1 * (1.f / 128.f), var = fmaxf(s2 * (1.f / 128.f) - mu * mu, 0.f), rs = __builtin_amdgcn_rsqf(var + EPS);
            bf16* sp = (bf16*)(stg + crow(r, hi_l) * 256) + r32;
#pragma unroll
            for (int d0 = 0; d0 < 4; ++d0) sp[d0 * 32] = (bf16)(cvtpk((o[d0][r] - mu) * rs * gw[d0], 0.f) & 0xffffu);
        }
        { const char* gbase = (const char*)(proj + (row0 + 128 * c + 32 * (wid & 3)) * PITCH + C_RG + h * 128);
          const unsigned goff = (unsigned)((lane >> 4) * PITCH + (lane & 15) * 8) * 2u;
          u32x4 gv[8];
#pragma unroll
          for (int k = 0; k < 8; ++k) gv[k] = *(const u32x4*)(uptr(gbase + (size_t)k * (4 * PITCH * 2)) + goff);
#pragma unroll
          for (int k = 0; k < 8; ++k) {
              const u32x4 nv = *(const u32x4*)(stg + (4 * k + (lane >> 4)) * 256 + (lane & 15) * 16);
              u32x4 ov;
#pragma unroll
              for (int q = 0; q < 4; ++q) ov[q] = cvtpk(bf_lo(nv[q]) * bf_lo(gv[k][q]), bf_hi(nv[q]) * bf_hi(gv[k][q]));
              *(u32x4*)((char*)uptr(gbase + (size_t)k * (4 * PITCH * 2)) + goff) = ov;
          } }
        __syncthreads();
    }
#undef RM_LOAD
}

__global__ void __launch_bounds__(NTHREADS) fwd_megakernel(Params p) {
    extern __shared__ __attribute__((aligned(16))) unsigned char lds[];
    cg::grid_group grid = cg::this_grid();
    const int G = gridDim.x, bid = blockIdx.x;
    const int NGW = G * NWAVES; const long NGT = (long)G * NTHREADS;
#define PHASE_IDS() const int tid = fresh_tid(), lane = tid & 63, wave = tid >> 6, gw = bid * NWAVES + wave; const long gt = (long)bid * NTHREADS + tid; (void)lane; (void)gw; (void)gt
    unsigned char* ws = p.ws;
    const float* x = p.in[0]; const float* cvec = p.in[1]; const int* positions = (const int*)p.in[2];
    const float* norm_w = p.in[3]; const float* w_ada = p.in[4]; const float* b_ada = p.in[5]; const float* w_in = p.in[6];
    const float* dl_f = p.in[7]; const float* dl_b = p.in[8]; const float* gn_w = p.in[9];
    const float* q_norm_w = p.in[10]; const float* w_uq = p.in[11]; const float* kv_norm_w = p.in[12]; const float* w_ukv = p.in[13];
    const float* qn_nope_w = p.in[14]; const float* qn_rope_w = p.in[15]; const float* kn_nope_w = p.in[16]; const float* kn_rope_w = p.in[17];
    const float* mla_norm_w = p.in[18]; const float* w_out = p.in[19];
    bf16* PROJ = (bf16*)(ws + WS_PROJ); bf16* KB = (bf16*)(ws + WS_K); bf16* VB = (bf16*)(ws + WS_V);
    bf16* WIN = (bf16*)(ws + WS_WIN); bf16* WQ = (bf16*)(ws + WS_WQ); bf16* WKV = (bf16*)(ws + WS_WKV); bf16* WO = (bf16*)(ws + WS_WO);
    float* CS64 = (float*)(ws + WS_CS64); float* CS32 = (float*)(ws + WS_CS32); float* MOD = (float*)(ws + WS_MOD); f32x2* STAT = (f32x2*)(ws + WS_STAT);
    float* SSB = (float*)(ws + WS_SS);
    bf16* HB = (bf16*)p.out; bf16* QO = (bf16*)((unsigned char*)p.out + OUT_QO); bf16* KVS = (bf16*)((unsigned char*)p.out + OUT_KVS);

    if (threadIdx.x < 4) ((volatile LAS unsigned*)((LAS unsigned char*)lds + LDS_CTL_OFF))[threadIdx.x] = 0u;
    __syncthreads();
    const XcdBarrier xbar = xcd_barrier_post((unsigned*)(ws + WS_BAR), (volatile LAS unsigned*)((LAS unsigned char*)lds + LDS_CTL_OFF));
#define GRID_BAR() xcd_barrier(xbar)
    {
        PHASE_IDS();
        float* sc = (float*)lds; float* red = (float*)(lds + 16384);
        for (int it = bid; it < 192; it += G) {
            for (int i = tid; i < 4096; i += NTHREADS) sc[i] = silu_f(cvec[i]);
            __syncthreads();
            const int ks4 = lane >> 4, col = lane & 15, kb0 = wave * 128 + ks4 * 32;
            const float* wp = w_ada + (size_t)kb0 * 3072 + it * 16 + col;
            float a0 = 0.f, a1 = 0.f, a2 = 0.f, a3 = 0.f;
#pragma unroll 8
            for (int i = 0; i < 32; ++i) { const float wv = wp[(size_t)i * 3072]; const int k = kb0 + i;
                a0 += sc[k] * wv; a1 += sc[1024 + k] * wv; a2 += sc[2048 + k] * wv; a3 += sc[3072 + k] * wv; }
            a0 += __shfl_xor(a0, 16); a0 += __shfl_xor(a0, 32); a1 += __shfl_xor(a1, 16); a1 += __shfl_xor(a1, 32);
            a2 += __shfl_xor(a2, 16); a2 += __shfl_xor(a2, 32); a3 += __shfl_xor(a3, 16); a3 += __shfl_xor(a3, 32);
            if (lane < 16) { red[(wave * 4 + 0) * 16 + lane] = a0; red[(wave * 4 + 1) * 16 + lane] = a1; red[(wave * 4 + 2) * 16 + lane] = a2; red[(wave * 4 + 3) * 16 + lane] = a3; }
            __syncthreads();
            if (tid < 64) { const int bb = tid >> 4, l = tid & 15; float s = b_ada[it * 16 + l];
#pragma unroll
                for (int w = 0; w < 8; ++w) s += red[(w * 4 + bb) * 16 + l];
                MOD[bb * 3072 + it * 16 + l] = s; }
            __syncthreads();
        }
    }
    grid.sync();
#if PROBE_DUP == 4
    for (int rep_ = 0; rep_ < 2; ++rep_)
#endif
    {
    {
        PHASE_IDS();
        constexpr long I1 = 4864L * 128, I2 = 768L * 48, I3 = 1536L * 32, I4 = 1024L * 256;
        for (long it = gt; it < I1 + I2 + I3 + I4; it += NGT) {
            long r = it; const float* W; const float* ksc = nullptr; int n, kc, Kd, No, oc; bf16* WT;
            if (r < I1) { n = (int)(r % 4864); kc = (int)(r / 4864); W = w_in; Kd = 1024; No = D_IN; oc = win_colmap(n); WT = WIN; }
            else if ((r -= I1) < I2) { n = (int)(r % 768); kc = (int)(r / 768); W = w_uq; Kd = 384; No = 768; oc = wq_colmap(n); WT = WQ; ksc = q_norm_w; }
            else if ((r -= I2) < I3) { n = (int)(r % 1536); kc = (int)(r / 1536); W = w_ukv; Kd = 256; No = 1536; oc = wkv_colmap(n); WT = WKV; ksc = kv_norm_w; }
            else { r -= I3; n = (int)(r % 1024); kc = (int)(r / 1024); W = w_out; Kd = 2048; No = 1024; oc = n; WT = WO; }
            float v[8];
#pragma unroll
            for (int i = 0; i < 8; ++i) { const int k = kc * 8 + i; const int ks_ = (W == w_out) ? (k < 1024 ? k + 1024 : k - 1024) : k;
                float t = oc >= 0 ? W[(size_t)ks_ * No + oc] : 0.f; if (ksc) t *= ksc[k]; v[i] = t; }
            u32x4 w; w.x = cvtpk(v[0], v[1]); w.y = cvtpk(v[2], v[3]); w.z = cvtpk(v[4], v[5]); w.w = cvtpk(v[6], v[7]);
            *(u32x4*)(WT + (size_t)n * Kd + kc * 8) = w;
        }
        for (long it = gt; it < (long)M * 48; it += NGT) {
            const int m = (int)(it / 48), i = (int)(it % 48);
            const float pos = (float)positions[m];
            const float fe = i < 32 ? (float)(2 * i) * (1.f / 64.f) : (float)(2 * (i - 32)) * (1.f / 32.f);
            const float invf = exp2f(-fe * 13.287712379549449f);
            const float ang = pos * invf;
            double rev = (double)ang * 0.15915494309189535; rev -= floor(rev);
            const float rf = (float)rev;
            const float cs = __builtin_amdgcn_cosf(rf), sn = __builtin_amdgcn_sinf(rf);
            float* dst = i < 32 ? CS64 + ((size_t)m * 32 + i) * 2 : CS32 + ((size_t)m * 16 + (i - 32)) * 2;
            *(f32x2*)dst = (f32x2){cs, sn};
        }
    }
    { PHASE_IDS();
    for (int m0 = gw; m0 < M; m0 += 2 * NGW) {
        const int m1 = m0 + NGW; const bool has1 = m1 < M;
        const f32x4* xr0 = (const f32x4*)(x + (size_t)m0 * DM) + lane; const f32x4* xr1 = (const f32x4*)(x + (size_t)(has1 ? m1 : m0) * DM) + lane;
        f32x4 v0[4], v1[4]; float s0 = 0.f, s1 = 0.f;
#pragma unroll
        for (int j = 0; j < 4; ++j) { v0[j] = xr0[64 * j]; v1[j] = xr1[64 * j]; }
#pragma unroll
        for (int j = 0; j < 4; ++j) { s0 += (v0[j].x * v0[j].x + v0[j].y * v0[j].y) + (v0[j].z * v0[j].z + v0[j].w * v0[j].w);
                                      s1 += (v1[j].x * v1[j].x + v1[j].y * v1[j].y) + (v1[j].z * v1[j].z + v1[j].w * v1[j].w); }
        const float rstd0 = __builtin_amdgcn_rsqf(wave_sum(s0) * (1.f / DM) + EPS), rstd1 = __builtin_amdgcn_rsqf(wave_sum(s1) * (1.f / DM) + EPS);
        const int b0 = m0 / SEQ, b1 = (has1 ? m1 : m0) / SEQ;
        u32x2* o80 = (u32x2*)(HB + (size_t)m0 * DM) + lane; u32x2* o81 = (u32x2*)(HB + (size_t)m1 * DM) + lane;
#pragma unroll
        for (int j = 0; j < 4; ++j) {
            const int col = 4 * lane + 256 * j;
            const f32x4 nw = *(const f32x4*)(norm_w + col);
            { const f32x4 sh = *(const f32x4*)(MOD + b0 * 3072 + col), scl = *(const f32x4*)(MOD + b0 * 3072 + 1024 + col);
              const f32x4 hv = v0[j] * rstd0 * nw * (scl + 1.f) + sh; o80[64 * j] = (u32x2){cvtpk(hv.x, hv.y), cvtpk(hv.z, hv.w)}; }
            if (has1) { const f32x4 sh = *(const f32x4*)(MOD + b1 * 3072 + col), scl = *(const f32x4*)(MOD + b1 * 3072 + 1024 + col);
              const f32x4 hv = v1[j] * rstd1 * nw * (scl + 1.f) + sh; o81[64 * j] = (u32x2){cvtpk(hv.x, hv.y), cvtpk(hv.z, hv.w)}; }
        }
    } }
    }
    GRID_BAR();

    {
        pg8::Gemm g{HB, WIN, M, PITCH, DM, DM}; pg8::StaticOrder S; S.init(M, PITCH, G, bid);
        EpiIn E{PROJ, CS64};
        pg8::gemm_phase<EpiIn, pg8::StaticOrder>((LAS unsigned char*)lds, g, S, E);
    }
    GRID_BAR();

#if PROBE_DUP == 1
    for (int rep_ = 0; rep_ < 2; ++rep_)
#endif
    {
    { PHASE_IDS();
    const int sub = lane >> 4, l16 = lane & 15;
    for (int m0 = gw * 4; m0 < M; m0 += NGW * 4) {
        const int m = m0 + sub, b = m / SEQ, s = m - b * SEQ;
        const bf16* pr = PROJ + (size_t)m * PITCH + C_CQ + 8 * l16;
        u32x4 v[6];
#pragma unroll
        for (int i = 0; i < 5; ++i) v[i] = *(const u32x4*)(pr + 128 * i);
        v[5] = (u32x4){0u, 0u, 0u, 0u}; if (l16 < 4) v[5] = *(const u32x4*)(pr + 640);
        float s_cq = sumsq8(v[0]) + sumsq8(v[1]) + sumsq8(v[2]);
        float s_ckv = sumsq8(v[3]) + sumsq8(v[4]);
        float s_kr = sumsq8(v[5]);
#pragma unroll
        for (int ofs = 1; ofs < 16; ofs <<= 1) { s_cq += __shfl_xor(s_cq, ofs); s_ckv += __shfl_xor(s_ckv, ofs); s_kr += __shfl_xor(s_kr, ofs); }
        if (l16 == 0) STAT[m] = (f32x2){s_cq * (1.f / 384.f), s_ckv * (1.f / 256.f)};
        const float rk = __builtin_amdgcn_rsqf(s_kr * (1.f / 32.f) + EPS);
        const u32x4 b2 = v[5];
        u32x4 pw; pw.x = __shfl_xor(b2.x, 2); pw.y = __shfl_xor(b2.y, 2); pw.z = __shfl_xor(b2.z, 2); pw.w = __shfl_xor(b2.w, 2);
        if (l16 < 2) {
            const int pb = 8 * l16;
            unsigned ow[8];
#pragma unroll
            for (int q = 0; q < 4; ++q) {
#pragma unroll
                for (int e = 0; e < 2; ++e) {
                    const int pidx = pb + 2 * q + e;
                    const float x1 = (e ? bf_hi(b2[q]) : bf_lo(b2[q])) * rk * kn_rope_w[pidx];
                    const float x2 = (e ? bf_hi(pw[q]) : bf_lo(pw[q])) * rk * kn_rope_w[pidx + 16];
                    const f32x2 csv = *(const f32x2*)(CS32 + ((size_t)m * 16 + pidx) * 2);
                    ow[2 * q + e] = cvtpk(x1 * csv.x - x2 * csv.y, x2 * csv.x + x1 * csv.y);
                }
            }
            const u32x4 w0 = {ow[0], ow[1], ow[2], ow[3]}, w1 = {ow[4], ow[5], ow[6], ow[7]};
#pragma unroll
            for (int hh = 0; hh < NH; ++hh) { bf16* kp = KB + ((size_t)(b * NH + hh) * SEQ + s) * 96 + 64 + 16 * l16;
                *(u32x4*)kp = w0; *(u32x4*)(kp + 8) = w1; }
        }
    } }
    ret_state_phase(PROJ, KVS, dl_f, dl_b, bid, G, (char*)lds);
    }
    GRID_BAR();

    { PHASE_IDS();
    for (long it = gt; it < 32L * 2 * 2048; it += NGT) {
        const int e4 = (int)(it & 2047), dir = (int)((it >> 11) & 1), bh = (int)(it >> 12), h = bh & 7;
        const float lg2 = -log1pf(expf(-(dir ? dl_b[h] : dl_f[h]))) * LOG2E;
        const float gC = __builtin_amdgcn_exp2f(lg2 * 128.f);
        float s0 = 0.f, s1 = 0.f, s2 = 0.f, s3 = 0.f;
        for (int i = 0; i < 64; ++i) {
            const int c = dir ? 63 - i : i;
            u32x2* ptr = (u32x2*)(KVS + (((size_t)(bh * 64 + c) * 2 + dir) * 8192) + 4 * e4);
            const u32x2 kv = *ptr;
            *ptr = (u32x2){cvtpk(s0, s1), cvtpk(s2, s3)};
            s0 = s0 * gC + bf_lo(kv.x); s1 = s1 * gC + bf_hi(kv.x); s2 = s2 * gC + bf_lo(kv.y); s3 = s3 * gC + bf_hi(kv.y);
        }
    } }
#if PROBE_DUP == 2
    for (int rep_ = 0; rep_ < 2; ++rep_)
#endif
    {
    {
        pg8::Gemm g{PROJ + C_CQ, WQ, M, 768, 384, PITCH}; pg8::StaticOrder S; S.init(M, 768, G, G - 1 - bid);
        EpiUp<3> E{QO, nullptr, STAT, qn_nope_w, qn_rope_w, CS32};
        pg8::gemm_phase<EpiUp<3>, pg8::StaticOrder>((LAS unsigned char*)lds, g, S, E);
    }
    {
        pg8::Gemm g{PROJ + C_CKV, WKV, M, 1536, 256, PITCH}; pg8::StaticOrder S; S.init(M, 1536, G, bid);
        EpiUp<2> E{KB, VB, STAT, kn_nope_w, nullptr, nullptr};
        pg8::gemm_phase<EpiUp<2>, pg8::StaticOrder>((LAS unsigned char*)lds, g, S, E);
    }
    }
    GRID_BAR();

    for (int i = 0; i * G < 1024; ++i) {
        int u = i * G + bid; if (u >= 1024) break;
        int bh, qb;
        if (G == 256) { bh = (bid & 7) * 4 + i; qb = bid >> 3; } else { bh = u >> 5; qb = u & 31; }
        bf16* qo = QO + ((size_t)bh * SEQ + (size_t)qb * 256) * 128;
        { const int b_ = bh >> 3, h_ = bh & 7; const size_t row_ = (size_t)b_ * SEQ + (size_t)qb * 256;
          attn_unit(qo, KB + (size_t)bh * SEQ * 96, VB + (size_t)bh * SEQ * 128, SEQ, (char*)lds,
                    PROJ + row_ * PITCH + C_MG + h_ * 128, SSB + row_ * 8 + h_, mla_norm_w + h_ * 128); }
        __syncthreads();
    }
    ret_main_phase(PROJ, KVS, gn_w, dl_f, dl_b, bid, G, (char*)lds);
    GRID_BAR();

    {
        pg8::Gemm g{PROJ + C_MG, WO, M, DM, 2048, PITCH}; pg8::StaticOrder S; S.init(M, DM, G, bid);
        EpiOut E{x, p.out, MOD, SSB};
        pg8::gemm_phase<EpiOut, pg8::StaticOrder>((LAS unsigned char*)lds, g, S, E);
    }
}

extern "C" void kernel_launch(void* const* d_in, const int* in_sizes, int n_in, void* d_out, int out_size, void* d_ws, size_t ws_size, hipStream_t stream) {
    static int grid_blocks = 0;
    if (grid_blocks == 0) {
        if (n_in != 20 || out_size != M * DM || ws_size < WS_END) { fprintf(stderr, "kernel_launch: unexpected shapes (n_in %d out %d ws %zu)\n", n_in, out_size, ws_size); grid_blocks = -1; return; }
        int dev = 0, cus = 0, per_cu = 0;
        hipGetDevice(&dev);
        hipDeviceGetAttribute(&cus, hipDeviceAttributeMultiprocessorCount, dev);
        if (hipFuncSetAttribute((const void*)fwd_megakernel, hipFuncAttributeMaxDynamicSharedMemorySize, LDS_BYTES) != hipSuccess) { fprintf(stderr, "kernel_launch: hipFuncSetAttribute failed\n"); grid_blocks = -1; return; }
        if (hipOccupancyMaxActiveBlocksPerMultiprocessor(&per_cu, (const void*)fwd_megakernel, NTHREADS, LDS_BYTES) != hipSuccess || per_cu < 1) { fprintf(stderr, "kernel_launch: occupancy query failed (%d)\n", per_cu); per_cu = 1; }
        (void)hipGetLastError();
        grid_blocks = cus * per_cu;
    }
    if (grid_blocks < 0) return;
    if (hipMemsetAsync((char*)d_ws + WS_BAR, 0, XCD_BAR_WORDS * 4, stream) != hipSuccess) { fprintf(stderr, "kernel_launch: memset failed\n"); return; }
    Params p{};
    for (int i = 0; i < 20; ++i) p.in[i] = (const float*)d_in[i];
    p.out = (float*)d_out; p.ws = (unsigned char*)d_ws;
    void* args[] = {&p};
    hipError_t e = hipLaunchCooperativeKernel((const void*)fwd_megakernel, dim3(grid_blocks), dim3(NTHREADS), args, LDS_BYTES, stream);
    if (e != hipSuccess) fprintf(stderr, "cooperative launch failed: %s (grid %d)\n", hipGetErrorString(e), grid_blocks);
}
```

```cpp
#ifndef PROBE_DUP
#define PROBE_DUP 0
#endif
#include <hip/hip_runtime.h>
#include <hip/hip_cooperative_groups.h>
#include <cstdio>
#include <cstdint>
namespace cg = cooperative_groups;

namespace pg8 {
#define PG8_LAS __attribute__((address_space(3)))
typedef unsigned short bf16_t;
typedef short bf16x8 __attribute__((ext_vector_type(8)));
typedef float f32x4 __attribute__((ext_vector_type(4)));
typedef unsigned u32x4 __attribute__((ext_vector_type(4)));
constexpr int BM = 256, BK = 64, HALF = 128, HTB = HALF * BK * 2, STAGE_BYTES = 8 * HTB, NXCD = 8, WGM = 8;

__host__ __device__ __forceinline__ int lds_byte(int r, int c) { const int st = (r >> 4) * 2 + (c >> 5), rr = r & 15, cc = c & 31, ob = rr * 64 + cc * 2; return st * 1024 + (ob ^ (((ob >> 9) & 1) << 5)); }
__host__ __device__ __forceinline__ void stage_rc(int b, int& R, int& C) { const int st = b / 1024, sb = b % 1024, swz = sb ^ (((sb >> 9) & 1) << 5); R = (st >> 1) * 16 + swz / 64; C = (st & 1) * 32 + (swz % 64) / 2; }
__host__ __device__ __forceinline__ int perm32(int rho) { const int n = rho >> 4, i = rho & 15; return 8 * (i >> 2) + 4 * n + (i & 3); }

struct Unit { int pm, pn; };
struct Gemm { const bf16_t* A; const bf16_t* Bt; int M, N, K, lda; };

struct StaticOrder {
    int nM, nN, nwg, G, c;
    __host__ __device__ void init(int M, int N, int G_, int c_) { nM = M / BM; nN = N / BM; nwg = nM * nN; G = G_; c = c_; }
    __host__ __device__ bool next(int i, Unit& u) const {
        const long L = (long)i * G + c; if (L >= nwg) return false;
        int wgid = (int)L; { const int q = nwg / NXCD, r = nwg % NXCD, xcd = wgid % NXCD, off = wgid / NXCD; wgid = (xcd < r ? xcd * (q + 1) : r * (q + 1) + (xcd - r) * q) + off; }
        const int nig = WGM * nN, gid = wgid / nig, fm = gid * WGM, gsz = (nM - fm) < WGM ? (nM - fm) : WGM;
        u.pm = fm + ((wgid % nig) % gsz); u.pn = (wgid % nig) / gsz; return true;
    }
};

typedef float f32x2_c __attribute__((ext_vector_type(2)));
typedef __bf16 bf16x2_c __attribute__((ext_vector_type(2)));
__device__ __forceinline__ unsigned cvt_pk_bf16(float lo, float hi) { const f32x2_c v = {lo, hi}; return __builtin_bit_cast(unsigned, __builtin_convertvector(v, bf16x2_c)); }

template <class Epi, class Sched>
__device__ __forceinline__ void gemm_phase(PG8_LAS unsigned char* lds, const Gemm g, const Sched& S, const Epi& E) {
    int tid_ = threadIdx.x; asm volatile("" : "+v"(tid_));
    const int tid = tid_, wid = __builtin_amdgcn_readfirstlane(tid >> 6), lane = tid & 63, wr = wid >> 2, wc = wid & 3, fr = lane & 15, fq = lane >> 4;
    const int K = g.K, nt = K / BK, lda = g.lda;
    unsigned voffA[2], voffB[2];
#pragma unroll
    for (int i = 0; i < 2; ++i) { int R, C; stage_rc(tid * 16 + i * 8192, R, C); const int Rb = Epi::PERM ? ((R & ~31) + perm32(R & 31)) : R;
        voffA[i] = (unsigned)(R * lda + C) * 2u; voffB[i] = (unsigned)(Rb * K + C) * 2u; }
    const size_t kstep = (size_t)(BK * 2);
    const size_t hstepA = (size_t)HALF * lda * 2, hstepB = (size_t)HALF * K * 2;
    const size_t tstepA = 2 * hstepA, tstepB = 2 * hstepB;
    const unsigned ldsw = (unsigned)wid * 1024u;
    const int aoff = lds_byte(wr * 64 + fr, fq * 8), boff = lds_byte(wc * 32 + fr, fq * 8);
#define PG8_SA(b, h) (((b) * 2 + (h)) * HTB)
#define PG8_SB(b, h) ((4 + (b) * 2 + (h)) * HTB)
#define PG8_STAGE(bufoff, gbase, voff) do { _Pragma("unroll") for (int _i = 0; _i < 2; ++_i) \
        __builtin_amdgcn_global_load_lds((const unsigned*)((const char*)(gbase) + (voff)[_i]), (PG8_LAS unsigned*)(lds + (bufoff) + ldsw + _i * 8192), 16, 0, 0); } while (0)
#define PG8_LDA(dst, b, h) do { _Pragma("unroll") for (int m = 0; m < 4; ++m) _Pragma("unroll") for (int k = 0; k < 2; ++k) dst[m][k] = *(const PG8_LAS bf16x8*)(lds + PG8_SA(b, h) + aoff + m * 2048 + k * 1024); } while (0)
#define PG8_LDB(dst, b, h) do { _Pragma("unroll") for (int n = 0; n < 2; ++n) _Pragma("unroll") for (int k = 0; k < 2; ++k) dst[n][k] = *(const PG8_LAS bf16x8*)(lds + PG8_SB(b, h) + boff + n * 2048 + k * 1024); } while (0)
#define PG8_MMA(ai, bj, At, Bt) do { __builtin_amdgcn_s_setprio(1); _Pragma("unroll") for (int m = 0; m < 4; ++m) _Pragma("unroll") for (int n = 0; n < 2; ++n) _Pragma("unroll") for (int k = 0; k < 2; ++k) \
        acc[ai][bj][m][n] = __builtin_amdgcn_mfma_f32_16x16x32_bf16(Bt[n][k], At[m][k], acc[ai][bj][m][n], 0, 0, 0); __builtin_amdgcn_s_setprio(0); } while (0)
#define PG8_WAIT_V(n) asm volatile("s_waitcnt vmcnt(" #n ")" ::: "memory")
#define PG8_WAIT_L(n) asm volatile("s_waitcnt lgkmcnt(" #n ")" ::: "memory")
#define PG8_BAR __builtin_amdgcn_s_barrier()
#define PG8_SCHED __builtin_amdgcn_sched_barrier(0)
    Unit cur, nxt; int ui = 0;
    if (!S.next(0, cur)) return;
    f32x4 acc[2][2][4][2];
#pragma unroll
    for (int a = 0; a < 2; ++a)
#pragma unroll
        for (int b = 0; b < 2; ++b)
#pragma unroll
            for (int m = 0; m < 4; ++m)
#pragma unroll
                for (int n = 0; n < 2; ++n) acc[a][b][m][n] = (f32x4){0.f, 0.f, 0.f, 0.f};
    bf16x8 At[4][2], B0[2][2], B1[2][2];
    const char* cA = (const char*)g.A + (size_t)cur.pm * tstepA; const char* cB = (const char*)g.Bt + (size_t)cur.pn * tstepB;
    PG8_STAGE(PG8_SB(0, 0), cB, voffB); PG8_STAGE(PG8_SB(0, 1), cB + hstepB, voffB); PG8_STAGE(PG8_SA(0, 0), cA, voffA); PG8_STAGE(PG8_SA(0, 1), cA + hstepA, voffA);
    if (wr == 1) PG8_BAR;
    PG8_WAIT_V(2); PG8_BAR;
    PG8_STAGE(PG8_SB(1, 0), cB + kstep, voffB); PG8_STAGE(PG8_SA(1, 0), cA + kstep, voffA); PG8_STAGE(PG8_SB(1, 1), cB + hstepB + kstep, voffB);
    PG8_WAIT_V(6); PG8_BAR;
    for (;;) {
        const bool has_next = S.next(ui + 1, nxt);
        const char* nA = has_next ? (const char*)g.A + (size_t)nxt.pm * tstepA : cA; const char* nB = has_next ? (const char*)g.Bt + (size_t)nxt.pn * tstepB : cB;
#pragma unroll 1
        for (int t = 0; t < nt; t += 2) {
            if constexpr (Epi::MIDSCALE) { if (t == nt / 2) E.mid(acc, cur); }
            const bool last = (t == nt - 2);
            const char* a1 = cA + (size_t)(t + 1) * kstep;
            const char* a2 = last ? nA : cA + (size_t)(t + 2) * kstep; const char* b2 = last ? nB : cB + (size_t)(t + 2) * kstep;
            const char* a3 = a2 + kstep; const char* b3 = b2 + kstep;
            PG8_LDB(B0, 0, 0); PG8_LDB(B1, 0, 1); PG8_SCHED; PG8_LDA(At, 0, 0); PG8_STAGE(PG8_SA(1, 1), a1 + hstepA, voffA);
            PG8_WAIT_V(8); PG8_WAIT_L(0); PG8_BAR; PG8_MMA(0, 0, At, B0); PG8_MMA(0, 1, At, B1); PG8_BAR; PG8_SCHED;
            PG8_LDA(At, 0, 1); PG8_STAGE(PG8_SB(0, 0), b2, voffB); PG8_STAGE(PG8_SB(0, 1), b2 + hstepB, voffB); PG8_STAGE(PG8_SA(0, 0), a2, voffA);
            PG8_WAIT_V(8); PG8_WAIT_L(0); PG8_BAR; PG8_MMA(1, 0, At, B0); PG8_MMA(1, 1, At, B1); PG8_BAR; PG8_SCHED;
            PG8_LDB(B0, 1, 0); PG8_LDB(B1, 1, 1); PG8_SCHED; PG8_LDA(At, 1, 0); PG8_STAGE(PG8_SA(0, 1), a2 + hstepA, voffA);
            PG8_WAIT_V(8); PG8_WAIT_L(0); PG8_BAR; PG8_MMA(0, 0, At, B0); PG8_MMA(0, 1, At, B1); PG8_BAR; PG8_SCHED;
            PG8_LDA(At, 1, 1); PG8_STAGE(PG8_SB(1, 0), b3, voffB); PG8_STAGE(PG8_SB(1, 1), b3 + hstepB, voffB); PG8_STAGE(PG8_SA(1, 0), a3, voffA);
            PG8_WAIT_V(8); PG8_WAIT_L(0); PG8_BAR; PG8_MMA(1, 0, At, B0); PG8_MMA(1, 1, At, B1); PG8_BAR; PG8_SCHED;
        }
        if (wr == 0) PG8_BAR;
        E(acc, cur, wr, wc, fr, fq);
        if (!has_next) break;
#pragma unroll
        for (int a = 0; a < 2; ++a)
#pragma unroll
            for (int b = 0; b < 2; ++b)
#pragma unroll
                for (int m = 0; m < 4; ++m)
#pragma unroll
                    for (int n = 0; n < 2; ++n) acc[a][b][m][n] = (f32x4){0.f, 0.f, 0.f, 0.f};
        cur = nxt; cA = nA; cB = nB; ++ui;
        if (wr == 1) PG8_BAR;
    }
    PG8_WAIT_V(0);
    PG8_BAR;
#undef PG8_SA
#undef PG8_SB
#undef PG8_STAGE
#undef PG8_LDA
#undef PG8_LDB
#undef PG8_MMA
#undef PG8_WAIT_V
#undef PG8_WAIT_L
#undef PG8_BAR
#undef PG8_SCHED
}
}

typedef unsigned short bf16;
typedef short bf16x8 __attribute__((ext_vector_type(8)));
typedef short s16x4 __attribute__((ext_vector_type(4)));
typedef float f32x16 __attribute__((ext_vector_type(16)));
typedef float f32x4 __attribute__((ext_vector_type(4)));
typedef float f32x2 __attribute__((ext_vector_type(2)));
typedef unsigned u32x4 __attribute__((ext_vector_type(4)));
typedef unsigned u32x2 __attribute__((ext_vector_type(2)));
#define LAS __attribute__((address_space(3)))

constexpr int BATCH = 4, SEQ = 8192, DM = 1024, M = BATCH * SEQ, NH = 8;
constexpr int D_IN = 4768, PITCH = 4864;
constexpr int C_RQ = 0, C_RK = 512, C_RV = 1024, C_MG = 2048, C_RG = 3072, C_CQ = 4096, C_CKV = 4480, C_KR = 4736;
constexpr float EPS = 1e-6f;
constexpr float QSC = 0.10206207261596575f * 1.4426950408889634f;
constexpr float LOG2E = 1.4426950408889634f;
constexpr int NTHREADS = 512, NWAVES = 8;

constexpr size_t MiB = 1u << 20;
constexpr size_t WS_PROJ = 0;
constexpr size_t WS_K = 304 * MiB;
constexpr size_t WS_V = 352 * MiB;
constexpr size_t WS_WIN = 416 * MiB;
constexpr size_t WS_WQ = 426 * MiB;
constexpr size_t WS_WKV = 427 * MiB;
constexpr size_t WS_WO = 428 * MiB;
constexpr size_t WS_CS64 = 432 * MiB;
constexpr size_t WS_CS32 = 440 * MiB;
constexpr size_t WS_MOD = 444 * MiB;
constexpr size_t WS_STAT = 445 * MiB;
constexpr size_t WS_SS = 447 * MiB;
constexpr size_t WS_BAR = 446 * MiB;
constexpr size_t WS_END = 448 * MiB;
constexpr size_t OUT_QO = 0, OUT_KVS = 64 * MiB;

constexpr int LDS_BYTES = 135168;
constexpr int LDS_CTL_OFF = 133120;

struct Params { const float* in[20]; float* out; unsigned char* ws; };

__device__ __forceinline__ unsigned cvtpk(float lo, float hi) { return pg8::cvt_pk_bf16(lo, hi); }
__device__ __forceinline__ float bf_lo(unsigned w) { return __uint_as_float(w << 16); }
__device__ __forceinline__ float bf_hi(unsigned w) { return __uint_as_float(w & 0xffff0000u); }
__device__ __forceinline__ float wave_sum(float v) {
#pragma unroll
    for (int o = 1; o < 64; o <<= 1) v += __shfl_xor(v, o);
    return v;
}
__device__ __forceinline__ float silu_f(float v) { return v * __builtin_amdgcn_rcpf(1.f + __builtin_amdgcn_exp2f(-v * LOG2E)); }
__device__ __forceinline__ float sumsq8(u32x4 a) {
    float s = 0.f;
#pragma unroll
    for (int i = 0; i < 4; ++i) { const float x = bf_lo(a[i]), y = bf_hi(a[i]); s += x * x + y * y; }
    return s;
}

__device__ __forceinline__ int fresh_tid() { int t = threadIdx.x; asm volatile("" : "+v"(t)); return t; }
#define EPI_LANES() const int t_ = fresh_tid(), l_ = t_ & 63, wi_ = t_ >> 6, wr = wi_ >> 2, wc = wi_ & 3, fr = l_ & 15, fq = l_ >> 4


#define RLX_AGENT __ATOMIC_RELAXED, __HIP_MEMORY_SCOPE_AGENT
#define XB_TMO      128
#define XB_XCNT(j)  (256  + 64 * (j))
#define XB_XSUB(j)  (1280 + 64 * (j))
#define XB_XGEN(j)  (2304 + 64 * (j))
#define XB_TOP      3328
#define XB_TOPGEN   3392
#define XCD_BAR_WORDS 3456
#define XB_SPIN_CAP (1u << 18)

__device__ __forceinline__ unsigned xb_ld(unsigned* p)              { return __hip_atomic_load(p, __ATOMIC_RELAXED, __HIP_MEMORY_SCOPE_AGENT); }
__device__ __forceinline__ unsigned xb_add(unsigned* p, unsigned v) { return __hip_atomic_fetch_add(p, v, __ATOMIC_RELAXED, __HIP_MEMORY_SCOPE_AGENT); }
__device__ __forceinline__ unsigned xb_xcc_id() { return (unsigned)__builtin_amdgcn_s_getreg((3 << 11) | 20) & 0xFu; }
#define XB_SPIN(cond, bar) do { unsigned _sp = 0; while (cond) { __builtin_amdgcn_s_sleep(1); \
    if ((++_sp & 255u) == 0u) { if (xb_ld(&(bar)[XB_TMO])) break; if (_sp > XB_SPIN_CAP) { atomicAdd(&(bar)[XB_TMO], 1u); break; } } } } while (0)

struct XcdBarrier {
    unsigned* bar; unsigned x;
    volatile LAS unsigned* st;
};

__device__ __forceinline__ XcdBarrier xcd_barrier_post(unsigned* bar, volatile LAS unsigned* st) {
    XcdBarrier b; b.bar = bar; b.x = xb_xcc_id(); b.st = st;
    if (threadIdx.x == 0) (void)xb_add(&bar[XB_XCNT(b.x)], 1u);
    return b;
}
__device__ __forceinline__ void xcd_barrier_complete(unsigned* bar, unsigned x, unsigned& nloc, unsigned& nx) {
    const unsigned G = gridDim.x * gridDim.y * gridDim.z;
    unsigned sum, cnt, mine, sp = 0u;
    for (;;) {
        sum = 0u; cnt = 0u; mine = 0u;
#pragma unroll
        for (unsigned j = 0; j < 16; ++j) { const unsigned c = xb_ld(&bar[XB_XCNT(j)]); sum += c; cnt += (c > 0u) ? 1u : 0u; mine = (j == x) ? c : mine; }
        if (sum == G) break;
        __builtin_amdgcn_s_sleep(1);
        if ((++sp & 255u) == 0u) { if (xb_ld(&bar[XB_TMO])) break; if (sp > XB_SPIN_CAP) { atomicAdd(&bar[XB_TMO], 1u); break; } }
    }
    nloc = mine > 0u ? mine : 1u; nx = cnt > 0u ? cnt : 1u;
}

__device__ __forceinline__ void xcd_barrier(const XcdBarrier& b) {
    asm volatile("s_waitcnt vmcnt(0)" ::: "memory");
    __syncthreads();
    if (threadIdx.x == 0) {
        unsigned* bar = b.bar;
        __builtin_amdgcn_s_waitcnt(0);
        unsigned nloc = b.st[0], nx = b.st[1];
        if (nloc == 0u) { xcd_barrier_complete(bar, b.x, nloc, nx); b.st[0] = nloc; b.st[1] = nx; }
        const unsigned old = xb_add(&bar[XB_XSUB(b.x)], 1u);
        const unsigned gen = old / nloc;
        if (old + 1u == (gen + 1u) * nloc) {
            __builtin_amdgcn_fence(__ATOMIC_RELEASE, "agent");
            asm volatile("s_waitcnt vmcnt(0)" ::: "memory");
            const unsigned og = xb_add(&bar[XB_TOP], 1u);
            const unsigned tg = og / nx;
            if (og + 1u == (tg + 1u) * nx) xb_add(&bar[XB_TOPGEN], 1u);
            else XB_SPIN(xb_ld(&bar[XB_TOPGEN]) == tg, bar);
            __builtin_amdgcn_fence(__ATOMIC_ACQUIRE, "agent");
            xb_add(&bar[XB_XGEN(b.x)], 1u);
            asm volatile("s_waitcnt vmcnt(0)" ::: "memory");
        } else {
            XB_SPIN(xb_ld(&bar[XB_XGEN(b.x)]) == gen, bar);
            __builtin_amdgcn_fence(__ATOMIC_ACQUIRE, "agent");
            asm volatile("s_waitcnt vmcnt(0)" ::: "memory");
        }
    }
    __syncthreads();
}


__device__ __forceinline__ int win_colmap(int n) {
    if (n < 1024) { const int base = n & ~63, j = n & 63; return base + (j >> 1) + 32 * (j & 1); }
    if (n < 2048) return n;
    if (n < 3072) return 3744 + (n - 2048);
    if (n < 4096) return 2048 + (n - 3072);
    if (n < 4480) return 3072 + (n - 4096);
    if (n < 4736) return 3456 + (n - 4480);
    if (n < 4768) return 3712 + (n - 4736);
    return -1;
}
__device__ __forceinline__ int nope_map(int n, int per_head) {
    const int t = n >> 8, c = n & 255, bj = c >> 7, wc = (c >> 5) & 3, j = c & 31;
    return (4 * t + wc) * per_head + 32 * bj + j;
}
__device__ __forceinline__ int wq_colmap(int n) {
    if (n < 512) return nope_map(n, 96);
    const int c = n - 512, head = c >> 5, j = c & 31; return head * 96 + 64 + (j >> 1) + 16 * (j & 1);
}
__device__ __forceinline__ int wkv_colmap(int n) {
    if (n < 512) return nope_map(n, 192);
    const int c = n - 512, head = c >> 7, dim = c & 127; return head * 192 + 64 + dim;
}

struct EpiIn {
    static constexpr bool PERM = true, MIDSCALE = false;
    bf16* P; const float* cs64;
    __device__ __forceinline__ void operator()(const pg8::f32x4 (&acc)[2][2][4][2], const pg8::Unit& u, int, int, int, int) const {
        EPI_LANES();
        const int row0 = u.pm * 256 + wr * 64 + fr, colt = u.pn * 256, cl = wc * 32 + 8 * fq;
        const int mode = u.pn < 4 ? 1 : ((u.pn >= 8 && u.pn < 16) ? 2 : 0);
        const float rs = u.pn < 2 ? 1.f : 0.125f;
        const int p0 = (wc & 1) * 16 + 4 * fq;
        f32x4 n0 = {1.f, 0.f, 1.f, 0.f}, n1 = {1.f, 0.f, 1.f, 0.f};
        if (mode == 1) { const f32x4* t = (const f32x4*)(cs64 + ((size_t)row0 * 32 + p0) * 2); n0 = t[0]; n1 = t[1]; }
#pragma unroll
        for (int ai = 0; ai < 2; ++ai)
#pragma unroll
            for (int m = 0; m < 4; ++m) {
                const int row = row0 + ai * 128 + m * 16;
                bf16* rowp = P + (size_t)row * PITCH + colt + cl;
                const f32x4 c0 = n0, c1 = n1;
                if (mode == 1 && (ai * 4 + m) < 7) { const int rown = row0 + ((ai * 4 + m + 1) >> 2) * 128 + ((ai * 4 + m + 1) & 3) * 16;
                    const f32x4* t = (const f32x4*)(cs64 + ((size_t)rown * 32 + p0) * 2); n0 = t[0]; n1 = t[1]; }
#pragma unroll
                for (int bj = 0; bj < 2; ++bj) {
                    f32x4 v0 = acc[ai][bj][m][0], v1 = acc[ai][bj][m][1];
                    if (mode == 1) {
                        f32x4 o0, o1;
                        o0[0] = (v0[0] * c0[0] - v0[1] * c0[1]) * rs; o0[1] = (v0[1] * c0[0] + v0[0] * c0[1]) * rs;
                        o0[2] = (v0[2] * c0[2] - v0[3] * c0[3]) * rs; o0[3] = (v0[3] * c0[2] + v0[2] * c0[3]) * rs;
                        o1[0] = (v1[0] * c1[0] - v1[1] * c1[1]) * rs; o1[1] = (v1[1] * c1[0] + v1[0] * c1[1]) * rs;
                        o1[2] = (v1[2] * c1[2] - v1[3] * c1[3]) * rs; o1[3] = (v1[3] * c1[2] + v1[2] * c1[3]) * rs;
                        v0 = o0; v1 = o1;
                    } else if (mode == 2) {
#pragma unroll
                        for (int i = 0; i < 4; ++i) { v0[i] = silu_f(v0[i]); v1[i] = silu_f(v1[i]); }
                    }
                    u32x4 w; w.x = cvtpk(v0[0], v0[1]); w.y = cvtpk(v0[2], v0[3]); w.z = cvtpk(v1[0], v1[1]); w.w = cvtpk(v1[2], v1[3]);
                    *(u32x4*)(rowp + bj * 128) = w;
                }
                asm volatile("" ::: "memory");
            }
    }
};

template <int MODE> struct EpiUp {
    static constexpr bool IS_Q = MODE != 2, MIDSCALE = false;
    static constexpr bool PERM = true;
    bf16* O;
    bf16* Vo;
    const f32x2* stat;
    const float* wn;
    const float* wr_;
    const float* cs32;
    __device__ __forceinline__ void operator()(const pg8::f32x4 (&acc)[2][2][4][2], const pg8::Unit& u, int, int, int, int) const {
        EPI_LANES();
        const int row0 = u.pm * 256 + wr * 64 + fr;
        const int b = row0 / SEQ;
        constexpr int OP = IS_Q ? 128 : 96;
        float ms8[8];
#pragma unroll
        for (int i = 0; i < 8; ++i) { const f32x2 st = stat[row0 + (i >> 2) * 128 + (i & 3) * 16]; ms8[i] = IS_Q ? st.x : st.y; }
        if (MODE == 0 || ((MODE == 2 || MODE == 3) && u.pn < 2)) {
            const int head = 4 * u.pn + wc;
            const f32x4 w00 = *(const f32x4*)(wn + 8 * fq), w01 = *(const f32x4*)(wn + 8 * fq + 4), w10 = *(const f32x4*)(wn + 32 + 8 * fq), w11 = *(const f32x4*)(wn + 36 + 8 * fq);
#pragma unroll
            for (int ai = 0; ai < 2; ++ai)
#pragma unroll
                for (int m = 0; m < 4; ++m) {
                    const int row = row0 + ai * 128 + m * 16;
                    const f32x4 a0 = acc[ai][0][m][0], a1 = acc[ai][0][m][1], b0 = acc[ai][1][m][0], b1 = acc[ai][1][m][1];
                    float ss = 0.f;
#pragma unroll
                    for (int i = 0; i < 4; ++i) ss += a0[i] * a0[i] + a1[i] * a1[i] + b0[i] * b0[i] + b1[i] * b1[i];
                    ss += __shfl_xor(ss, 16); ss += __shfl_xor(ss, 32);
                    const float ms = ms8[ai * 4 + m];
                    const float sc = __builtin_amdgcn_rsqf(ss * (1.f / 64.f) + EPS * (ms + EPS)) * (IS_Q ? QSC : 1.f);
                    bf16* op = O + ((size_t)(b * NH + head) * SEQ + (row - b * SEQ)) * OP;
                    const f32x4 x0 = a0 * sc * w00, x1 = a1 * sc * w01, y0 = b0 * sc * w10, y1 = b1 * sc * w11;
                    u32x4 w; w.x = cvtpk(x0[0], x0[1]); w.y = cvtpk(x0[2], x0[3]); w.z = cvtpk(x1[0], x1[1]); w.w = cvtpk(x1[2], x1[3]);
                    *(u32x4*)(op + 8 * fq) = w;
                    w.x = cvtpk(y0[0], y0[1]); w.y = cvtpk(y0[2], y0[3]); w.z = cvtpk(y1[0], y1[1]); w.w = cvtpk(y1[2], y1[3]);
                    *(u32x4*)(op + 32 + 8 * fq) = w;
                }
        } else if (MODE == 1 || MODE == 3) {
            const f32x4 wl = *(const f32x4*)(wr_ + 4 * fq), wh = *(const f32x4*)(wr_ + 16 + 4 * fq);
            f32x4 n0, n1; { const f32x4* t = (const f32x4*)(cs32 + ((size_t)row0 * 16 + 4 * fq) * 2); n0 = t[0]; n1 = t[1]; }
#pragma unroll
            for (int ai = 0; ai < 2; ++ai)
#pragma unroll
                for (int m = 0; m < 4; ++m) {
                    const int row = row0 + ai * 128 + m * 16;
                    const float epsq = EPS * (ms8[ai * 4 + m] + EPS);
                    const f32x4 c0 = n0, c1 = n1;
                    if ((ai * 4 + m) < 7) { const int rown = row0 + ((ai * 4 + m + 1) >> 2) * 128 + ((ai * 4 + m + 1) & 3) * 16;
                        const f32x4* t = (const f32x4*)(cs32 + ((size_t)rown * 16 + 4 * fq) * 2); n0 = t[0]; n1 = t[1]; }
#pragma unroll
                    for (int bj = 0; bj < 2; ++bj) {
                        const f32x4 v0 = acc[ai][bj][m][0], v1 = acc[ai][bj][m][1];
                        float ss = 0.f;
#pragma unroll
                        for (int i = 0; i < 4; ++i) ss += v0[i] * v0[i] + v1[i] * v1[i];
                        ss += __shfl_xor(ss, 16); ss += __shfl_xor(ss, 32);
                        const float sc = __builtin_amdgcn_rsqf(ss * (1.f / 32.f) + epsq) * QSC;
                        const float x1a = v0[0] * sc * wl[0], x2a = v0[1] * sc * wh[0], x1b = v0[2] * sc * wl[1], x2b = v0[3] * sc * wh[1];
                        const float x1c = v1[0] * sc * wl[2], x2c = v1[1] * sc * wh[2], x1d = v1[2] * sc * wl[3], x2d = v1[3] * sc * wh[3];
                        u32x4 w;
                        w.x = cvtpk(x1a * c0[0] - x2a * c0[1], x2a * c0[0] + x1a * c0[1]);
                        w.y = cvtpk(x1b * c0[2] - x2b * c0[3], x2b * c0[2] + x1b * c0[3]);
                        w.z = cvtpk(x1c * c1[0] - x2c * c1[1], x2c * c1[0] + x1c * c1[1]);
                        w.w = cvtpk(x1d * c1[2] - x2d * c1[3], x2d * c1[2] + x1d * c1[3]);
                        const int head = 4 * bj + wc;
                        bf16* op = O + ((size_t)(b * NH + head) * SEQ + (row - b * SEQ)) * OP;
                        *(u32x4*)(op + 64 + 8 * fq) = w;
                    }
                    asm volatile("" ::: "memory");
                }
        } else {
#pragma unroll
            for (int ai = 0; ai < 2; ++ai)
#pragma unroll
                for (int m = 0; m < 4; ++m) {
                    const int row = row0 + ai * 128 + m * 16;
                    const float sc = __builtin_amdgcn_rsqf(ms8[ai * 4 + m] + EPS);
#pragma unroll
                    for (int bj = 0; bj < 2; ++bj) {
                        const f32x4 v0 = acc[ai][bj][m][0] * sc, v1 = acc[ai][bj][m][1] * sc;
                        const int head = 2 * (u.pn - 2) + bj;
                        bf16* op = Vo + ((size_t)(b * NH + head) * SEQ + (row - b * SEQ)) * 128 + 32 * wc + 8 * fq;
                        u32x4 w; w.x = cvtpk(v0[0], v0[1]); w.y = cvtpk(v0[2], v0[3]); w.z = cvtpk(v1[0], v1[1]); w.w = cvtpk(v1[2], v1[3]);
                        *(u32x4*)op = w;
                    }
                }
        }
    }
};

struct EpiOut {
    static constexpr bool PERM = false, MIDSCALE = true;
    const float* x; float* out; const float* mod; const float* ss;
    __device__ __forceinline__ void mid(pg8::f32x4 (&acc)[2][2][4][2], const pg8::Unit& u) const {
        EPI_LANES(); (void)wc; (void)fq;
        const int row0 = u.pm * 256 + wr * 64 + fr;
#pragma unroll
        for (int ai = 0; ai < 2; ++ai)
#pragma unroll
            for (int m = 0; m < 4; ++m) {
                const f32x4* sp = (const f32x4*)(ss + (size_t)(row0 + ai * 128 + m * 16) * 8);
                const f32x4 s0 = sp[0], s1 = sp[1];
                const float rstd = __builtin_amdgcn_rsqf(((s0[0] + s0[1]) + (s0[2] + s0[3]) + (s1[0] + s1[1]) + (s1[2] + s1[3])) * (1.f / 1024.f) + EPS);
#pragma unroll
                for (int bj = 0; bj < 2; ++bj)
#pragma unroll
                    for (int n = 0; n < 2; ++n) acc[ai][bj][m][n] *= rstd;
            }
    }
    __device__ __forceinline__ void operator()(const pg8::f32x4 (&acc)[2][2][4][2], const pg8::Unit& u, int, int, int, int) const {
        EPI_LANES();
        const int row0 = u.pm * 256 + wr * 64 + fr, b = row0 / SEQ;
        const int col0 = u.pn * 256 + wc * 32 + 4 * fq;
        f32x4 gv[2][2];
#pragma unroll
        for (int bj = 0; bj < 2; ++bj)
#pragma unroll
            for (int n = 0; n < 2; ++n) gv[bj][n] = *(const f32x4*)(mod + b * 3072 + 2048 + col0 + bj * 128 + n * 16);
#pragma unroll
        for (int ai = 0; ai < 2; ++ai)
#pragma unroll
            for (int m = 0; m < 4; ++m) {
                const size_t off = (size_t)(row0 + ai * 128 + m * 16) * DM + col0;
#pragma unroll
                for (int bj = 0; bj < 2; ++bj)
#pragma unroll
                    for (int n = 0; n < 2; ++n) {
                        const f32x4 xv = *(const f32x4*)(x + off + bj * 128 + n * 16);
                        *(f32x4*)(out + off + bj * 128 + n * 16) = xv + gv[bj][n] * acc[ai][bj][m][n];
                    }
            }
    }
};

#define KSWZ(row, colB) ((row) * 256 + ((colB) ^ (((row) & 7) << 4)))
#define SBAR() __builtin_amdgcn_sched_barrier(0)
constexpr int KVBLK = 64;
constexpr size_t SHM_V = KVBLK * 128 * 2, SHM_K = KVBLK * 128 * 2;
constexpr float ATT_SCALE = 0.10206207261596575f;
constexpr float THR = 8.f;
__device__ __forceinline__ f32x16 zero16() { float z; asm volatile("v_mov_b32 %0, 0" : "=v"(z)); f32x16 r;
#pragma unroll
    for (int i = 0; i < 16; ++i) r[i] = z;
    return r; }
__device__ __forceinline__ int crow(int r, int hi) { return (r & 3) + 8 * (r >> 2) + 4 * hi; }
__device__ __forceinline__ int v_st(int k, int c) { const int kk = (k & ~0xC) | ((k & 4) << 1) | ((k & 8) >> 1); return ((kk >> 3) * 4 + (c >> 5)) * 512 + ((kk & 7) * 32 + (c & 31)) * 2; }
__device__ __forceinline__ int v_st_raw(int k, int c) { return ((k >> 3) * 4 + (c >> 5)) * 512 + ((k & 7) * 32 + (c & 31)) * 2; }
__device__ __forceinline__ int v_rd_base(int lane) { return ((lane & 3) << 3) | (((lane >> 2) & 3) << 6) | (((lane >> 4) & 1) << 5) | (((lane >> 5) & 1) << 8); }
constexpr int v_rd_off(int d0, int ks, int half) { return d0 * 512 + ks * 4096 + half * 2048; }
template <int OFF> __device__ __forceinline__ s16x4 tr_read(int vb) {
    s16x4 r; asm volatile("ds_read_b64_tr_b16 %0, %1 offset:%2" : "=&v"(r) : "v"(vb), "i"(OFF) : "memory"); return r;
}
#define PKF(L, H) (bf16x8){L[0], L[1], L[2], L[3], H[0], H[1], H[2], H[3]}
template <int D0> __device__ __forceinline__ void pv_one(f32x16& od, int vb, bf16x8 pa0, bf16x8 pa1, bf16x8 pa2, bf16x8 pa3) {
    const s16x4 l0 = tr_read<v_rd_off(D0, 0, 0)>(vb), h0 = tr_read<v_rd_off(D0, 0, 1)>(vb), l1 = tr_read<v_rd_off(D0, 1, 0)>(vb), h1 = tr_read<v_rd_off(D0, 1, 1)>(vb);
    const s16x4 l2 = tr_read<v_rd_off(D0, 2, 0)>(vb), h2 = tr_read<v_rd_off(D0, 2, 1)>(vb), l3 = tr_read<v_rd_off(D0, 3, 0)>(vb), h3 = tr_read<v_rd_off(D0, 3, 1)>(vb);
    asm volatile("s_waitcnt lgkmcnt(0)" ::: "memory"); SBAR();
    od = __builtin_amdgcn_mfma_f32_32x32x16_bf16(pa0, PKF(l0, h0), od, 0, 0, 0);
    od = __builtin_amdgcn_mfma_f32_32x32x16_bf16(pa1, PKF(l1, h1), od, 0, 0, 0);
    od = __builtin_amdgcn_mfma_f32_32x32x16_bf16(pa2, PKF(l2, h2), od, 0, 0, 0);
    od = __builtin_amdgcn_mfma_f32_32x32x16_bf16(pa3, PKF(l3, h3), od, 0, 0, 0);
}
__device__ __forceinline__ void pv_d0(f32x16* o, int vb, bf16x8 pa0, bf16x8 pa1, bf16x8 pa2, bf16x8 pa3) {
    pv_one<0>(o[0], vb, pa0, pa1, pa2, pa3); pv_one<1>(o[1], vb, pa0, pa1, pa2, pa3); pv_one<2>(o[2], vb, pa0, pa1, pa2, pa3); pv_one<3>(o[3], vb, pa0, pa1, pa2, pa3);
}
#define PK4(P, BASE, OUT) do { u32x4 w = {cvtpk(P[BASE + 0], P[BASE + 1]), cvtpk(P[BASE + 2], P[BASE + 3]), cvtpk(P[BASE + 4], P[BASE + 5]), cvtpk(P[BASE + 6], P[BASE + 7])}; \
    OUT = *reinterpret_cast<bf16x8*>(&w); } while (0)

__device__ __forceinline__ void partialSM(f32x16& p0, f32x16& p1) {
    (void)p1;
#pragma unroll
    for (int r = 0; r < 16; ++r) p0[r] = __builtin_amdgcn_exp2f(p0[r]);
}
__device__ __forceinline__ void finishSM(f32x16& p0, f32x16& p1, float& l_reg, bf16x8& pa0, bf16x8& pa1, bf16x8& pa2, bf16x8& pa3) {
#pragma unroll
    for (int r = 0; r < 16; ++r) p1[r] = __builtin_amdgcn_exp2f(p1[r]);
    float ps = 0;
#pragma unroll
    for (int r = 0; r < 16; ++r) ps += p0[r];
#pragma unroll
    for (int r = 0; r < 16; ++r) ps += p1[r];
    { auto rr = __builtin_amdgcn_permlane32_swap(__float_as_uint(ps), __float_as_uint(ps), false, false);
      ps = __uint_as_float(rr[0]) + __uint_as_float(rr[1]); }
    l_reg += ps;
    PK4(p0, 0, pa0); PK4(p0, 8, pa1); PK4(p1, 0, pa2); PK4(p1, 8, pa3);
}
__device__ __forceinline__ void qkt6(f32x16& p0, f32x16& p1, const char* Ks, const bf16x8* qr, int r32, int hi) {
    asm volatile("" : "+v"(r32));
    p0 = f32x16{}; p1 = f32x16{};
#pragma unroll
    for (int d0 = 0; d0 < 6; ++d0) { const int cb = (d0 * 16 + hi * 8) * 2;
        const bf16x8 b0 = *reinterpret_cast<const bf16x8*>(Ks + KSWZ(r32, cb));
        const bf16x8 b1 = *reinterpret_cast<const bf16x8*>(Ks + KSWZ(32 + r32, cb));
        p0 = __builtin_amdgcn_mfma_f32_32x32x16_bf16(b0, qr[d0], p0, 0, 0, 0);
        p1 = __builtin_amdgcn_mfma_f32_32x32x16_bf16(b1, qr[d0], p1, 0, 0, 0);
        asm volatile("" :: "v"(b0), "v"(b1), "v"(qr[d0])); }
}

__device__ __forceinline__ void attn_unit(bf16* __restrict__ QOb, const bf16* __restrict__ Kh, const bf16* __restrict__ Vh, int seq, char* lds,
                                          bf16* __restrict__ mgb  , float* __restrict__ ssb  , const float* __restrict__ wnh  ) {
    constexpr int LDQ = 128, LDKK = 96, LDV = 128;
    int tid_ = threadIdx.x; asm volatile("" : "+v"(tid_));
    const int tid = tid_, wid = tid >> 6, lane = tid & 63, r32 = lane & 31, hi = lane >> 5;
    char* V_lds = lds; char* K_lds = lds + 3 * SHM_V;
    float* ws = (float*)(lds + 3 * SHM_V + 3 * SHM_K) + wid * 64; float* li_l = ws;
    float l_reg = 0; f32x16 o[4] = {}; bf16x8 qr[6];
    const bf16* Qw = QOb + (long)(wid * 32 + r32) * LDQ + hi * 8;
#pragma unroll
    for (int d0 = 0; d0 < 6; ++d0) qr[d0] = *reinterpret_cast<const bf16x8*>(Qw + d0 * 16);
    const int sr = tid >> 4, sc = (tid & 15) * 8, vst0 = v_st_raw(sr, sc), vst1 = v_st_raw(32 + sr, sc);
    const int sck = sc < 96 ? sc : 88;
    const int vb0 = (int)(uintptr_t)V_lds + v_rd_base(lane);
    struct { bf16x8 vs0, vs1, ks0, ks1; } sr_[2];
    const char* Vhb = (const char*)Vh; const char* Khb = (const char*)Kh;
    const unsigned voV = (unsigned)(sr * LDV + sc) * 2u, voK = (unsigned)(sr * LDKK + sck) * 2u;
#define SLOAD(i, k0) do { const char* vt_ = Vhb + (size_t)(k0) * (LDV * 2); const char* kt_ = Khb + (size_t)(k0) * (LDKK * 2); \
    sr_[i].vs0 = *(const bf16x8*)(vt_ + voV); sr_[i].vs1 = *(const bf16x8*)(vt_ + 32 * LDV * 2 + voV); \
    sr_[i].ks0 = *(const bf16x8*)(kt_ + voK); sr_[i].ks1 = *(const bf16x8*)(kt_ + 32 * LDKK * 2 + voK); } while (0)
#define SWRITE(b, i) do {   *(bf16x8*)(V_lds + (b) * SHM_V + vst0) = sr_[i].vs0; *(bf16x8*)(V_lds + (b) * SHM_V + vst1) = sr_[i].vs1; const int kc = sc * 2; \
    *(bf16x8*)(K_lds + (b) * SHM_K + KSWZ(sr, kc)) = sr_[i].ks0; *(bf16x8*)(K_lds + (b) * SHM_K + KSWZ(32 + sr, kc)) = sr_[i].ks1; } while (0)
#define SWAIT() asm volatile("s_waitcnt vmcnt(4)" ::: "memory")
    f32x16 pA0, pA1, pB0, pB1; bf16x8 pa0, pa1, pa2, pa3; const int NT = seq / KVBLK;
    constexpr int SE = 0, SO = 1;
#define ASTEP(PC0, PC1, PP0, PP1, KS, VS, WS, RW, RL, LT, LCOND) do { \
        SBAR(); qkt6(PC0, PC1, K_lds + (KS) * SHM_K, qr, r32, hi); \
        finishSM(PP0, PP1, l_reg, pa0, pa1, pa2, pa3); SBAR(); \
        if (LCOND) SLOAD(RL, (LT) * KVBLK); SBAR(); \
        pv_d0(o, vb0 + (VS) * (int)SHM_V, pa0, pa1, pa2, pa3); partialSM(PC0, PC1); \
        SWRITE(WS, RW); __syncthreads(); } while (0)
    SLOAD(0, 0); SLOAD(1, KVBLK);
    SWRITE(0, 0); __syncthreads();
    SLOAD(0, 2 * KVBLK);
    qkt6(pA0, pA1, K_lds, qr, r32, hi); partialSM(pA0, pA1);
    SWRITE(1, 1); __syncthreads();
    for (int j = 1; j + 5 < NT; j += 6) {
        ASTEP(pB0, pB1, pA0, pA1, 1, 0, 2, 0, 1, j + 2, true);
        ASTEP(pA0, pA1, pB0, pB1, 2, 1, 0, 1, 0, j + 3, true);
        ASTEP(pB0, pB1, pA0, pA1, 0, 2, 1, 0, 1, j + 4, true);
        ASTEP(pA0, pA1, pB0, pB1, 1, 0, 2, 1, 0, j + 5, true);
        ASTEP(pB0, pB1, pA0, pA1, 2, 1, 0, 0, 1, j + 6, true);
        ASTEP(pA0, pA1, pB0, pB1, 0, 2, 1, 1, 0, j + 7, j + 7 < NT);
    }
    SBAR(); qkt6(pB0, pB1, K_lds + 1 * SHM_K, qr, r32, hi);
    finishSM(pA0, pA1, l_reg, pa0, pa1, pa2, pa3); SBAR();
    pv_d0(o, vb0 + 0 * (int)SHM_V, pa0, pa1, pa2, pa3); partialSM(pB0, pB1);
    finishSM(pB0, pB1, l_reg, pa0, pa1, pa2, pa3); SBAR();
    pv_d0(o, vb0 + 1 * (int)SHM_V, pa0, pa1, pa2, pa3);
    __syncthreads();
#undef ASTEP
    { const int t2_ = fresh_tid(), wid = t2_ >> 6, lane = t2_ & 63, r32 = lane & 31, hi = lane >> 5;
      float* li_l = (float*)(lds + 3 * SHM_V + 3 * SHM_K) + wid * 64;
      char* stg = lds + wid * 8192;
      if (hi == 0) li_l[r32] = l_reg; asm volatile("s_waitcnt lgkmcnt(0)" ::: "memory");
      float wv[4];
#pragma unroll
      for (int d0 = 0; d0 < 4; ++d0) wv[d0] = wnh[d0 * 32 + r32];
#pragma unroll
      for (int r = 0; r < 16; ++r) { const int orow = crow(r, hi); const float rl = __builtin_amdgcn_rcpf(li_l[orow]);
          const float a0 = o[0][r] * rl, a1 = o[1][r] * rl, a2 = o[2][r] * rl, a3 = o[3][r] * rl;
          float sq = (a0 * a0 + a1 * a1) + (a2 * a2 + a3 * a3);
#pragma unroll
          for (int ofs = 1; ofs < 32; ofs <<= 1) sq += __shfl_xor(sq, ofs);
          if (r32 == 0) ssb[(size_t)(wid * 32 + orow) * 8] = sq;
          bf16* sp = (bf16*)(stg + orow * 256) + r32;
          sp[0] = (bf16)(cvtpk(a0 * wv[0], 0.f) & 0xffffu); sp[32] = (bf16)(cvtpk(a1 * wv[1], 0.f) & 0xffffu);
          sp[64] = (bf16)(cvtpk(a2 * wv[2], 0.f) & 0xffffu); sp[96] = (bf16)(cvtpk(a3 * wv[3], 0.f) & 0xffffu); }
      const char* gbase = (const char*)(mgb + (size_t)(wid * 32) * PITCH);
      const unsigned goff = (unsigned)((lane >> 4) * PITCH + (lane & 15) * 8) * 2u;
      u32x4 gv[8];
#pragma unroll
      for (int k = 0; k < 8; ++k) gv[k] = *(const u32x4*)(gbase + (size_t)k * (4 * PITCH * 2) + goff);
#pragma unroll
      for (int k = 0; k < 8; ++k) {
          const u32x4 nv = *(const u32x4*)(stg + (4 * k + (lane >> 4)) * 256 + (lane & 15) * 16);
          u32x4 ov;
#pragma unroll
          for (int q = 0; q < 4; ++q) ov[q] = cvtpk(bf_lo(nv[q]) * bf_lo(gv[k][q]), bf_hi(nv[q]) * bf_hi(gv[k][q]));
          *(u32x4*)((char*)gbase + (size_t)k * (4 * PITCH * 2) + goff) = ov;
      } }
#undef SLOAD
#undef SWRITE
#undef SWAIT
}

__device__ __forceinline__ const char* uptr(const char* p) { const unsigned long long a = (unsigned long long)p;
    const unsigned lo = __builtin_amdgcn_readfirstlane((unsigned)a), hi = __builtin_amdgcn_readfirstlane((unsigned)(a >> 32));
    return (const char*)(((unsigned long long)hi << 32) | lo); }

__device__ __forceinline__ void ret_state_phase(const bf16* __restrict__ proj, bf16* __restrict__ kvs, const float* __restrict__ dl_f, const float* __restrict__ dl_b, int bid, int G, char* lds) {
    const int tid = fresh_tid(), wid = tid >> 6, lane = tid & 63, r32 = lane & 31, hi = lane >> 5;
    char* KX = lds;
    char* VT = lds + 32768;
    const unsigned koff = (unsigned)((tid >> 3) * PITCH + (tid & 7) * 8) * 2u, voff = (unsigned)((tid >> 4) * PITCH + (tid & 15) * 8) * 2u;
    const int rb = wid & 3, cg2 = wid >> 2;
    const int kb = (int)(uintptr_t)KX + v_rd_base(lane) + rb * 512;
    const int vb = (int)(uintptr_t)VT + v_rd_base(lane) + cg2 * 1024;
    u32x4 kreg[2], vreg[4];
#define RS_LOAD(U) do { const int bh_ = (U) >> 6, c_ = (U) & 63, b_ = bh_ >> 3, h_ = bh_ & 7; const size_t row0_ = (size_t)b_ * SEQ + (size_t)c_ * 128; \
        const char* kbase_ = (const char*)(proj + row0_ * PITCH + C_RK + h_ * 64); const char* vbase_ = (const char*)(proj + row0_ * PITCH + C_RV + h_ * 128); \
        _Pragma("unroll") for (int i = 0; i < 2; ++i) kreg[i] = *(const u32x4*)(uptr(kbase_ + (size_t)i * (64 * PITCH * 2)) + koff); \
        _Pragma("unroll") for (int i = 0; i < 4; ++i) vreg[i] = *(const u32x4*)(uptr(vbase_ + (size_t)i * (32 * PITCH * 2)) + voff); } while (0)
    int u = bid;
    if (u < BATCH * NH * 64) RS_LOAD(u);
    for (; u < BATCH * NH * 64; u += G) {
        const int bh = u >> 6, c = u & 63, h = bh & 7;
        const float lgf2 = -log1pf(expf(-dl_f[h])) * LOG2E, lgb2 = -log1pf(expf(-dl_b[h])) * LOG2E;
#pragma unroll
        for (int i = 0; i < 2; ++i) {
            const int key = (tid >> 3) + 64 * i, ch = tid & 7;
            const float df = __builtin_amdgcn_exp2f(lgf2 * (float)(127 - key)), db = __builtin_amdgcn_exp2f(lgb2 * (float)key);
            u32x4 wf, wb;
#pragma unroll
            for (int q = 0; q < 4; ++q) { const float x = bf_lo(kreg[i][q]), y = bf_hi(kreg[i][q]); wf[q] = cvtpk(x * df, y * df); wb[q] = cvtpk(x * db, y * db); }
            char* t = KX + (key >> 6) * 16384;
            *(u32x4*)(t + v_st(key & 63, ch * 8)) = wf;
            *(u32x4*)(t + v_st(key & 63, 64 + ch * 8)) = wb;
        }
#pragma unroll
        for (int i = 0; i < 4; ++i) {
            const int key = (tid >> 4) + 32 * i, ch = tid & 15;
            *(u32x4*)(VT + (key >> 6) * 16384 + v_st(key & 63, ch * 8)) = vreg[i];
        }
        __syncthreads();
        if (u + G < BATCH * NH * 64) RS_LOAD(u + G);
        f32x16 acc0 = {}, acc1 = {};
#define RS_STEP(T, KS) do { \
        const s16x4 al = tr_read<(T) * 16384 + (KS) * 4096>(kb), ah = tr_read<(T) * 16384 + (KS) * 4096 + 2048>(kb); \
        const s16x4 bl0 = tr_read<(T) * 16384 + (KS) * 4096>(vb), bh0 = tr_read<(T) * 16384 + (KS) * 4096 + 2048>(vb); \
        const s16x4 bl1 = tr_read<(T) * 16384 + (KS) * 4096 + 512>(vb), bh1 = tr_read<(T) * 16384 + (KS) * 4096 + 2048 + 512>(vb); \
        asm volatile("s_waitcnt lgkmcnt(0)" ::: "memory"); SBAR(); \
        acc0 = __builtin_amdgcn_mfma_f32_32x32x16_bf16(PKF(al, ah), PKF(bl0, bh0), acc0, 0, 0, 0); \
        acc1 = __builtin_amdgcn_mfma_f32_32x32x16_bf16(PKF(al, ah), PKF(bl1, bh1), acc1, 0, 0, 0); } while (0)
        RS_STEP(0, 0); RS_STEP(0, 1); RS_STEP(0, 2); RS_STEP(0, 3); RS_STEP(1, 0); RS_STEP(1, 1); RS_STEP(1, 2); RS_STEP(1, 3);
#undef RS_STEP
        const int dir = rb >> 1;
        bf16* op = kvs + (((size_t)(bh * 64 + c) * 2 + dir) * 64) * 128;
#pragma unroll
        for (int r = 0; r < 16; ++r) { const int dk = 32 * (rb & 1) + crow(r, hi);
            op[dk * 128 + (2 * cg2) * 32 + r32] = (bf16)(cvtpk(acc0[r], 0.f) & 0xffffu);
            op[dk * 128 + (2 * cg2 + 1) * 32 + r32] = (bf16)(cvtpk(acc1[r], 0.f) & 0xffffu); }
        __syncthreads();
    }
#undef RS_LOAD
}

__device__ __forceinline__ void ret_main_phase(bf16* __restrict__ proj, const bf16* __restrict__ kvs, const float* __restrict__ gnw, const float* __restrict__ dl_f, const float* __restrict__ dl_b, int bid, int G, char* lds) {
    const int tid = fresh_tid(), wid = tid >> 6, lane = tid & 63, r32 = lane & 31, hi = lane >> 5;
    char* KT = lds;
    char* VT = lds + 32768;
    const unsigned koff = (unsigned)((tid >> 3) * PITCH + (tid & 7) * 8) * 2u, voff = (unsigned)((tid >> 4) * PITCH + (tid & 15) * 8) * 2u;
    const int c = wid >> 2, iloc = 32 * (wid & 3) + r32;
    const unsigned qoff = (unsigned)((128 * c + iloc) * PITCH + hi * 8) * 2u;
    const int vb0 = (int)(uintptr_t)VT + v_rd_base(lane);
    u32x4 kreg[4], vreg[8]; bf16x8 qr[4];
#define RM_LOAD(U) do { const int bh_ = (U) >> 5, cp_ = (U) & 31, b_ = bh_ >> 3, h_ = bh_ & 7; const size_t row0_ = (size_t)b_ * SEQ + (size_t)cp_ * 256; \
        const char* kbase_ = (const char*)(proj + row0_ * PITCH + C_RK + h_ * 64); const char* vbase_ = (const char*)(proj + row0_ * PITCH + C_RV + h_ * 128); \
        const char* qbase_ = (const char*)(proj + row0_ * PITCH + C_RQ + h_ * 64); \
        _Pragma("unroll") for (int i = 0; i < 4; ++i) kreg[i] = *(const u32x4*)(uptr(kbase_ + (size_t)i * (64 * PITCH * 2)) + koff); \
        _Pragma("unroll") for (int i = 0; i < 8; ++i) vreg[i] = *(const u32x4*)(uptr(vbase_ + (size_t)i * (32 * PITCH * 2)) + voff); \
        _Pragma("unroll") for (int d0 = 0; d0 < 4; ++d0) qr[d0] = *(const bf16x8*)(uptr(qbase_ + d0 * 32) + qoff); } while (0)
    int u = bid;
    if (u < 1024) RM_LOAD(u);
    for (; u < 1024; u += G) {
        const int bh = u >> 5, cp = u & 31, b = bh >> 3, h = bh & 7;
        const float lgf2 = -log1pf(expf(-dl_f[h])) * LOG2E, lgb2 = -log1pf(expf(-dl_b[h])) * LOG2E;
        const size_t row0 = (size_t)b * SEQ + (size_t)cp * 256;
        int iloc_l = iloc, hi_l = hi; asm volatile("" : "+v"(iloc_l), "+v"(hi_l));
#pragma unroll
        for (int i = 0; i < 4; ++i) { const int key = (tid >> 3) + 64 * i, ch = tid & 7; *(u32x4*)(KT + key * 128 + ((ch ^ (key & 7)) << 4)) = kreg[i]; }
#pragma unroll
        for (int i = 0; i < 8; ++i) { const int key = (tid >> 4) + 32 * i, ch = tid & 15; *(u32x4*)(VT + (key >> 6) * 16384 + v_st_raw(key & 63, ch * 8)) = vreg[i]; }
        __syncthreads();
        u32x4 sreg[8];
        { const char* sbase = (const char*)(kvs + (size_t)(bh * 64 + 2 * cp) * (128 * 128));
#pragma unroll
          for (int i = 0; i < 8; ++i) sreg[i] = *(const u32x4*)(uptr(sbase + (size_t)i * 8192) + (unsigned)tid * 16u); }
        f32x16 o[4] = {};
#pragma unroll
        for (int kt = 0; kt < 2; ++kt) {
            const int T = 2 * c + kt;
            f32x16 p0 = {}, p1 = {};
#pragma unroll
            for (int d0 = 0; d0 < 4; ++d0) { const int ch = d0 * 2 + hi; const int k0 = T * 64 + r32, k1 = k0 + 32;
                const bf16x8 b0 = *(const bf16x8*)(KT + k0 * 128 + ((ch ^ (k0 & 7)) << 4));
                const bf16x8 b1 = *(const bf16x8*)(KT + k1 * 128 + ((ch ^ (k1 & 7)) << 4));
                p0 = __builtin_amdgcn_mfma_f32_32x32x16_bf16(b0, qr[d0], p0, 0, 0, 0);
                p1 = __builtin_amdgcn_mfma_f32_32x32x16_bf16(b1, qr[d0], p1, 0, 0, 0); }
#pragma unroll
            for (int r = 0; r < 16; ++r) {
                const int j0 = 64 * kt + crow(r, hi_l), d0_ = iloc_l - j0, d1_ = d0_ - 32;
                const float e0 = (d0_ >= 0 ? lgf2 : -lgb2) * (float)d0_;
                const float e1 = (d1_ >= 0 ? lgf2 : -lgb2) * (float)d1_;
                p0[r] *= __builtin_amdgcn_exp2f(e0); p1[r] *= __builtin_amdgcn_exp2f(e1);
            }
            bf16x8 pa0, pa1, pa2, pa3;
            PK4(p0, 0, pa0); PK4(p0, 8, pa1); PK4(p1, 0, pa2); PK4(p1, 8, pa3);
            pv_d0(o, vb0 + T * 16384, pa0, pa1, pa2, pa3);
        }
        __syncthreads();
#pragma unroll
        for (int i = 0; i < 8; ++i) { const int trow = (tid >> 4) + 32 * i, ch = tid & 15, tile = trow >> 6, dk = trow & 63;
            *(u32x4*)(VT + tile * 16384 + v_st(dk, ch * 8)) = sreg[i]; }
        __syncthreads();
#pragma unroll
        for (int dir = 0; dir < 2; ++dir) {
            const float dec = dir == 0 ? __builtin_amdgcn_exp2f(lgf2 * (float)(iloc_l + 1)) : __builtin_amdgcn_exp2f(lgb2 * (float)(128 - iloc_l));
            bf16x8 pa[4];
#pragma unroll
            for (int k = 0; k < 4; ++k) { const u32x4 w = *reinterpret_cast<const u32x4*>(&qr[k]); u32x4 o4;
#pragma unroll
                for (int q = 0; q < 4; ++q) o4[q] = cvtpk(bf_lo(w[q]) * dec, bf_hi(w[q]) * dec);
                pa[k] = *reinterpret_cast<bf16x8*>(&o4); }
            pv_d0(o, vb0 + (2 * c + dir) * 16384, pa[0], pa[1], pa[2], pa[3]);
        }
        if (u + G < 1024) RM_LOAD(u + G);
        __syncthreads();
        char* stg = VT + wid * 8192;
        float gw[4];
#pragma unroll
        for (int d0 = 0; d0 < 4; ++d0) gw[d0] = gnw[h * 128 + d0 * 32 + r32];
#pragma unroll
        for (int r = 0; r < 16; ++r) {
            float s1 = (o[0][r] + o[1][r]) + (o[2][r] + o[3][r]);
            float s2 = (o[0][r] * o[0][r] + o[1][r] * o[1][r]) + (o[2][r] * o[2][r] + o[3][r] * o[3][r]);
#pragma unroll
            for (int ofs = 1; ofs < 32; ofs <<= 1) { s1 += __shfl_xor(s1, ofs); s2 += __shfl_xor(s2, ofs); }
            const float mu = s1 * (1.f / 128.f), var = fmaxf(s2 * (1.f / 128.f) - mu * mu, 0.f), rs = __builtin_amdgcn_rsqf(var + EPS);
            bf16* sp = (bf16*)(stg + crow(r, hi_l) * 256) + r32;
#pragma unroll
            for (int d0 = 0; d0 < 4; ++d0) sp[d0 * 32] = (bf16)(cvtpk((o[d0][r] - mu) * rs * gw[d0], 0.f) & 0xffffu);
        }
        { const char* gbase = (const char*)(proj + (row0 + 128 * c + 32 * (wid & 3)) * PITCH + C_RG + h * 128);
          const unsigned goff = (unsigned)((lane >> 4) * PITCH + (lane & 15) * 8) * 2u;
          u32x4 gv[8];
#pragma unroll
          for (int k = 0; k < 8; ++k) gv[k] = *(const u32x4*)(uptr(gbase + (size_t)k * (4 * PITCH * 2)) + goff);
#pragma unroll
          for (int k = 0; k < 8; ++k) {
              const u32x4 nv = *(const u32x4*)(stg + (4 * k + (lane >> 4)) * 256 + (lane & 15) * 16);
              u32x4 ov;
#pragma unroll
              for (int q = 0; q < 4; ++q) ov[q] = cvtpk(bf_lo(nv[q]) * bf_lo(gv[k][q]), bf_hi(nv[q]) * bf_hi(gv[k][q]));
              *(u32x4*)((char*)uptr(gbase + (size_t)k * (4 * PITCH * 2)) + goff) = ov;
          } }
        __syncthreads();
    }
#undef RM_LOAD
}

__global__ void __launch_bounds__(NTHREADS) fwd_megakernel(Params p) {
    extern __shared__ __attribute__((aligned(16))) unsigned char lds[];
    cg::grid_group grid = cg::this_grid();
    const int G = gridDim.x, bid = blockIdx.x;
    const int NGW = G * NWAVES; const long NGT = (long)G * NTHREADS;
#define PHASE_IDS() const int tid = fresh_tid(), lane = tid & 63, wave = tid >> 6, gw = bid * NWAVES + wave; const long gt = (long)bid * NTHREADS + tid; (void)lane; (void)gw; (void)gt
    unsigned char* ws = p.ws;
    const float* x = p.in[0]; const float* cvec = p.in[1]; const int* positions = (const int*)p.in[2];
    const float* norm_w = p.in[3]; const float* w_ada = p.in[4]; const float* b_ada = p.in[5]; const float* w_in = p.in[6];
    const float* dl_f = p.in[7]; const float* dl_b = p.in[8]; const float* gn_w = p.in[9];
    const float* q_norm_w = p.in[10]; const float* w_uq = p.in[11]; const float* kv_norm_w = p.in[12]; const float* w_ukv = p.in[13];
    const float* qn_nope_w = p.in[14]; const float* qn_rope_w = p.in[15]; const float* kn_nope_w = p.in[16]; const float* kn_rope_w = p.in[17];
    const float* mla_norm_w = p.in[18]; const float* w_out = p.in[19];
    bf16* PROJ = (bf16*)(ws + WS_PROJ); bf16* KB = (bf16*)(ws + WS_K); bf16* VB = (bf16*)(ws + WS_V);
    bf16* WIN = (bf16*)(ws + WS_WIN); bf16* WQ = (bf16*)(ws + WS_WQ); bf16* WKV = (bf16*)(ws + WS_WKV); bf16* WO = (bf16*)(ws + WS_WO);
    float* CS64 = (float*)(ws + WS_CS64); float* CS32 = (float*)(ws + WS_CS32); float* MOD = (float*)(ws + WS_MOD); f32x2* STAT = (f32x2*)(ws + WS_STAT);
    float* SSB = (float*)(ws + WS_SS);
    bf16* HB = (bf16*)p.out; bf16* QO = (bf16*)((unsigned char*)p.out + OUT_QO); bf16* KVS = (bf16*)((unsigned char*)p.out + OUT_KVS);

    if (threadIdx.x < 4) ((volatile LAS unsigned*)((LAS unsigned char*)lds + LDS_CTL_OFF))[threadIdx.x] = 0u;
    __syncthreads();
    const XcdBarrier xbar = xcd_barrier_post((unsigned*)(ws + WS_BAR), (volatile LAS unsigned*)((LAS unsigned char*)lds + LDS_CTL_OFF));
#define GRID_BAR() xcd_barrier(xbar)
    {
        PHASE_IDS();
        float* sc = (float*)lds; float* red = (float*)(lds + 16384);
        for (int it = bid; it < 192; it += G) {
            for (int i = tid; i < 4096; i += NTHREADS) sc[i] = silu_f(cvec[i]);
            __syncthreads();
            const int ks4 = lane >> 4, col = lane & 15, kb0 = wave * 128 + ks4 * 32;
            const float* wp = w_ada + (size_t)kb0 * 3072 + it * 16 + col;
            float a0 = 0.f, a1 = 0.f, a2 = 0.f, a3 = 0.f;
#pragma unroll 8
            for (int i = 0; i < 32; ++i) { const float wv = wp[(size_t)i * 3072]; const int k = kb0 + i;
                a0 += sc[k] * wv; a1 += sc[1024 + k] * wv; a2 += sc[2048 + k] * wv; a3 += sc[3072 + k] * wv; }
            a0 += __shfl_xor(a0, 16); a0 += __shfl_xor(a0, 32); a1 += __shfl_xor(a1, 16); a1 += __shfl_xor(a1, 32);
            a2 += __shfl_xor(a2, 16); a2 += __shfl_xor(a2, 32); a3 += __shfl_xor(a3, 16); a3 += __shfl_xor(a3, 32);
            if (lane < 16) { red[(wave * 4 + 0) * 16 + lane] = a0; red[(wave * 4 + 1) * 16 + lane] = a1; red[(wave * 4 + 2) * 16 + lane] = a2; red[(wave * 4 + 3) * 16 + lane] = a3; }
            __syncthreads();
            if (tid < 64) { const int bb = tid >> 4, l = tid & 15; float s = b_ada[it * 16 + l];
#pragma unroll
                for (int w = 0; w < 8; ++w) s += red[(w * 4 + bb) * 16 + l];
                MOD[bb * 3072 + it * 16 + l] = s; }
            __syncthreads();
        }
    }
    grid.sync();
#if PROBE_DUP == 4
    for (int rep_ = 0; rep_ < 2; ++rep_)
#endif
    {
    {
        PHASE_IDS();
        constexpr long I1 = 4864L * 128, I2 = 768L * 48, I3 = 1536L * 32, I4 = 1024L * 256;
        for (long it = gt; it < I1 + I2 + I3 + I4; it += NGT) {
            long r = it; const float* W; const float* ksc = nullptr; int n, kc, Kd, No, oc; bf16* WT;
            if (r < I1) { n = (int)(r % 4864); kc = (int)(r / 4864); W = w_in; Kd = 1024; No = D_IN; oc = win_colmap(n); WT = WIN; }
            else if ((r -= I1) < I2) { n = (int)(r % 768); kc = (int)(r / 768); W = w_uq; Kd = 384; No = 768; oc = wq_colmap(n); WT = WQ; ksc = q_norm_w; }
            else if ((r -= I2) < I3) { n = (int)(r % 1536); kc = (int)(r / 1536); W = w_ukv; Kd = 256; No = 1536; oc = wkv_colmap(n); WT = WKV; ksc = kv_norm_w; }
            else { r -= I3; n = (int)(r % 1024); kc = (int)(r / 1024); W = w_out; Kd = 2048; No = 1024; oc = n; WT = WO; }
            float v[8];
#pragma unroll
            for (int i = 0; i < 8; ++i) { const int k = kc * 8 + i; const int ks_ = (W == w_out) ? (k < 1024 ? k + 1024 : k - 1024) : k;
                float t = oc >= 0 ? W[(size_t)ks_ * No + oc] : 0.f; if (ksc) t *= ksc[k]; v[i] = t; }
            u32x4 w; w.x = cvtpk(v[0], v[1]); w.y = cvtpk(v[2], v[3]); w.z = cvtpk(v[4], v[5]); w.w = cvtpk(v[6], v[7]);
            *(u32x4*)(WT + (size_t)n * Kd + kc * 8) = w;
        }
        for (long it = gt; it < (long)M * 48; it += NGT) {
            const int m = (int)(it / 48), i = (int)(it % 48);
            const float pos = (float)positions[m];
            const float fe = i < 32 ? (float)(2 * i) * (1.f / 64.f) : (float)(2 * (i - 32)) * (1.f / 32.f);
            const float invf = exp2f(-fe * 13.287712379549449f);
            const float ang = pos * invf;
            double rev = (double)ang * 0.15915494309189535; rev -= floor(rev);
            const float rf = (float)rev;
            const float cs = __builtin_amdgcn_cosf(rf), sn = __builtin_amdgcn_sinf(rf);
            float* dst = i < 32 ? CS64 + ((size_t)m * 32 + i) * 2 : CS32 + ((size_t)m * 16 + (i - 32)) * 2;
            *(f32x2*)dst = (f32x2){cs, sn};
        }
    }
    { PHASE_IDS();
    for (int m0 = gw; m0 < M; m0 += 2 * NGW) {
        const int m1 = m0 + NGW; const bool has1 = m1 < M;
        const f32x4* xr0 = (const f32x4*)(x + (size_t)m0 * DM) + lane; const f32x4* xr1 = (const f32x4*)(x + (size_t)(has1 ? m1 : m0) * DM) + lane;
        f32x4 v0[4], v1[4]; float s0 = 0.f, s1 = 0.f;
#pragma unroll
        for (int j = 0; j < 4; ++j) { v0[j] = xr0[64 * j]; v1[j] = xr1[64 * j]; }
#pragma unroll
        for (int j = 0; j < 4; ++j) { s0 += (v0[j].x * v0[j].x + v0[j].y * v0[j].y) + (v0[j].z * v0[j].z + v0[j].w * v0[j].w);
                                      s1 += (v1[j].x * v1[j].x + v1[j].y * v1[j].y) + (v1[j].z * v1[j].z + v1[j].w * v1[j].w); }
        const float rstd0 = __builtin_amdgcn_rsqf(wave_sum(s0) * (1.f / DM) + EPS), rstd1 = __builtin_amdgcn_rsqf(wave_sum(s1) * (1.f / DM) + EPS);
        const int b0 = m0 / SEQ, b1 = (has1 ? m1 : m0) / SEQ;
        u32x2* o80 = (u32x2*)(HB + (size_t)m0 * DM) + lane; u32x2* o81 = (u32x2*)(HB + (size_t)m1 * DM) + lane;
#pragma unroll
        for (int j = 0; j < 4; ++j) {
            const int col = 4 * lane + 256 * j;
            const f32x4 nw = *(const f32x4*)(norm_w + col);
            { const f32x4 sh = *(const f32x4*)(MOD + b0 * 3072 + col), scl = *(const f32x4*)(MOD + b0 * 3072 + 1024 + col);
              const f32x4 hv = v0[j] * rstd0 * nw * (scl + 1.f) + sh; o80[64 * j] = (u32x2){cvtpk(hv.x, hv.y), cvtpk(hv.z, hv.w)}; }
            if (has1) { const f32x4 sh = *(const f32x4*)(MOD + b1 * 3072 + col), scl = *(const f32x4*)(MOD + b1 * 3072 + 1024 + col);
              const f32x4 hv = v1[j] * rstd1 * nw * (scl + 1.f) + sh; o81[64 * j] = (u32x2){cvtpk(hv.x, hv.y), cvtpk(hv.z, hv.w)}; }
        }
    } }
    }
    GRID_BAR();

    {
        pg8::Gemm g{HB, WIN, M, PITCH, DM, DM}; pg8::StaticOrder S; S.init(M, PITCH, G, bid);
        EpiIn E{PROJ, CS64};
        pg8::gemm_phase<EpiIn, pg8::StaticOrder>((LAS unsigned char*)lds, g, S, E);
    }
    GRID_BAR();

#if PROBE_DUP == 1
    for (int rep_ = 0; rep_ < 2; ++rep_)
#endif
    {
    { PHASE_IDS();
    const int sub = lane >> 4, l16 = lane & 15;
    for (int m0 = gw * 4; m0 < M; m0 += NGW * 4) {
        const int m = m0 + sub, b = m / SEQ, s = m - b * SEQ;
        const bf16* pr = PROJ + (size_t)m * PITCH + C_CQ + 8 * l16;
        u32x4 v[6];
#pragma unroll
        for (int i = 0; i < 5; ++i) v[i] = *(const u32x4*)(pr + 128 * i);
        v[5] = (u32x4){0u, 0u, 0u, 0u}; if (l16 < 4) v[5] = *(const u32x4*)(pr + 640);
        float s_cq = sumsq8(v[0]) + sumsq8(v[1]) + sumsq8(v[2]);
        float s_ckv = sumsq8(v[3]) + sumsq8(v[4]);
        float s_kr = sumsq8(v[5]);
#pragma unroll
        for (int ofs = 1; ofs < 16; ofs <<= 1) { s_cq += __shfl_xor(s_cq, ofs); s_ckv += __shfl_xor(s_ckv, ofs); s_kr += __shfl_xor(s_kr, ofs); }
        if (l16 == 0) STAT[m] = (f32x2){s_cq * (1.f / 384.f), s_ckv * (1.f / 256.f)};
        const float rk = __builtin_amdgcn_rsqf(s_kr * (1.f / 32.f) + EPS);
        const u32x4 b2 = v[5];
        u32x4 pw; pw.x = __shfl_xor(b2.x, 2); pw.y = __shfl_xor(b2.y, 2); pw.z = __shfl_xor(b2.z, 2); pw.w = __shfl_xor(b2.w, 2);
        if (l16 < 2) {
            const int pb = 8 * l16;
            unsigned ow[8];
#pragma unroll
            for (int q = 0; q < 4; ++q) {
#pragma unroll
                for (int e = 0; e < 2; ++e) {
                    const int pidx = pb + 2 * q + e;
                    const float x1 = (e ? bf_hi(b2[q]) : bf_lo(b2[q])) * rk * kn_rope_w[pidx];
                    const float x2 = (e ? bf_hi(pw[q]) : bf_lo(pw[q])) * rk * kn_rope_w[pidx + 16];
                    const f32x2 csv = *(const f32x2*)(CS32 + ((size_t)m * 16 + pidx) * 2);
                    ow[2 * q + e] = cvtpk(x1 * csv.x - x2 * csv.y, x2 * csv.x + x1 * csv.y);
                }
            }
            const u32x4 w0 = {ow[0], ow[1], ow[2], ow[3]}, w1 = {ow[4], ow[5], ow[6], ow[7]};
#pragma unroll
            for (int hh = 0; hh < NH; ++hh) { bf16* kp = KB + ((size_t)(b * NH + hh) * SEQ + s) * 96 + 64 + 16 * l16;
                *(u32x4*)kp = w0; *(u32x4*)(kp + 8) = w1; }
        }
    } }
    ret_state_phase(PROJ, KVS, dl_f, dl_b, bid, G, (char*)lds);
    }
    GRID_BAR();

    { PHASE_IDS();
    for (long it = gt; it < 32L * 2 * 2048; it += NGT) {
        const int e4 = (int)(it & 2047), dir = (int)((it >> 11) & 1), bh = (int)(it >> 12), h = bh & 7;
        const float lg2 = -log1pf(expf(-(dir ? dl_b[h] : dl_f[h]))) * LOG2E;
        const float gC = __builtin_amdgcn_exp2f(lg2 * 128.f);
        float s0 = 0.f, s1 = 0.f, s2 = 0.f, s3 = 0.f;
        for (int i = 0; i < 64; ++i) {
            const int c = dir ? 63 - i : i;
            u32x2* ptr = (u32x2*)(KVS + (((size_t)(bh * 64 + c) * 2 + dir) * 8192) + 4 * e4);
            const u32x2 kv = *ptr;
            *ptr = (u32x2){cvtpk(s0, s1), cvtpk(s2, s3)};
            s0 = s0 * gC + bf_lo(kv.x); s1 = s1 * gC + bf_hi(kv.x); s2 = s2 * gC + bf_lo(kv.y); s3 = s3 * gC + bf_hi(kv.y);
        }
    } }
#if PROBE_DUP == 2
    for (int rep_ = 0; rep_ < 2; ++rep_)
#endif
    {
    {
        pg8::Gemm g{PROJ + C_CQ, WQ, M, 768, 384, PITCH}; pg8::StaticOrder S; S.init(M, 768, G, G - 1 - bid);
        EpiUp<3> E{QO, nullptr, STAT, qn_nope_w, qn_rope_w, CS32};
        pg8::gemm_phase<EpiUp<3>, pg8::StaticOrder>((LAS unsigned char*)lds, g, S, E);
    }
    {
        pg8::Gemm g{PROJ + C_CKV, WKV, M, 1536, 256, PITCH}; pg8::StaticOrder S; S.init(M, 1536, G, bid);
        EpiUp<2> E{KB, VB, STAT, kn_nope_w, nullptr, nullptr};
        pg8::gemm_phase<EpiUp<2>, pg8::StaticOrder>((LAS unsigned char*)lds, g, S, E);
    }
    }
    GRID_BAR();

    for (int i = 0; i * G < 1024; ++i) {
        int u = i * G + bid; if (u >= 1024) break;
        int bh, qb;
        if (G == 256) { bh = (bid & 7) * 4 + i; qb = bid >> 3; } else { bh = u >> 5; qb = u & 31; }
        bf16* qo = QO + ((size_t)bh * SEQ + (size_t)qb * 256) * 128;
        { const int b_ = bh >> 3, h_ = bh & 7; const size_t row_ = (size_t)b_ * SEQ + (size_t)qb * 256;
          attn_unit(qo, KB + (size_t)bh * SEQ * 96, VB + (size_t)bh * SEQ * 128, SEQ, (char*)lds,
                    PROJ + row_ * PITCH + C_MG + h_ * 128, SSB + row_ * 8 + h_, mla_norm_w + h_ * 128); }
        __syncthreads();
    }
    ret_main_phase(PROJ, KVS, gn_w, dl_f, dl_b, bid, G, (char*)lds);
    GRID_BAR();

    {
        pg8::Gemm g{PROJ + C_MG, WO, M, DM, 2048, PITCH}; pg8::StaticOrder S; S.init(M, DM, G, bid);
        EpiOut E{x, p.out, MOD, SSB};
        pg8::gemm_phase<EpiOut, pg8::StaticOrder>((LAS unsigned char*)lds, g, S, E);
    }
}

extern "C" void kernel_launch(void* const* d_in, const int* in_sizes, int n_in, void* d_out, int out_size, void* d_ws, size_t ws_size, hipStream_t stream) {
    static int grid_blocks = 0;
    if (grid_blocks == 0) {
        if (n_in != 20 || out_size != M * DM || ws_size < WS_END) { fprintf(stderr, "kernel_launch: unexpected shapes (n_in %d out %d ws %zu)\n", n_in, out_size, ws_size); grid_blocks = -1; return; }
        int dev = 0, cus = 0, per_cu = 0;
        hipGetDevice(&dev);
        hipDeviceGetAttribute(&cus, hipDeviceAttributeMultiprocessorCount, dev);
        if (hipFuncSetAttribute((const void*)fwd_megakernel, hipFuncAttributeMaxDynamicSharedMemorySize, LDS_BYTES) != hipSuccess) { fprintf(stderr, "kernel_launch: hipFuncSetAttribute failed\n"); grid_blocks = -1; return; }
        if (hipOccupancyMaxActiveBlocksPerMultiprocessor(&per_cu, (const void*)fwd_megakernel, NTHREADS, LDS_BYTES) != hipSuccess || per_cu < 1) { fprintf(stderr, "kernel_launch: occupancy query failed (%d)\n", per_cu); per_cu = 1; }
        (void)hipGetLastError();
        grid_blocks = cus * per_cu;
    }
    if (grid_blocks < 0) return;
    if (hipMemsetAsync((char*)d_ws + WS_BAR, 0, XCD_BAR_WORDS * 4, stream) != hipSuccess) { fprintf(stderr, "kernel_launch: memset failed\n"); return; }
    Params p{};
    for (int i = 0; i < 20; ++i) p.in[i] = (const float*)d_in[i];
    p.out = (float*)d_out; p.ws = (unsigned char*)d_ws;
    void* args[] = {&p};
    hipError_t e = hipLaunchCooperativeKernel((const void*)fwd_megakernel, dim3(grid_blocks), dim3(NTHREADS), args, LDS_BYTES, stream);
    if (e != hipSuccess) fprintf(stderr, "cooperative launch failed: %s (grid %d)\n", hipGetErrorString(e), grid_blocks);
}
```

```cpp
#ifndef PROBE_DUP
#define PROBE_DUP 0
#endif
#include <hip/hip_runtime.h>
#include <hip/hip_cooperative_groups.h>
#include <cstdio>
#include <cstdint>
namespace cg = cooperative_groups;

namespace pg8 {
#define PG8_LAS __attribute__((address_space(3)))
typedef unsigned short bf16_t;
typedef short bf16x8 __attribute__((ext_vector_type(8)));
typedef float f32x4 __attribute__((ext_vector_type(4)));
typedef unsigned u32x4 __attribute__((ext_vector_type(4)));
constexpr int BM = 256, BK = 64, HALF = 128, HTB = HALF * BK * 2, STAGE_BYTES = 8 * HTB, NXCD = 8, WGM = 8;

__host__ __device__ __forceinline__ int lds_byte(int r, int c) { const int st = (r >> 4) * 2 + (c >> 5), rr = r & 15, cc = c & 31, ob = rr * 64 + cc * 2; return st * 1024 + (ob ^ (((ob >> 9) & 1) << 5)); }
__host__ __device__ __forceinline__ void stage_rc(int b, int& R, int& C) { const int st = b / 1024, sb = b % 1024, swz = sb ^ (((sb >> 9) & 1) << 5); R = (st >> 1) * 16 + swz / 64; C = (st & 1) * 32 + (swz % 64) / 2; }
__host__ __device__ __forceinline__ int perm32(int rho) { const int n = rho >> 4, i = rho & 15; return 8 * (i >> 2) + 4 * n + (i & 3); }

struct Unit { int pm, pn; };
struct Gemm { const bf16_t* A; const bf16_t* Bt; int M, N, K, lda; };

struct StaticOrder {
    int nM, nN, nwg, G, c;
    __host__ __device__ void init(int M, int N, int G_, int c_) { nM = M / BM; nN = N / BM; nwg = nM * nN; G = G_; c = c_; }
    __host__ __device__ bool next(int i, Unit& u) const {
        const long L = (long)i * G + c; if (L >= nwg) return false;
        int wgid = (int)L; { const int q = nwg / NXCD, r = nwg % NXCD, xcd = wgid % NXCD, off = wgid / NXCD; wgid = (xcd < r ? xcd * (q + 1) : r * (q + 1) + (xcd - r) * q) + off; }
        const int nig = WGM * nN, gid = wgid / nig, fm = gid * WGM, gsz = (nM - fm) < WGM ? (nM - fm) : WGM;
        u.pm = fm + ((wgid % nig) % gsz); u.pn = (wgid % nig) / gsz; return true;
    }
};

typedef float f32x2_c __attribute__((ext_vector_type(2)));
typedef __bf16 bf16x2_c __attribute__((ext_vector_type(2)));
__device__ __forceinline__ unsigned cvt_pk_bf16(float lo, float hi) { const f32x2_c v = {lo, hi}; return __builtin_bit_cast(unsigned, __builtin_convertvector(v, bf16x2_c)); }

template <class Epi, class Sched>
__device__ __forceinline__ void gemm_phase(PG8_LAS unsigned char* lds, const Gemm g, const Sched& S, const Epi& E) {
    int tid_ = threadIdx.x; asm volatile("" : "+v"(tid_));
    const int tid = tid_, wid = __builtin_amdgcn_readfirstlane(tid >> 6), lane = tid & 63, wr = wid >> 2, wc = wid & 3, fr = lane & 15, fq = lane >> 4;
    const int K = g.K, nt = K / BK, lda = g.lda;
    unsigned voffA[2], voffB[2];
#pragma unroll
    for (int i = 0; i < 2; ++i) { int R, C; stage_rc(tid * 16 + i * 8192, R, C); const int Rb = Epi::PERM ? ((R & ~31) + perm32(R & 31)) : R;
        voffA[i] = (unsigned)(R * lda + C) * 2u; voffB[i] = (unsigned)(Rb * K + C) * 2u; }
    const size_t kstep = (size_t)(BK * 2);
    const size_t hstepA = (size_t)HALF * lda * 2, hstepB = (size_t)HALF * K * 2;
    const size_t tstepA = 2 * hstepA, tstepB = 2 * hstepB;
    const unsigned ldsw = (unsigned)wid * 1024u;
    const int aoff = lds_byte(wr * 64 + fr, fq * 8), boff = lds_byte(wc * 32 + fr, fq * 8);
#define PG8_SA(b, h) (((b) * 2 + (h)) * HTB)
#define PG8_SB(b, h) ((4 + (b) * 2 + (h)) * HTB)
#define PG8_STAGE(bufoff, gbase, voff) do { _Pragma("unroll") for (int _i = 0; _i < 2; ++_i) \
        __builtin_amdgcn_global_load_lds((const unsigned*)((const char*)(gbase) + (voff)[_i]), (PG8_LAS unsigned*)(lds + (bufoff) + ldsw + _i * 8192), 16, 0, 0); } while (0)
#define PG8_LDA(dst, b, h) do { _Pragma("unroll") for (int m = 0; m < 4; ++m) _Pragma("unroll") for (int k = 0; k < 2; ++k) dst[m][k] = *(const PG8_LAS bf16x8*)(lds + PG8_SA(b, h) + aoff + m * 2048 + k * 1024); } while (0)
#define PG8_LDB(dst, b, h) do { _Pragma("unroll") for (int n = 0; n < 2; ++n) _Pragma("unroll") for (int k = 0; k < 2; ++k) dst[n][k] = *(const PG8_LAS bf16x8*)(lds + PG8_SB(b, h) + boff + n * 2048 + k * 1024); } while (0)
#define PG8_MMA(ai, bj, At, Bt) do { __builtin_amdgcn_s_setprio(1); _Pragma("unroll") for (int m = 0; m < 4; ++m) _Pragma("unroll") for (int n = 0; n < 2; ++n) _Pragma("unroll") for (int k = 0; k < 2; ++k) \
        acc[ai][bj][m][n] = __builtin_amdgcn_mfma_f32_16x16x32_bf16(Bt[n][k], At[m][k], acc[ai][bj][m][n], 0, 0, 0); __builtin_amdgcn_s_setprio(0); } while (0)
#define PG8_WAIT_V(n) asm volatile("s_waitcnt vmcnt(" #n ")" ::: "memory")
#define PG8_WAIT_L(n) asm volatile("s_waitcnt lgkmcnt(" #n ")" ::: "memory")
#define PG8_BAR __builtin_amdgcn_s_barrier()
#define PG8_SCHED __builtin_amdgcn_sched_barrier(0)
    Unit cur, nxt; int ui = 0;
    if (!S.next(0, cur)) return;
    f32x4 acc[2][2][4][2];
#pragma unroll
    for (int a = 0; a < 2; ++a)
#pragma unroll
        for (int b = 0; b < 2; ++b)
#pragma unroll
            for (int m = 0; m < 4; ++m)
#pragma unroll
                for (int n = 0; n < 2; ++n) acc[a][b][m][n] = (f32x4){0.f, 0.f, 0.f, 0.f};
    bf16x8 At[4][2], B0[2][2], B1[2][2];
    const char* cA = (const char*)g.A + (size_t)cur.pm * tstepA; const char* cB = (const char*)g.Bt + (size_t)cur.pn * tstepB;
    PG8_STAGE(PG8_SB(0, 0), cB, voffB); PG8_STAGE(PG8_SB(0, 1), cB + hstepB, voffB); PG8_STAGE(PG8_SA(0, 0), cA, voffA); PG8_STAGE(PG8_SA(0, 1), cA + hstepA, voffA);
    if (wr == 1) PG8_BAR;
    PG8_WAIT_V(2); PG8_BAR;
    PG8_STAGE(PG8_SB(1, 0), cB + kstep, voffB); PG8_STAGE(PG8_SA(1, 0), cA + kstep, voffA); PG8_STAGE(PG8_SB(1, 1), cB + hstepB + kstep, voffB);
    PG8_WAIT_V(6); PG8_BAR;
    for (;;) {
        const bool has_next = S.next(ui + 1, nxt);
        const char* nA = has_next ? (const char*)g.A + (size_t)nxt.pm * tstepA : cA; const char* nB = has_next ? (const char*)g.Bt + (size_t)nxt.pn * tstepB : cB;
#pragma unroll 1
        for (int t = 0; t < nt; t += 2) {
            if constexpr (Epi::MIDSCALE) { if (t == nt / 2) E.mid(acc, cur); }
            const bool last = (t == nt - 2);
            const char* a1 = cA + (size_t)(t + 1) * kstep;
            const char* a2 = last ? nA : cA + (size_t)(t + 2) * kstep; const char* b2 = last ? nB : cB + (size_t)(t + 2) * kstep;
            const char* a3 = a2 + kstep; const char* b3 = b2 + kstep;
            PG8_LDB(B0, 0, 0); PG8_LDB(B1, 0, 1); PG8_SCHED; PG8_LDA(At, 0, 0); PG8_STAGE(PG8_SA(1, 1), a1 + hstepA, voffA);
            PG8_WAIT_V(8); PG8_WAIT_L(0); PG8_BAR; PG8_MMA(0, 0, At, B0); PG8_MMA(0, 1, At, B1); PG8_BAR; PG8_SCHED;
            PG8_LDA(At, 0, 1); PG8_STAGE(PG8_SB(0, 0), b2, voffB); PG8_STAGE(PG8_SB(0, 1), b2 + hstepB, voffB); PG8_STAGE(PG8_SA(0, 0), a2, voffA);
            PG8_WAIT_V(8); PG8_WAIT_L(0); PG8_BAR; PG8_MMA(1, 0, At, B0); PG8_MMA(1, 1, At, B1); PG8_BAR; PG8_SCHED;
            PG8_LDB(B0, 1, 0); PG8_LDB(B1, 1, 1); PG8_SCHED; PG8_LDA(At, 1, 0); PG8_STAGE(PG8_SA(0, 1), a2 + hstepA, voffA);
            PG8_WAIT_V(8); PG8_WAIT_L(0); PG8_BAR; PG8_MMA(0, 0, At, B0); PG8_MMA(0, 1, At, B1); PG8_BAR; PG8_SCHED;
            PG8_LDA(At, 1, 1); PG8_STAGE(PG8_SB(1, 0), b3, voffB); PG8_STAGE(PG8_SB(1, 1), b3 + hstepB, voffB); PG8_STAGE(PG8_SA(1, 0), a3, voffA);
            PG8_WAIT_V(8); PG8_WAIT_L(0); PG8_BAR; PG8_MMA(1, 0, At, B0); PG8_MMA(1, 1, At, B1); PG8_BAR; PG8_SCHED;
        }
        if (wr == 0) PG8_BAR;
        E(acc, cur, wr, wc, fr, fq);
        if (!has_next) break;
#pragma unroll
        for (int a = 0; a < 2; ++a)
#pragma unroll
            for (int b = 0; b < 2; ++b)
#pragma unroll
                for (int m = 0; m < 4; ++m)
#pragma unroll
                    for (int n = 0; n < 2; ++n) acc[a][b][m][n] = (f32x4){0.f, 0.f, 0.f, 0.f};
        cur = nxt; cA = nA; cB = nB; ++ui;
        if (wr == 1) PG8_BAR;
    }
    PG8_WAIT_V(0);
    PG8_BAR;
#undef PG8_SA
#undef PG8_SB
#undef PG8_STAGE
#undef PG8_LDA
#undef PG8_LDB
#undef PG8_MMA
#undef PG8_WAIT_V
#undef PG8_WAIT_L
#undef PG8_BAR
#undef PG8_SCHED
}
}

typedef unsigned short bf16;
typedef short bf16x8 __attribute__((ext_vector_type(8)));
typedef short s16x4 __attribute__((ext_vector_type(4)));
typedef float f32x16 __attribute__((ext_vector_type(16)));
typedef float f32x4 __attribute__((ext_vector_type(4)));
typedef float f32x2 __attribute__((ext_vector_type(2)));
typedef unsigned u32x4 __attribute__((ext_vector_type(4)));
typedef unsigned u32x2 __attribute__((ext_vector_type(2)));
#define LAS __attribute__((address_space(3)))

constexpr int BATCH = 4, SEQ = 8192, DM = 1024, M = BATCH * SEQ, NH = 8;
constexpr int D_IN = 4768, PITCH = 4864;
constexpr int C_RQ = 0, C_RK = 512, C_RV = 1024, C_MG = 2048, C_RG = 3072, C_CQ = 4096, C_CKV = 4480, C_KR = 4736;
constexpr float EPS = 1e-6f;
constexpr float QSC = 0.10206207261596575f * 1.4426950408889634f;
constexpr float LOG2E = 1.4426950408889634f;
constexpr int NTHREADS = 512, NWAVES = 8;

constexpr size_t MiB = 1u << 20;
constexpr size_t WS_PROJ = 0;
constexpr size_t WS_K = 304 * MiB;
constexpr size_t WS_V = 352 * MiB;
constexpr size_t WS_WIN = 416 * MiB;
constexpr size_t WS_WQ = 426 * MiB;
constexpr size_t WS_WKV = 427 * MiB;
constexpr size_t WS_WO = 428 * MiB;
constexpr size_t WS_CS64 = 432 * MiB;
constexpr size_t WS_CS32 = 440 * MiB;
constexpr size_t WS_MOD = 444 * MiB;
constexpr size_t WS_STAT = 445 * MiB;
constexpr size_t WS_SS = 447 * MiB;
constexpr size_t WS_BAR = 446 * MiB;
constexpr size_t WS_END = 448 * MiB;
constexpr size_t OUT_QO = 0, OUT_KVS = 64 * MiB;

constexpr int LDS_BYTES = 135168;
constexpr int LDS_CTL_OFF = 133120;

struct Params { const float* in[20]; float* out; unsigned char* ws; };

__device__ __forceinline__ unsigned cvtpk(float lo, float hi) { return pg8::cvt_pk_bf16(lo, hi); }
__device__ __forceinline__ float bf_lo(unsigned w) { return __uint_as_float(w << 16); }
__device__ __forceinline__ float bf_hi(unsigned w) { return __uint_as_float(w & 0xffff0000u); }
__device__ __forceinline__ float wave_sum(float v) {
#pragma unroll
    for (int o = 1; o < 64; o <<= 1) v += __shfl_xor(v, o);
    return v;
}
__device__ __forceinline__ float silu_f(float v) { return v * __builtin_amdgcn_rcpf(1.f + __builtin_amdgcn_exp2f(-v * LOG2E)); }
__device__ __forceinline__ float sumsq8(u32x4 a) {
    float s = 0.f;
#pragma unroll
    for (int i = 0; i < 4; ++i) { const float x = bf_lo(a[i]), y = bf_hi(a[i]); s += x * x + y * y; }
    return s;
}

__device__ __forceinline__ int fresh_tid() { int t = threadIdx.x; asm volatile("" : "+v"(t)); return t; }
#define EPI_LANES() const int t_ = fresh_tid(), l_ = t_ & 63, wi_ = t_ >> 6, wr = wi_ >> 2, wc = wi_ & 3, fr = l_ & 15, fq = l_ >> 4


#define RLX_AGENT __ATOMIC_RELAXED, __HIP_MEMORY_SCOPE_AGENT
#define XB_TMO      128
#define XB_XCNT(j)  (256  + 64 * (j))
#define XB_XSUB(j)  (1280 + 64 * (j))
#define XB_XGEN(j)  (2304 + 64 * (j))
#define XB_TOP      3328
#define XB_TOPGEN   3392
#define XCD_BAR_WORDS 3456
#define XB_SPIN_CAP (1u << 18)

__device__ __forceinline__ unsigned xb_ld(unsigned* p)              { return __hip_atomic_load(p, __ATOMIC_RELAXED, __HIP_MEMORY_SCOPE_AGENT); }
__device__ __forceinline__ unsigned xb_add(unsigned* p, unsigned v) { return __hip_atomic_fetch_add(p, v, __ATOMIC_RELAXED, __HIP_MEMORY_SCOPE_AGENT); }
__device__ __forceinline__ unsigned xb_xcc_id() { return (unsigned)__builtin_amdgcn_s_getreg((3 << 11) | 20) & 0xFu; }
#define XB_SPIN(cond, bar) do { unsigned _sp = 0; while (cond) { __builtin_amdgcn_s_sleep(1); \
    if ((++_sp & 255u) == 0u) { if (xb_ld(&(bar)[XB_TMO])) break; if (_sp > XB_SPIN_CAP) { atomicAdd(&(bar)[XB_TMO], 1u); break; } } } } while (0)

struct XcdBarrier {
    unsigned* bar; unsigned x;
    volatile LAS unsigned* st;
};

__device__ __forceinline__ XcdBarrier xcd_barrier_post(unsigned* bar, volatile LAS unsigned* st) {
    XcdBarrier b; b.bar = bar; b.x = xb_xcc_id(); b.st = st;
    if (threadIdx.x == 0) (void)xb_add(&bar[XB_XCNT(b.x)], 1u);
    return b;
}
__device__ __forceinline__ void xcd_barrier_complete(unsigned* bar, unsigned x, unsigned& nloc, unsigned& nx) {
    const unsigned G = gridDim.x * gridDim.y * gridDim.z;
    unsigned sum, cnt, mine, sp = 0u;
    for (;;) {
        sum = 0u; cnt = 0u; mine = 0u;
#pragma unroll
        for (unsigned j = 0; j < 16; ++j) { const unsigned c = xb_ld(&bar[XB_XCNT(j)]); sum += c; cnt += (c > 0u) ? 1u : 0u; mine = (j == x) ? c : mine; }
        if (sum == G) break;
        __builtin_amdgcn_s_sleep(1);
        if ((++sp & 255u) == 0u) { if (xb_ld(&bar[XB_TMO])) break; if (sp > XB_SPIN_CAP) { atomicAdd(&bar[XB_TMO], 1u); break; } }
    }
    nloc = mine > 0u ? mine : 1u; nx = cnt > 0u ? cnt : 1u;
}

__device__ __forceinline__ void xcd_barrier(const XcdBarrier& b) {
    asm volatile("s_waitcnt vmcnt(0)" ::: "memory");
    __syncthreads();
    if (threadIdx.x == 0) {
        unsigned* bar = b.bar;
        __builtin_amdgcn_s_waitcnt(0);
        unsigned nloc = b.st[0], nx = b.st[1];
        if (nloc == 0u) { xcd_barrier_complete(bar, b.x, nloc, nx); b.st[0] = nloc; b.st[1] = nx; }
        const unsigned old = xb_add(&bar[XB_XSUB(b.x)], 1u);
        const unsigned gen = old / nloc;
        if (old + 1u == (gen + 1u) * nloc) {
            __builtin_amdgcn_fence(__ATOMIC_RELEASE, "agent");
            asm volatile("s_waitcnt vmcnt(0)" ::: "memory");
            const unsigned og = xb_add(&bar[XB_TOP], 1u);
            const unsigned tg = og / nx;
            if (og + 1u == (tg + 1u) * nx) xb_add(&bar[XB_TOPGEN], 1u);
            else XB_SPIN(xb_ld(&bar[XB_TOPGEN]) == tg, bar);
            __builtin_amdgcn_fence(__ATOMIC_ACQUIRE, "agent");
            xb_add(&bar[XB_XGEN(b.x)], 1u);
            asm volatile("s_waitcnt vmcnt(0)" ::: "memory");
        } else {
            XB_SPIN(xb_ld(&bar[XB_XGEN(b.x)]) == gen, bar);
            __builtin_amdgcn_fence(__ATOMIC_ACQUIRE, "agent");
            asm volatile("s_waitcnt vmcnt(0)" ::: "memory");
        }
    }
    __syncthreads();
}


__device__ __forceinline__ int win_colmap(int n) {
    if (n < 1024) { const int base = n & ~63, j = n & 63; return base + (j >> 1) + 32 * (j & 1); }
    if (n < 2048) return n;
    if (n < 3072) return 3744 + (n - 2048);
    if (n < 4096) return 2048 + (n - 3072);
    if (n < 4480) return 3072 + (n - 4096);
    if (n < 4736) return 3456 + (n - 4480);
    if (n < 4768) return 3712 + (n - 4736);
    return -1;
}
__device__ __forceinline__ int nope_map(int n, int per_head) {
    const int t = n >> 8, c = n & 255, bj = c >> 7, wc = (c >> 5) & 3, j = c & 31;
    return (4 * t + wc) * per_head + 32 * bj + j;
}
__device__ __forceinline__ int wq_colmap(int n) {
    if (n < 512) return nope_map(n, 96);
    const int c = n - 512, head = c >> 5, j = c & 31; return head * 96 + 64 + (j >> 1) + 16 * (j & 1);
}
__device__ __forceinline__ int wkv_colmap(int n) {
    if (n < 512) return nope_map(n, 192);
    const int c = n - 512, head = c >> 7, dim = c & 127; return head * 192 + 64 + dim;
}

struct EpiIn {
    static constexpr bool PERM = true, MIDSCALE = false;
    bf16* P; const float* cs64;
    __device__ __forceinline__ void operator()(const pg8::f32x4 (&acc)[2][2][4][2], const pg8::Unit& u, int, int, int, int) const {
        EPI_LANES();
        const int row0 = u.pm * 256 + wr * 64 + fr, colt = u.pn * 256, cl = wc * 32 + 8 * fq;
        const int mode = u.pn < 4 ? 1 : ((u.pn >= 8 && u.pn < 16) ? 2 : 0);
        const float rs = u.pn < 2 ? 1.f : 0.125f;
        const int p0 = (wc & 1) * 16 + 4 * fq;
        f32x4 n0 = {1.f, 0.f, 1.f, 0.f}, n1 = {1.f, 0.f, 1.f, 0.f};
        if (mode == 1) { const f32x4* t = (const f32x4*)(cs64 + ((size_t)row0 * 32 + p0) * 2); n0 = t[0]; n1 = t[1]; }
#pragma unroll
        for (int ai = 0; ai < 2; ++ai)
#pragma unroll
            for (int m = 0; m < 4; ++m) {
                const int row = row0 + ai * 128 + m * 16;
                bf16* rowp = P + (size_t)row * PITCH + colt + cl;
                const f32x4 c0 = n0, c1 = n1;
                if (mode == 1 && (ai * 4 + m) < 7) { const int rown = row0 + ((ai * 4 + m + 1) >> 2) * 128 + ((ai * 4 + m + 1) & 3) * 16;
                    const f32x4* t = (const f32x4*)(cs64 + ((size_t)rown * 32 + p0) * 2); n0 = t[0]; n1 = t[1]; }
#pragma unroll
                for (int bj = 0; bj < 2; ++bj) {
                    f32x4 v0 = acc[ai][bj][m][0], v1 = acc[ai][bj][m][1];
                    if (mode == 1) {
                        f32x4 o0, o1;
                        o0[0] = (v0[0] * c0[0] - v0[1] * c0[1]) * rs; o0[1] = (v0[1] * c0[0] + v0[0] * c0[1]) * rs;
                        o0[2] = (v0[2] * c0[2] - v0[3] * c0[3]) * rs; o0[3] = (v0[3] * c0[2] + v0[2] * c0[3]) * rs;
                        o1[0] = (v1[0] * c1[0] - v1[1] * c1[1]) * rs; o1[1] = (v1[1] * c1[0] + v1[0] * c1[1]) * rs;
                        o1[2] = (v1[2] * c1[2] - v1[3] * c1[3]) * rs; o1[3] = (v1[3] * c1[2] + v1[2] * c1[3]) * rs;
                        v0 = o0; v1 = o1;
                    } else if (mode == 2) {
#pragma unroll
                        for (int i = 0; i < 4; ++i) { v0[i] = silu_f(v0[i]); v1[i] = silu_f(v1[i]); }
                    }
                    u32x4 w; w.x = cvtpk(v0[0], v0[1]); w.y = cvtpk(v0[2], v0[3]); w.z = cvtpk(v1[0], v1[1]); w.w = cvtpk(v1[2], v1[3]);
                    *(u32x4*)(rowp + bj * 128) = w;
                }
                asm volatile("" ::: "memory");
            }
    }
};

template <int MODE> struct EpiUp {
    static constexpr bool IS_Q = MODE != 2, MIDSCALE = false;
    static constexpr bool PERM = true;
    bf16* O;
    bf16* Vo;
    const f32x2* stat;
    const float* wn;
    const float* wr_;
    const float* cs32;
    __device__ __forceinline__ void operator()(const pg8::f32x4 (&acc)[2][2][4][2], const pg8::Unit& u, int, int, int, int) const {
        EPI_LANES();
        const int row0 = u.pm * 256 + wr * 64 + fr;
        const int b = row0 / SEQ;
        constexpr int OP = IS_Q ? 128 : 96;
        float ms8[8];
#pragma unroll
        for (int i = 0; i < 8; ++i) { const f32x2 st = stat[row0 + (i >> 2) * 128 + (i & 3) * 16]; ms8[i] = IS_Q ? st.x : st.y; }
        if (MODE == 0 || ((MODE == 2 || MODE == 3) && u.pn < 2)) {
            const int head = 4 * u.pn + wc;
            const f32x4 w00 = *(const f32x4*)(wn + 8 * fq), w01 = *(const f32x4*)(wn + 8 * fq + 4), w10 = *(const f32x4*)(wn + 32 + 8 * fq), w11 = *(const f32x4*)(wn + 36 + 8 * fq);
#pragma unroll
            for (int ai = 0; ai < 2; ++ai)
#pragma unroll
                for (int m = 0; m < 4; ++m) {
                    const int row = row0 + ai * 128 + m * 16;
                    const f32x4 a0 = acc[ai][0][m][0], a1 = acc[ai][0][m][1], b0 = acc[ai][1][m][0], b1 = acc[ai][1][m][1];
                    float ss = 0.f;
#pragma unroll
                    for (int i = 0; i < 4; ++i) ss += a0[i] * a0[i] + a1[i] * a1[i] + b0[i] * b0[i] + b1[i] * b1[i];
                    ss += __shfl_xor(ss, 16); ss += __shfl_xor(ss, 32);
                    const float ms = ms8[ai * 4 + m];
                    const float sc = __builtin_amdgcn_rsqf(ss * (1.f / 64.f) + EPS * (ms + EPS)) * (IS_Q ? QSC : 1.f);
                    bf16* op = O + ((size_t)(b * NH + head) * SEQ + (row - b * SEQ)) * OP;
                    const f32x4 x0 = a0 * sc * w00, x1 = a1 * sc * w01, y0 = b0 * sc * w10, y1 = b1 * sc * w11;
                    u32x4 w; w.x = cvtpk(x0[0], x0[1]); w.y = cvtpk(x0[2], x0[3]); w.z = cvtpk(x1[0], x1[1]); w.w = cvtpk(x1[2], x1[3]);
                    *(u32x4*)(op + 8 * fq) = w;
                    w.x = cvtpk(y0[0], y0[1]); w.y = cvtpk(y0[2], y0[3]); w.z = cvtpk(y1[0], y1[1]); w.w = cvtpk(y1[2], y1[3]);
                    *(u32x4*)(op + 32 + 8 * fq) = w;
                }
        } else if (MODE == 1 || MODE == 3) {
            const f32x4 wl = *(const f32x4*)(wr_ + 4 * fq), wh = *(const f32x4*)(wr_ + 16 + 4 * fq);
            f32x4 n0, n1; { const f32x4* t = (const f32x4*)(cs32 + ((size_t)row0 * 16 + 4 * fq) * 2); n0 = t[0]; n1 = t[1]; }
#pragma unroll
            for (int ai = 0; ai < 2; ++ai)
#pragma unroll
                for (int m = 0; m < 4; ++m) {
                    const int row = row0 + ai * 128 + m * 16;
                    const float epsq = EPS * (ms8[ai * 4 + m] + EPS);
                    const f32x4 c0 = n0, c1 = n1;
                    if ((ai * 4 + m) < 7) { const int rown = row0 + ((ai * 4 + m + 1) >> 2) * 128 + ((ai * 4 + m + 1) & 3) * 16;
                        const f32x4* t = (const f32x4*)(cs32 + ((size_t)rown * 16 + 4 * fq) * 2); n0 = t[0]; n1 = t[1]; }
#pragma unroll
                    for (int bj = 0; bj < 2; ++bj) {
                        const f32x4 v0 = acc[ai][bj][m][0], v1 = acc[ai][bj][m][1];
                        float ss = 0.f;
#pragma unroll
                        for (int i = 0; i < 4; ++i) ss += v0[i] * v0[i] + v1[i] * v1[i];
                        ss += __shfl_xor(ss, 16); ss += __shfl_xor(ss, 32);
                        const float sc = __builtin_amdgcn_rsqf(ss * (1.f / 32.f) + epsq) * QSC;
                        const float x1a = v0[0] * sc * wl[0], x2a = v0[1] * sc * wh[0], x1b = v0[2] * sc * wl[1], x2b = v0[3] * sc * wh[1];
                        const float x1c = v1[0] * sc * wl[2], x2c = v1[1] * sc * wh[2], x1d = v1[2] * sc * wl[3], x2d = v1[3] * sc * wh[3];
                        u32x4 w;
                        w.x = cvtpk(x1a * c0[0] - x2a * c0[1], x2a * c0[0] + x1a * c0[1]);
                        w.y = cvtpk(x1b * c0[2] - x2b * c0[3], x2b * c0[2] + x1b * c0[3]);
                        w.z = cvtpk(x1c * c1[0] - x2c * c1[1], x2c * c1[0] + x1c * c1[1]);
                        w.w = cvtpk(x1d * c1[2] - x2d * c1[3], x2d * c1[2] + x1d * c1[3]);
                        const int head = 4 * bj + wc;
                        bf16* op = O + ((size_t)(b * NH + head) * SEQ + (row - b * SEQ)) * OP;
                        *(u32x4*)(op + 64 + 8 * fq) = w;
                    }
                    asm volatile("" ::: "memory");
                }
        } else {
#pragma unroll
            for (int ai = 0; ai < 2; ++ai)
#pragma unroll
                for (int m = 0; m < 4; ++m) {
                    const int row = row0 + ai * 128 + m * 16;
                    const float sc = __builtin_amdgcn_rsqf(ms8[ai * 4 + m] + EPS);
#pragma unroll
                    for (int bj = 0; bj < 2; ++bj) {
                        const f32x4 v0 = acc[ai][bj][m][0] * sc, v1 = acc[ai][bj][m][1] * sc;
                        const int head = 2 * (u.pn - 2) + bj;
                        bf16* op = Vo + ((size_t)(b * NH + head) * SEQ + (row - b * SEQ)) * 128 + 32 * wc + 8 * fq;
                        u32x4 w; w.x = cvtpk(v0[0], v0[1]); w.y = cvtpk(v0[2], v0[3]); w.z = cvtpk(v1[0], v1[1]); w.w = cvtpk(v1[2], v1[3]);
                        *(u32x4*)op = w;
                    }
                }
        }
    }
};

struct EpiOut {
    static constexpr bool PERM = false, MIDSCALE = true;
    const float* x; float* out; const float* mod; const float* ss;
    __device__ __forceinline__ void mid(pg8::f32x4 (&acc)[2][2][4][2], const pg8::Unit& u) const {
        EPI_LANES(); (void)wc; (void)fq;
        const int row0 = u.pm * 256 + wr * 64 + fr;
#pragma unroll
        for (int ai = 0; ai < 2; ++ai)
#pragma unroll
            for (int m = 0; m < 4; ++m) {
                const f32x4* sp = (const f32x4*)(ss + (size_t)(row0 + ai * 128 + m * 16) * 8);
                const f32x4 s0 = sp[0], s1 = sp[1];
                const float rstd = __builtin_amdgcn_rsqf(((s0[0] + s0[1]) + (s0[2] + s0[3]) + (s1[0] + s1[1]) + (s1[2] + s1[3])) * (1.f / 1024.f) + EPS);
#pragma unroll
                for (int bj = 0; bj < 2; ++bj)
#pragma unroll
                    for (int n = 0; n < 2; ++n) acc[ai][bj][m][n] *= rstd;
            }
    }
    __device__ __forceinline__ void operator()(const pg8::f32x4 (&acc)[2][2][4][2], const pg8::Unit& u, int, int, int, int) const {
        EPI_LANES();
        const int row0 = u.pm * 256 + wr * 64 + fr, b = row0 / SEQ;
        const int col0 = u.pn * 256 + wc * 32 + 4 * fq;
        f32x4 gv[2][2];
#pragma unroll
        for (int bj = 0; bj < 2; ++bj)
#pragma unroll
            for (int n = 0; n < 2; ++n) gv[bj][n] = *(const f32x4*)(mod + b * 3072 + 2048 + col0 + bj * 128 + n * 16);
#pragma unroll
        for (int ai = 0; ai < 2; ++ai)
#pragma unroll
            for (int m = 0; m < 4; ++m) {
                const size_t off = (size_t)(row0 + ai * 128 + m * 16) * DM + col0;
#pragma unroll
                for (int bj = 0; bj < 2; ++bj)
#pragma unroll
                    for (int n = 0; n < 2; ++n) {
                        const f32x4 xv = *(const f32x4*)(x + off + bj * 128 + n * 16);
                        *(f32x4*)(out + off + bj * 128 + n * 16) = xv + gv[bj][n] * acc[ai][bj][m][n];
                    }
            }
    }
};

#define KSWZ(row, colB) ((row) * 256 + ((colB) ^ (((row) & 7) << 4)))
#define SBAR() __builtin_amdgcn_sched_barrier(0)
constexpr int KVBLK = 64;
constexpr size_t SHM_V = KVBLK * 128 * 2, SHM_K = KVBLK * 128 * 2;
constexpr float ATT_SCALE = 0.10206207261596575f;
constexpr float THR = 8.f;
__device__ __forceinline__ f32x16 zero16() { float z; asm volatile("v_mov_b32 %0, 0" : "=v"(z)); f32x16 r;
#pragma unroll
    for (int i = 0; i < 16; ++i) r[i] = z;
    return r; }
__device__ __forceinline__ int crow(int r, int hi) { return (r & 3) + 8 * (r >> 2) + 4 * hi; }
__device__ __forceinline__ int v_st(int k, int c) { const int kk = (k & ~0xC) | ((k & 4) << 1) | ((k & 8) >> 1); return ((kk >> 3) * 4 + (c >> 5)) * 512 + ((kk & 7) * 32 + (c & 31)) * 2; }
__device__ __forceinline__ int v_st_raw(int k, int c) { return ((k >> 3) * 4 + (c >> 5)) * 512 + ((k & 7) * 32 + (c & 31)) * 2; }
__device__ __forceinline__ int v_rd_base(int lane) { return ((lane & 3) << 3) | (((lane >> 2) & 3) << 6) | (((lane >> 4) & 1) << 5) | (((lane >> 5) & 1) << 8); }
constexpr int v_rd_off(int d0, int ks, int half) { return d0 * 512 + ks * 4096 + half * 2048; }
template <int OFF> __device__ __forceinline__ s16x4 tr_read(int vb) {
    s16x4 r; asm volatile("ds_read_b64_tr_b16 %0, %1 offset:%2" : "=&v"(r) : "v"(vb), "i"(OFF) : "memory"); return r;
}
#define PKF(L, H) (bf16x8){L[0], L[1], L[2], L[3], H[0], H[1], H[2], H[3]}
template <int D0> __device__ __forceinline__ void pv_one(f32x16& od, int vb, bf16x8 pa0, bf16x8 pa1, bf16x8 pa2, bf16x8 pa3) {
    const s16x4 l0 = tr_read<v_rd_off(D0, 0, 0)>(vb), h0 = tr_read<v_rd_off(D0, 0, 1)>(vb), l1 = tr_read<v_rd_off(D0, 1, 0)>(vb), h1 = tr_read<v_rd_off(D0, 1, 1)>(vb);
    const s16x4 l2 = tr_read<v_rd_off(D0, 2, 0)>(vb), h2 = tr_read<v_rd_off(D0, 2, 1)>(vb), l3 = tr_read<v_rd_off(D0, 3, 0)>(vb), h3 = tr_read<v_rd_off(D0, 3, 1)>(vb);
    asm volatile("s_waitcnt lgkmcnt(0)" ::: "memory"); SBAR();
    od = __builtin_amdgcn_mfma_f32_32x32x16_bf16(pa0, PKF(l0, h0), od, 0, 0, 0);
    od = __builtin_amdgcn_mfma_f32_32x32x16_bf16(pa1, PKF(l1, h1), od, 0, 0, 0);
    od = __builtin_amdgcn_mfma_f32_32x32x16_bf16(pa2, PKF(l2, h2), od, 0, 0, 0);
    od = __builtin_amdgcn_mfma_f32_32x32x16_bf16(pa3, PKF(l3, h3), od, 0, 0, 0);
}
__device__ __forceinline__ void pv_d0(f32x16* o, int vb, bf16x8 pa0, bf16x8 pa1, bf16x8 pa2, bf16x8 pa3) {
    pv_one<0>(o[0], vb, pa0, pa1, pa2, pa3); pv_one<1>(o[1], vb, pa0, pa1, pa2, pa3); pv_one<2>(o[2], vb, pa0, pa1, pa2, pa3); pv_one<3>(o[3], vb, pa0, pa1, pa2, pa3);
}
#define PK4(P, BASE, OUT) do { u32x4 w = {cvtpk(P[BASE + 0], P[BASE + 1]), cvtpk(P[BASE + 2], P[BASE + 3]), cvtpk(P[BASE + 4], P[BASE + 5]), cvtpk(P[BASE + 6], P[BASE + 7])}; \
    OUT = *reinterpret_cast<bf16x8*>(&w); } while (0)

__device__ __forceinline__ void partialSM(f32x16& p0, f32x16& p1) {
    (void)p1;
#pragma unroll
    for (int r = 0; r < 16; ++r) p0[r] = __builtin_amdgcn_exp2f(p0[r]);
}
__device__ __forceinline__ void finishSM(f32x16& p0, f32x16& p1, float& l_reg, bf16x8& pa0, bf16x8& pa1, bf16x8& pa2, bf16x8& pa3) {
#pragma unroll
    for (int r = 0; r < 16; ++r) p1[r] = __builtin_amdgcn_exp2f(p1[r]);
    float ps = 0;
#pragma unroll
    for (int r = 0; r < 16; ++r) ps += p0[r];
#pragma unroll
    for (int r = 0; r < 16; ++r) ps += p1[r];
    { auto rr = __builtin_amdgcn_permlane32_swap(__float_as_uint(ps), __float_as_uint(ps), false, false);
      ps = __uint_as_float(rr[0]) + __uint_as_float(rr[1]); }
    l_reg += ps;
    PK4(p0, 0, pa0); PK4(p0, 8, pa1); PK4(p1, 0, pa2); PK4(p1, 8, pa3);
}
__device__ __forceinline__ void qkt6(f32x16& p0, f32x16& p1, const char* Ks, const bf16x8* qr, int r32, int hi) {
    asm volatile("" : "+v"(r32));
    p0 = f32x16{}; p1 = f32x16{};
#pragma unroll
    for (int d0 = 0; d0 < 6; ++d0) { const int cb = (d0 * 16 + hi * 8) * 2;
        const bf16x8 b0 = *reinterpret_cast<const bf16x8*>(Ks + KSWZ(r32, cb));
        const bf16x8 b1 = *reinterpret_cast<const bf16x8*>(Ks + KSWZ(32 + r32, cb));
        p0 = __builtin_amdgcn_mfma_f32_32x32x16_bf16(b0, qr[d0], p0, 0, 0, 0);
        p1 = __builtin_amdgcn_mfma_f32_32x32x16_bf16(b1, qr[d0], p1, 0, 0, 0);
        asm volatile("" :: "v"(b0), "v"(b1), "v"(qr[d0])); }
}

__device__ __forceinline__ void attn_unit(bf16* __restrict__ QOb, const bf16* __restrict__ Kh, const bf16* __restrict__ Vh, int seq, char* lds,
                                          bf16* __restrict__ mgb  , float* __restrict__ ssb  , const float* __restrict__ wnh  ) {
    constexpr int LDQ = 128, LDKK = 96, LDV = 128;
    int tid_ = threadIdx.x; asm volatile("" : "+v"(tid_));
    const int tid = tid_, wid = tid >> 6, lane = tid & 63, r32 = lane & 31, hi = lane >> 5;
    char* V_lds = lds; char* K_lds = lds + 3 * SHM_V;
    float* ws = (float*)(lds + 3 * SHM_V + 3 * SHM_K) + wid * 64; float* li_l = ws;
    float l_reg = 0; f32x16 o[4] = {}; bf16x8 qr[6];
    const bf16* Qw = QOb + (long)(wid * 32 + r32) * LDQ + hi * 8;
#pragma unroll
    for (int d0 = 0; d0 < 6; ++d0) qr[d0] = *reinterpret_cast<const bf16x8*>(Qw + d0 * 16);
    const int sr = tid >> 4, sc = (tid & 15) * 8, vst0 = v_st_raw(sr, sc), vst1 = v_st_raw(32 + sr, sc);
    const int sck = sc < 96 ? sc : 88;
    const int vb0 = (int)(uintptr_t)V_lds + v_rd_base(lane);
    struct { bf16x8 vs0, vs1, ks0, ks1; } sr_[2];
    const char* Vhb = (const char*)Vh; const char* Khb = (const char*)Kh;
    const unsigned voV = (unsigned)(sr * LDV + sc) * 2u, voK = (unsigned)(sr * LDKK + sck) * 2u;
#define SLOAD(i, k0) do { const char* vt_ = Vhb + (size_t)(k0) * (LDV * 2); const char* kt_ = Khb + (size_t)(k0) * (LDKK * 2); \
    sr_[i].vs0 = *(const bf16x8*)(vt_ + voV); sr_[i].vs1 = *(const bf16x8*)(vt_ + 32 * LDV * 2 + voV); \
    sr_[i].ks0 = *(const bf16x8*)(kt_ + voK); sr_[i].ks1 = *(const bf16x8*)(kt_ + 32 * LDKK * 2 + voK); } while (0)
#define SWRITE(b, i) do {   *(bf16x8*)(V_lds + (b) * SHM_V + vst0) = sr_[i].vs0; *(bf16x8*)(V_lds + (b) * SHM_V + vst1) = sr_[i].vs1; const int kc = sc * 2; \
    *(bf16x8*)(K_lds + (b) * SHM_K + KSWZ(sr, kc)) = sr_[i].ks0; *(bf16x8*)(K_lds + (b) * SHM_K + KSWZ(32 + sr, kc)) = sr_[i].ks1; } while (0)
#define SWAIT() asm volatile("s_waitcnt vmcnt(4)" ::: "memory")
    f32x16 pA0, pA1, pB0, pB1; bf16x8 pa0, pa1, pa2, pa3; const int NT = seq / KVBLK;
    constexpr int SE = 0, SO = 1;
#define ASTEP(PC0, PC1, PP0, PP1, KS, VS, WS, RW, RL, LT, LCOND) do { \
        SBAR(); qkt6(PC0, PC1, K_lds + (KS) * SHM_K, qr, r32, hi); \
        finishSM(PP0, PP1, l_reg, pa0, pa1, pa2, pa3); SBAR(); \
        if (LCOND) SLOAD(RL, (LT) * KVBLK); SBAR(); \
        pv_d0(o, vb0 + (VS) * (int)SHM_V, pa0, pa1, pa2, pa3); partialSM(PC0, PC1); \
        SWRITE(WS, RW); __syncthreads(); } while (0)
    SLOAD(0, 0); SLOAD(1, KVBLK);
    SWRITE(0, 0); __syncthreads();
    SLOAD(0, 2 * KVBLK);
    qkt6(pA0, pA1, K_lds, qr, r32, hi); partialSM(pA0, pA1);
    SWRITE(1, 1); __syncthreads();
    for (int j = 1; j + 5 < NT; j += 6) {
        ASTEP(pB0, pB1, pA0, pA1, 1, 0, 2, 0, 1, j + 2, true);
        ASTEP(pA0, pA1, pB0, pB1, 2, 1, 0, 1, 0, j + 3, true);
        ASTEP(pB0, pB1, pA0, pA1, 0, 2, 1, 0, 1, j + 4, true);
        ASTEP(pA0, pA1, pB0, pB1, 1, 0, 2, 1, 0, j + 5, true);
        ASTEP(pB0, pB1, pA0, pA1, 2, 1, 0, 0, 1, j + 6, true);
        ASTEP(pA0, pA1, pB0, pB1, 0, 2, 1, 1, 0, j + 7, j + 7 < NT);
    }
    SBAR(); qkt6(pB0, pB1, K_lds + 1 * SHM_K, qr, r32, hi);
    finishSM(pA0, pA1, l_reg, pa0, pa1, pa2, pa3); SBAR();
    pv_d0(o, vb0 + 0 * (int)SHM_V, pa0, pa1, pa2, pa3); partialSM(pB0, pB1);
    finishSM(pB0, pB1, l_reg, pa0, pa1, pa2, pa3); SBAR();
    pv_d0(o, vb0 + 1 * (int)SHM_V, pa0, pa1, pa2, pa3);
    __syncthreads();
#undef ASTEP
    { const int t2_ = fresh_tid(), wid = t2_ >> 6, lane = t2_ & 63, r32 = lane & 31, hi = lane >> 5;
      float* li_l = (float*)(lds + 3 * SHM_V + 3 * SHM_K) + wid * 64;
      char* stg = lds + wid * 8192;
      if (hi == 0) li_l[r32] = l_reg; asm volatile("s_waitcnt lgkmcnt(0)" ::: "memory");
      float wv[4];
#pragma unroll
      for (int d0 = 0; d0 < 4; ++d0) wv[d0] = wnh[d0 * 32 + r32];
#pragma unroll
      for (int r = 0; r < 16; ++r) { const int orow = crow(r, hi); const float rl = __builtin_amdgcn_rcpf(li_l[orow]);
          const float a0 = o[0][r] * rl, a1 = o[1][r] * rl, a2 = o[2][r] * rl, a3 = o[3][r] * rl;
          float sq = (a0 * a0 + a1 * a1) + (a2 * a2 + a3 * a3);
#pragma unroll
          for (int ofs = 1; ofs < 32; ofs <<= 1) sq += __shfl_xor(sq, ofs);
          if (r32 == 0) ssb[(size_t)(wid * 32 + orow) * 8] = sq;
          bf16* sp = (bf16*)(stg + orow * 256) + r32;
          sp[0] = (bf16)(cvtpk(a0 * wv[0], 0.f) & 0xffffu); sp[32] = (bf16)(cvtpk(a1 * wv[1], 0.f) & 0xffffu);
          sp[64] = (bf16)(cvtpk(a2 * wv[2], 0.f) & 0xffffu); sp[96] = (bf16)(cvtpk(a3 * wv[3], 0.f) & 0xffffu); }
      const char* gbase = (const char*)(mgb + (size_t)(wid * 32) * PITCH);
      const unsigned goff = (unsigned)((lane >> 4) * PITCH + (lane & 15) * 8) * 2u;
      u32x4 gv[8];
#pragma unroll
      for (int k = 0; k < 8; ++k) gv[k] = *(const u32x4*)(gbase + (size_t)k * (4 * PITCH * 2) + goff);
#pragma unroll
      for (int k = 0; k < 8; ++k) {
          const u32x4 nv = *(const u32x4*)(stg + (4 * k + (lane >> 4)) * 256 + (lane & 15) * 16);
          u32x4 ov;
#pragma unroll
          for (int q = 0; q < 4; ++q) ov[q] = cvtpk(bf_lo(nv[q]) * bf_lo(gv[k][q]), bf_hi(nv[q]) * bf_hi(gv[k][q]));
          *(u32x4*)((char*)gbase + (size_t)k * (4 * PITCH * 2) + goff) = ov;
      } }
#undef SLOAD
#undef SWRITE
#undef SWAIT
}

__device__ __forceinline__ const char* uptr(const char* p) { const unsigned long long a = (unsigned long long)p;
    const unsigned lo = __builtin_amdgcn_readfirstlane((unsigned)a), hi = __builtin_amdgcn_readfirstlane((unsigned)(a >> 32));
    return (const char*)(((unsigned long long)hi << 32) | lo); }

__device__ __forceinline__ void ret_state_phase(const bf16* __restrict__ proj, bf16* __restrict__ kvs, const float* __restrict__ dl_f, const float* __restrict__ dl_b, int bid, int G, char* lds) {
    const int tid = fresh_tid(), wid = tid >> 6, lane = tid & 63, r32 = lane & 31, hi = lane >> 5;
    char* KX = lds;
    char* VT = lds + 32768;
    const unsigned koff = (unsigned)((tid >> 3) * PITCH + (tid & 7) * 8) * 2u, voff = (unsigned)((tid >> 4) * PITCH + (tid & 15) * 8) * 2u;
    const int rb = wid & 3, cg2 = wid >> 2;
    const int kb = (int)(uintptr_t)KX + v_rd_base(lane) + rb * 512;
    const int vb = (int)(uintptr_t)VT + v_rd_base(lane) + cg2 * 1024;
    u32x4 kreg[2], vreg[4];
#define RS_LOAD(U) do { const int bh_ = (U) >> 6, c_ = (U) & 63, b_ = bh_ >> 3, h_ = bh_ & 7; const size_t row0_ = (size_t)b_ * SEQ + (size_t)c_ * 128; \
        const char* kbase_ = (const char*)(proj + row0_ * PITCH + C_RK + h_ * 64); const char* vbase_ = (const char*)(proj + row0_ * PITCH + C_RV + h_ * 128); \
        _Pragma("unroll") for (int i = 0; i < 2; ++i) kreg[i] = *(const u32x4*)(uptr(kbase_ + (size_t)i * (64 * PITCH * 2)) + koff); \
        _Pragma("unroll") for (int i = 0; i < 4; ++i) vreg[i] = *(const u32x4*)(uptr(vbase_ + (size_t)i * (32 * PITCH * 2)) + voff); } while (0)
    int u = bid;
    if (u < BATCH * NH * 64) RS_LOAD(u);
    for (; u < BATCH * NH * 64; u += G) {
        const int bh = u >> 6, c = u & 63, h = bh & 7;
        const float lgf2 = -log1pf(expf(-dl_f[h])) * LOG2E, lgb2 = -log1pf(expf(-dl_b[h])) * LOG2E;
#pragma unroll
        for (int i = 0; i < 2; ++i) {
            const int key = (tid >> 3) + 64 * i, ch = tid & 7;
            const float df = __builtin_amdgcn_exp2f(lgf2 * (float)(127 - key)), db = __builtin_amdgcn_exp2f(lgb2 * (float)key);
            u32x4 wf, wb;
#pragma unroll
            for (int q = 0; q < 4; ++q) { const float x = bf_lo(kreg[i][q]), y = bf_hi(kreg[i][q]); wf[q] = cvtpk(x * df, y * df); wb[q] = cvtpk(x * db, y * db); }
            char* t = KX + (key >> 6) * 16384;
            *(u32x4*)(t + v_st(key & 63, ch * 8)) = wf;
            *(u32x4*)(t + v_st(key & 63, 64 + ch * 8)) = wb;
        }
#pragma unroll
        for (int i = 0; i < 4; ++i) {
            const int key = (tid >> 4) + 32 * i, ch = tid & 15;
            *(u32x4*)(VT + (key >> 6) * 16384 + v_st(key & 63, ch * 8)) = vreg[i];
        }
        __syncthreads();
        if (u + G < BATCH * NH * 64) RS_LOAD(u + G);
        f32x16 acc0 = {}, acc1 = {};
#define RS_STEP(T, KS) do { \
        const s16x4 al = tr_read<(T) * 16384 + (KS) * 4096>(kb), ah = tr_read<(T) * 16384 + (KS) * 4096 + 2048>(kb); \
        const s16x4 bl0 = tr_read<(T) * 16384 + (KS) * 4096>(vb), bh0 = tr_read<(T) * 16384 + (KS) * 4096 + 2048>(vb); \
        const s16x4 bl1 = tr_read<(T) * 16384 + (KS) * 4096 + 512>(vb), bh1 = tr_read<(T) * 16384 + (KS) * 4096 + 2048 + 512>(vb); \
        asm volatile("s_waitcnt lgkmcnt(0)" ::: "memory"); SBAR(); \
        acc0 = __builtin_amdgcn_mfma_f32_32x32x16_bf16(PKF(al, ah), PKF(bl0, bh0), acc0, 0, 0, 0); \
        acc1 = __builtin_amdgcn_mfma_f32_32x32x16_bf16(PKF(al, ah), PKF(bl1, bh1), acc1, 0, 0, 0); } while (0)
        RS_STEP(0, 0); RS_STEP(0, 1); RS_STEP(0, 2); RS_STEP(0, 3); RS_STEP(1, 0); RS_STEP(1, 1); RS_STEP(1, 2); RS_STEP(1, 3);
#undef RS_STEP
        const int dir = rb >> 1;
        bf16* op = kvs + (((size_t)(bh * 64 + c) * 2 + dir) * 64) * 128;
#pragma unroll
        for (int r = 0; r < 16; ++r) { const int dk = 32 * (rb & 1) + crow(r, hi);
            op[dk * 128 + (2 * cg2) * 32 + r32] = (bf16)(cvtpk(acc0[r], 0.f) & 0xffffu);
            op[dk * 128 + (2 * cg2 + 1) * 32 + r32] = (bf16)(cvtpk(acc1[r], 0.f) & 0xffffu); }
        __syncthreads();
    }
#undef RS_LOAD
}

__device__ __forceinline__ void ret_main_phase(bf16* __restrict__ proj, const bf16* __restrict__ kvs, const float* __restrict__ gnw, const float* __restrict__ dl_f, const float* __restrict__ dl_b, int bid, int G, char* lds) {
    const int tid = fresh_tid(), wid = tid >> 6, lane = tid & 63, r32 = lane & 31, hi = lane >> 5;
    char* KT = lds;
    char* VT = lds + 32768;
    const unsigned koff = (unsigned)((tid >> 3) * PITCH + (tid & 7) * 8) * 2u, voff = (unsigned)((tid >> 4) * PITCH + (tid & 15) * 8) * 2u;
    const int c = wid >> 2, iloc = 32 * (wid & 3) + r32;
    const unsigned qoff = (unsigned)((128 * c + iloc) * PITCH + hi * 8) * 2u;
    const int vb0 = (int)(uintptr_t)VT + v_rd_base(lane);
    u32x4 kreg[4], vreg[8]; bf16x8 qr[4];
#define RM_LOAD(U) do { const int bh_ = (U) >> 5, cp_ = (U) & 31, b_ = bh_ >> 3, h_ = bh_ & 7; const size_t row0_ = (size_t)b_ * SEQ + (size_t)cp_ * 256; \
        const char* kbase_ = (const char*)(proj + row0_ * PITCH + C_RK + h_ * 64); const char* vbase_ = (const char*)(proj + row0_ * PITCH + C_RV + h_ * 128); \
        const char* qbase_ = (const char*)(proj + row0_ * PITCH + C_RQ + h_ * 64); \
        _Pragma("unroll") for (int i = 0; i < 4; ++i) kreg[i] = *(const u32x4*)(uptr(kbase_ + (size_t)i * (64 * PITCH * 2)) + koff); \
        _Pragma("unroll") for (int i = 0; i < 8; ++i) vreg[i] = *(const u32x4*)(uptr(vbase_ + (size_t)i * (32 * PITCH * 2)) + voff); \
        _Pragma("unroll") for (int d0 = 0; d0 < 4; ++d0) qr[d0] = *(const bf16x8*)(uptr(qbase_ + d0 * 32) + qoff); } while (0)
    int u = bid;
    if (u < 1024) RM_LOAD(u);
    for (; u < 1024; u += G) {
        const int bh = u >> 5, cp = u & 31, b = bh >> 3, h = bh & 7;
        const float lgf2 = -log1pf(expf(-dl_f[h])) * LOG2E, lgb2 = -log1pf(expf(-dl_b[h])) * LOG2E;
        const size_t row0 = (size_t)b * SEQ + (size_t)cp * 256;
        int iloc_l = iloc, hi_l = hi; asm volatile("" : "+v"(iloc_l), "+v"(hi_l));
#pragma unroll
        for (int i = 0; i < 4; ++i) { const int key = (tid >> 3) + 64 * i, ch = tid & 7; *(u32x4*)(KT + key * 128 + ((ch ^ (key & 7)) << 4)) = kreg[i]; }
#pragma unroll
        for (int i = 0; i < 8; ++i) { const int key = (tid >> 4) + 32 * i, ch = tid & 15; *(u32x4*)(VT + (key >> 6) * 16384 + v_st_raw(key & 63, ch * 8)) = vreg[i]; }
        __syncthreads();
        u32x4 sreg[8];
        { const char* sbase = (const char*)(kvs + (size_t)(bh * 64 + 2 * cp) * (128 * 128));
#pragma unroll
          for (int i = 0; i < 8; ++i) sreg[i] = *(const u32x4*)(uptr(sbase + (size_t)i * 8192) + (unsigned)tid * 16u); }
        f32x16 o[4] = {};
#pragma unroll
        for (int kt = 0; kt < 2; ++kt) {
            const int T = 2 * c + kt;
            f32x16 p0 = {}, p1 = {};
#pragma unroll
            for (int d0 = 0; d0 < 4; ++d0) { const int ch = d0 * 2 + hi; const int k0 = T * 64 + r32, k1 = k0 + 32;
                const bf16x8 b0 = *(const bf16x8*)(KT + k0 * 128 + ((ch ^ (k0 & 7)) << 4));
                const bf16x8 b1 = *(const bf16x8*)(KT + k1 * 128 + ((ch ^ (k1 & 7)) << 4));
                p0 = __builtin_amdgcn_mfma_f32_32x32x16_bf16(b0, qr[d0], p0, 0, 0, 0);
                p1 = __builtin_amdgcn_mfma_f32_32x32x16_bf16(b1, qr[d0], p1, 0, 0, 0); }
#pragma unroll
            for (int r = 0; r < 16; ++r) {
                const int j0 = 64 * kt + crow(r, hi_l), d0_ = iloc_l - j0, d1_ = d0_ - 32;
                const float e0 = (d0_ >= 0 ? lgf2 : -lgb2) * (float)d0_;
                const float e1 = (d1_ >= 0 ? lgf2 : -lgb2) * (float)d1_;
                p0[r] *= __builtin_amdgcn_exp2f(e0); p1[r] *= __builtin_amdgcn_exp2f(e1);
            }
            bf16x8 pa0, pa1, pa2, pa3;
            PK4(p0, 0, pa0); PK4(p0, 8, pa1); PK4(p1, 0, pa2); PK4(p1, 8, pa3);
            pv_d0(o, vb0 + T * 16384, pa0, pa1, pa2, pa3);
        }
        __syncthreads();
#pragma unroll
        for (int i = 0; i < 8; ++i) { const int trow = (tid >> 4) + 32 * i, ch = tid & 15, tile = trow >> 6, dk = trow & 63;
            *(u32x4*)(VT + tile * 16384 + v_st(dk, ch * 8)) = sreg[i]; }
        __syncthreads();
#pragma unroll
        for (int dir = 0; dir < 2; ++dir) {
            const float dec = dir == 0 ? __builtin_amdgcn_exp2f(lgf2 * (float)(iloc_l + 1)) : __builtin_amdgcn_exp2f(lgb2 * (float)(128 - iloc_l));
            bf16x8 pa[4];
#pragma unroll
            for (int k = 0; k < 4; ++k) { const u32x4 w = *reinterpret_cast<const u32x4*>(&qr[k]); u32x4 o4;
#pragma unroll
                for (int q = 0; q < 4; ++q) o4[q] = cvtpk(bf_lo(w[q]) * dec, bf_hi(w[q]) * dec);
                pa[k] = *reinterpret_cast<bf16x8*>(&o4); }
            pv_d0(o, vb0 + (2 * c + dir) * 16384, pa[0], pa[1], pa[2], pa[3]);
        }
        if (u + G < 1024) RM_LOAD(u + G);
        __syncthreads();
        char* stg = VT + wid * 8192;
        float gw[4];
#pragma unroll
        for (int d0 = 0; d0 < 4; ++d0) gw[d0] = gnw[h * 128 + d0 * 32 + r32];
#pragma unroll
        for (int r = 0; r < 16; ++r) {
            float s1 = (o[0][r] + o[1][r]) + (o[2][r] + o[3][r]);
            float s2 = (o[0][r] * o[0][r] + o[1][r] * o[1][r]) + (o[2][r] * o[2][r] + o[3][r] * o[3][r]);
#pragma unroll
            for (int ofs = 1; ofs < 32; ofs <<= 1) { s1 += __shfl_xor(s1, ofs); s2 += __shfl_xor(s2, ofs); }
            const float mu = s1 * (1.f / 128.f), var = fmaxf(s2 * (1.f / 128.f) - mu * mu, 0.f), rs = __builtin_amdgcn_rsqf(var + EPS);
            bf16* sp = (bf16*)(stg + crow(r, hi_l) * 256) + r32;
#pragma unroll
            for (int d0 = 0; d0 < 4; ++d0) sp[d0 * 32] = (bf16)(cvtpk((o[d0][r] - mu) * rs * gw[d0], 0.f) & 0xffffu);
        }
        { const char* gbase = (const char*)(proj + (row0 + 128 * c + 32 * (wid & 3)) * PITCH + C_RG + h * 128);
          const unsigned goff = (unsigned)((lane >> 4) * PITCH + (lane & 15) * 8) * 2u;
          u32x4 gv[8];
#pragma unroll
          for (int k = 0; k < 8; ++k) gv[k] = *(const u32x4*)(uptr(gbase + (size_t)k * (4 * PITCH * 2)) + goff);
#pragma unroll
          for (int k = 0; k < 8; ++k) {
              const u32x4 nv = *(const u32x4*)(stg + (4 * k + (lane >> 4)) * 256 + (lane & 15) * 16);
              u32x4 ov;
#pragma unroll
              for (int q = 0; q < 4; ++q) ov[q] = cvtpk(bf_lo(nv[q]) * bf_lo(gv[k][q]), bf_hi(nv[q]) * bf_hi(gv[k][q]));
              *(u32x4*)((char*)uptr(gbase + (size_t)k * (4 * PITCH * 2)) + goff) = ov;
          } }
        __syncthreads();
    }
#undef RM_LOAD
}

__global__ void __launch_bounds__(NTHREADS) fwd_megakernel(Params p) {
    extern __shared__ __attribute__((aligned(16))) unsigned char lds[];
    cg::grid_group grid = cg::this_grid();
    const int G = gridDim.x, bid = blockIdx.x;
    const int NGW = G * NWAVES; const long NGT = (long)G * NTHREADS;
#define PHASE_IDS() const int tid = fresh_tid(), lane = tid & 63, wave = tid >> 6, gw = bid * NWAVES + wave; const long gt = (long)bid * NTHREADS + tid; (void)lane; (void)gw; (void)gt
    unsigned char* ws = p.ws;
    const float* x = p.in[0]; const float* cvec = p.in[1]; const int* positions = (const int*)p.in[2];
    const float* norm_w = p.in[3]; const float* w_ada = p.in[4]; const float* b_ada = p.in[5]; const float* w_in = p.in[6];
    const float* dl_f = p.in[7]; const float* dl_b = p.in[8]; const float* gn_w = p.in[9];
    const float* q_norm_w = p.in[10]; const float* w_uq = p.in[11]; const float* kv_norm_w = p.in[12]; const float* w_ukv = p.in[13];
    const float* qn_nope_w = p.in[14]; const float* qn_rope_w = p.in[15]; const float* kn_nope_w = p.in[16]; const float* kn_rope_w = p.in[17];
    const float* mla_norm_w = p.in[18]; const float* w_out = p.in[19];
    bf16* PROJ = (bf16*)(ws + WS_PROJ); bf16* KB = (bf16*)(ws + WS_K); bf16* VB = (bf16*)(ws + WS_V);
    bf16* WIN = (bf16*)(ws + WS_WIN); bf16* WQ = (bf16*)(ws + WS_WQ); bf16* WKV = (bf16*)(ws + WS_WKV); bf16* WO = (bf16*)(ws + WS_WO);
    float* CS64 = (float*)(ws + WS_CS64); float* CS32 = (float*)(ws + WS_CS32); float* MOD = (float*)(ws + WS_MOD); f32x2* STAT = (f32x2*)(ws + WS_STAT);
    float* SSB = (float*)(ws + WS_SS);
    bf16* HB = (bf16*)p.out; bf16* QO = (bf16*)((unsigned char*)p.out + OUT_QO); bf16* KVS = (bf16*)((unsigned char*)p.out + OUT_KVS);

    if (threadIdx.x < 4) ((volatile LAS unsigned*)((LAS unsigned char*)lds + LDS_CTL_OFF))[threadIdx.x] = 0u;
    __syncthreads();
    const XcdBarrier xbar = xcd_barrier_post((unsigned*)(ws + WS_BAR), (volatile LAS unsigned*)((LAS unsigned char*)lds + LDS_CTL_OFF));
#define GRID_BAR() xcd_barrier(xbar)
    {
        PHASE_IDS();
        float* sc = (float*)lds; float* red = (float*)(lds + 16384);
        for (int it = bid; it < 192; it += G) {
            for (int i = tid; i < 4096; i += NTHREADS) sc[i] = silu_f(cvec[i]);
            __syncthreads();
            const int ks4 = lane >> 4, col = lane & 15, kb0 = wave * 128 + ks4 * 32;
            const float* wp = w_ada + (size_t)kb0 * 3072 + it * 16 + col;
            float a0 = 0.f, a1 = 0.f, a2 = 0.f, a3 = 0.f;
#pragma unroll 8
            for (int i = 0; i < 32; ++i) { const float wv = wp[(size_t)i * 3072]; const int k = kb0 + i;
                a0 += sc[k] * wv; a1 += sc[1024 + k] * wv; a2 += sc[2048 + k] * wv; a3 += sc[3072 + k] * wv; }
            a0 += __shfl_xor(a0, 16); a0 += __shfl_xor(a0, 32); a1 += __shfl_xor(a1, 16); a1 += __shfl_xor(a1, 32);
            a2 += __shfl_xor(a2, 16); a2 += __shfl_xor(a2, 32); a3 += __shfl_xor(a3, 16); a3 += __shfl_xor(a3, 32);
            if (lane < 16) { red[(wave * 4 + 0) * 16 + lane] = a0; red[(wave * 4 + 1) * 16 + lane] = a1; red[(wave * 4 + 2) * 16 + lane] = a2; red[(wave * 4 + 3) * 16 + lane] = a3; }
            __syncthreads();
            if (tid < 64) { const int bb = tid >> 4, l = tid & 15; float s = b_ada[it * 16 + l];
#pragma unroll
                for (int w = 0; w < 8; ++w) s += red[(w * 4 + bb) * 16 + l];
                MOD[bb * 3072 + it * 16 + l] = s; }
            __syncthreads();
        }
    }
    if (p.ws == nullptr) grid.sync();
    GRID_BAR();
#if PROBE_DUP == 4
    for (int rep_ = 0; rep_ < 2; ++rep_)
#endif
    {
    {
        PHASE_IDS();
        constexpr long I1 = 4864L * 128, I2 = 768L * 48, I3 = 1536L * 32, I4 = 1024L * 256;
        for (long it = gt; it < I1 + I2 + I3 + I4; it += NGT) {
            long r = it; const float* W; const float* ksc = nullptr; int n, kc, Kd, No, oc; bf16* WT;
            if (r < I1) { n = (int)(r % 4864); kc = (int)(r / 4864); W = w_in; Kd = 1024; No = D_IN; oc = win_colmap(n); WT = WIN; }
            else if ((r -= I1) < I2) { n = (int)(r % 768); kc = (int)(r / 768); W = w_uq; Kd = 384; No = 768; oc = wq_colmap(n); WT = WQ; ksc = q_norm_w; }
            else if ((r -= I2) < I3) { n = (int)(r % 1536); kc = (int)(r / 1536); W = w_ukv; Kd = 256; No = 1536; oc = wkv_colmap(n); WT = WKV; ksc = kv_norm_w; }
            else { r -= I3; n = (int)(r % 1024); kc = (int)(r / 1024); W = w_out; Kd = 2048; No = 1024; oc = n; WT = WO; }
            float v[8];
#pragma unroll
            for (int i = 0; i < 8; ++i) { const int k = kc * 8 + i; const int ks_ = (W == w_out) ? (k < 1024 ? k + 1024 : k - 1024) : k;
                float t = oc >= 0 ? W[(size_t)ks_ * No + oc] : 0.f; if (ksc) t *= ksc[k]; v[i] = t; }
            u32x4 w; w.x = cvtpk(v[0], v[1]); w.y = cvtpk(v[2], v[3]); w.z = cvtpk(v[4], v[5]); w.w = cvtpk(v[6], v[7]);
            *(u32x4*)(WT + (size_t)n * Kd + kc * 8) = w;
        }
        for (long it = gt; it < (long)M * 48; it += NGT) {
            const int m = (int)(it / 48), i = (int)(it % 48);
            const float pos = (float)positions[m];
            const float fe = i < 32 ? (float)(2 * i) * (1.f / 64.f) : (float)(2 * (i - 32)) * (1.f / 32.f);
            const float invf = exp2f(-fe * 13.287712379549449f);
            const float ang = pos * invf;
            double rev = (double)ang * 0.15915494309189535; rev -= floor(rev);
            const float rf = (float)rev;
            const float cs = __builtin_amdgcn_cosf(rf), sn = __builtin_amdgcn_sinf(rf);
            float* dst = i < 32 ? CS64 + ((size_t)m * 32 + i) * 2 : CS32 + ((size_t)m * 16 + (i - 32)) * 2;
            *(f32x2*)dst = (f32x2){cs, sn};
        }
    }
    { PHASE_IDS();
    for (int m0 = gw; m0 < M; m0 += 2 * NGW) {
        const int m1 = m0 + NGW; const bool has1 = m1 < M;
        const f32x4* xr0 = (const f32x4*)(x + (size_t)m0 * DM) + lane; const f32x4* xr1 = (const f32x4*)(x + (size_t)(has1 ? m1 : m0) * DM) + lane;
        f32x4 v0[4], v1[4]; float s0 = 0.f, s1 = 0.f;
#pragma unroll
        for (int j = 0; j < 4; ++j) { v0[j] = xr0[64 * j]; v1[j] = xr1[64 * j]; }
#pragma unroll
        for (int j = 0; j < 4; ++j) { s0 += (v0[j].x * v0[j].x + v0[j].y * v0[j].y) + (v0[j].z * v0[j].z + v0[j].w * v0[j].w);
                                      s1 += (v1[j].x * v1[j].x + v1[j].y * v1[j].y) + (v1[j].z * v1[j].z + v1[j].w * v1[j].w); }
        const float rstd0 = __builtin_amdgcn_rsqf(wave_sum(s0) * (1.f / DM) + EPS), rstd1 = __builtin_amdgcn_rsqf(wave_sum(s1) * (1.f / DM) + EPS);
        const int b0 = m0 / SEQ, b1 = (has1 ? m1 : m0) / SEQ;
        u32x2* o80 = (u32x2*)(HB + (size_t)m0 * DM) + lane; u32x2* o81 = (u32x2*)(HB + (size_t)m1 * DM) + lane;
#pragma unroll
        for (int j = 0; j < 4; ++j) {
            const int col = 4 * lane + 256 * j;
            const f32x4 nw = *(const f32x4*)(norm_w + col);
            { const f32x4 sh = *(const f32x4*)(MOD + b0 * 3072 + col), scl = *(const f32x4*)(MOD + b0 * 3072 + 1024 + col);
              const f32x4 hv = v0[j] * rstd0 * nw * (scl + 1.f) + sh; o80[64 * j] = (u32x2){cvtpk(hv.x, hv.y), cvtpk(hv.z, hv.w)}; }
            if (has1) { const f32x4 sh = *(const f32x4*)(MOD + b1 * 3072 + col), scl = *(const f32x4*)(MOD + b1 * 3072 + 1024 + col);
              const f32x4 hv = v1[j] * rstd1 * nw * (scl + 1.f) + sh; o81[64 * j] = (u32x2){cvtpk(hv.x, hv.y), cvtpk(hv.z, hv.w)}; }
        }
    } }
    }
    GRID_BAR();

    {
        pg8::Gemm g{HB, WIN, M, PITCH, DM, DM}; pg8::StaticOrder S; S.init(M, PITCH, G, bid);
        EpiIn E{PROJ, CS64};
        pg8::gemm_phase<EpiIn, pg8::StaticOrder>((LAS unsigned char*)lds, g, S, E);
    }
    GRID_BAR();

#if PROBE_DUP == 1
    for (int rep_ = 0; rep_ < 2; ++rep_)
#endif
    {
    { PHASE_IDS();
    const int sub = lane >> 4, l16 = lane & 15;
    for (int m0 = gw * 4; m0 < M; m0 += NGW * 4) {
        const int m = m0 + sub, b = m / SEQ, s = m - b * SEQ;
        const bf16* pr = PROJ + (size_t)m * PITCH + C_CQ + 8 * l16;
        u32x4 v[6];
#pragma unroll
        for (int i = 0; i < 5; ++i) v[i] = *(const u32x4*)(pr + 128 * i);
        v[5] = (u32x4){0u, 0u, 0u, 0u}; if (l16 < 4) v[5] = *(const u32x4*)(pr + 640);
        float s_cq = sumsq8(v[0]) + sumsq8(v[1]) + sumsq8(v[2]);
        float s_ckv = sumsq8(v[3]) + sumsq8(v[4]);
        float s_kr = sumsq8(v[5]);
#pragma unroll
        for (int ofs = 1; ofs < 16; ofs <<= 1) { s_cq += __shfl_xor(s_cq, ofs); s_ckv += __shfl_xor(s_ckv, ofs); s_kr += __shfl_xor(s_kr, ofs); }
        if (l16 == 0) STAT[m] = (f32x2){s_cq * (1.f / 384.f), s_ckv * (1.f / 256.f)};
        const float rk = __builtin_amdgcn_rsqf(s_kr * (1.f / 32.f) + EPS);
        const u32x4 b2 = v[5];
        u32x4 pw; pw.x = __shfl_xor(b2.x, 2); pw.y = __shfl_xor(b2.y, 2); pw.z = __shfl_xor(b2.z, 2); pw.w = __shfl_xor(b2.w, 2);
        if (l16 < 2) {
            const int pb = 8 * l16;
            unsigned ow[8];
#pragma unroll
            for (int q = 0; q < 4; ++q) {
#pragma unroll
                for (int e = 0; e < 2; ++e) {
                    const int pidx = pb + 2 * q + e;
                    const float x1 = (e ? bf_hi(b2[q]) : bf_lo(b2[q])) * rk * kn_rope_w[pidx];
                    const float x2 = (e ? bf_hi(pw[q]) : bf_lo(pw[q])) * rk * kn_rope_w[pidx + 16];
                    const f32x2 csv = *(const f32x2*)(CS32 + ((size_t)m * 16 + pidx) * 2);
                    ow[2 * q + e] = cvtpk(x1 * csv.x - x2 * csv.y, x2 * csv.x + x1 * csv.y);
                }
            }
            const u32x4 w0 = {ow[0], ow[1], ow[2], ow[3]}, w1 = {ow[4], ow[5], ow[6], ow[7]};
#pragma unroll
            for (int hh = 0; hh < NH; ++hh) { bf16* kp = KB + ((size_t)(b * NH + hh) * SEQ + s) * 96 + 64 + 16 * l16;
                *(u32x4*)kp = w0; *(u32x4*)(kp + 8) = w1; }
        }
    } }
    ret_state_phase(PROJ, KVS, dl_f, dl_b, bid, G, (char*)lds);
    }
    GRID_BAR();

    { PHASE_IDS();
    for (long it = gt; it < 32L * 2 * 2048; it += NGT) {
        const int e4 = (int)(it & 2047), dir = (int)((it >> 11) & 1), bh = (int)(it >> 12), h = bh & 7;
        const float lg2 = -log1pf(expf(-(dir ? dl_b[h] : dl_f[h]))) * LOG2E;
        const float gC = __builtin_amdgcn_exp2f(lg2 * 128.f);
        float s0 = 0.f, s1 = 0.f, s2 = 0.f, s3 = 0.f;
        for (int i = 0; i < 64; ++i) {
            const int c = dir ? 63 - i : i;
            u32x2* ptr = (u32x2*)(KVS + (((size_t)(bh * 64 + c) * 2 + dir) * 8192) + 4 * e4);
            const u32x2 kv = *ptr;
            *ptr = (u32x2){cvtpk(s0, s1), cvtpk(s2, s3)};
            s0 = s0 * gC + bf_lo(kv.x); s1 = s1 * gC + bf_hi(kv.x); s2 = s2 * gC + bf_lo(kv.y); s3 = s3 * gC + bf_hi(kv.y);
        }
    } }
#if PROBE_DUP == 2
    for (int rep_ = 0; rep_ < 2; ++rep_)
#endif
    {
    {
        pg8::Gemm g{PROJ + C_CQ, WQ, M, 768, 384, PITCH}; pg8::StaticOrder S; S.init(M, 768, G, G - 1 - bid);
        EpiUp<3> E{QO, nullptr, STAT, qn_nope_w, qn_rope_w, CS32};
        pg8::gemm_phase<EpiUp<3>, pg8::StaticOrder>((LAS unsigned char*)lds, g, S, E);
    }
    {
        pg8::Gemm g{PROJ + C_CKV, WKV, M, 1536, 256, PITCH}; pg8::StaticOrder S; S.init(M, 1536, G, bid);
        EpiUp<2> E{KB, VB, STAT, kn_nope_w, nullptr, nullptr};
        pg8::gemm_phase<EpiUp<2>, pg8::StaticOrder>((LAS unsigned char*)lds, g, S, E);
    }
    }
    GRID_BAR();

    for (int i = 0; i * G < 1024; ++i) {
        int u = i * G + bid; if (u >= 1024) break;
        int bh, qb;
        if (G == 256) { bh = (bid & 7) * 4 + i; qb = bid >> 3; } else { bh = u >> 5; qb = u & 31; }
        bf16* qo = QO + ((size_t)bh * SEQ + (size_t)qb * 256) * 128;
        { const int b_ = bh >> 3, h_ = bh & 7; const size_t row_ = (size_t)b_ * SEQ + (size_t)qb * 256;
          attn_unit(qo, KB + (size_t)bh * SEQ * 96, VB + (size_t)bh * SEQ * 128, SEQ, (char*)lds,
                    PROJ + row_ * PITCH + C_MG + h_ * 128, SSB + row_ * 8 + h_, mla_norm_w + h_ * 128); }
        __syncthreads();
    }
    ret_main_phase(PROJ, KVS, gn_w, dl_f, dl_b, bid, G, (char*)lds);
    GRID_BAR();

    {
        pg8::Gemm g{PROJ + C_MG, WO, M, DM, 2048, PITCH}; pg8::StaticOrder S; S.init(M, DM, G, bid);
        EpiOut E{x, p.out, MOD, SSB};
        pg8::gemm_phase<EpiOut, pg8::StaticOrder>((LAS unsigned char*)lds, g, S, E);
    }
}

extern "C" void kernel_launch(void* const* d_in, const int* in_sizes, int n_in, void* d_out, int out_size, void* d_ws, size_t ws_size, hipStream_t stream) {
    static int grid_blocks = 0;
    if (grid_blocks == 0) {
        if (n_in != 20 || out_size != M * DM || ws_size < WS_END) { fprintf(stderr, "kernel_launch: unexpected shapes (n_in %d out %d ws %zu)\n", n_in, out_size, ws_size); grid_blocks = -1; return; }
        int dev = 0, cus = 0, per_cu = 0;
        hipGetDevice(&dev);
        hipDeviceGetAttribute(&cus, hipDeviceAttributeMultiprocessorCount, dev);
        if (hipFuncSetAttribute((const void*)fwd_megakernel, hipFuncAttributeMaxDynamicSharedMemorySize, LDS_BYTES) != hipSuccess) { fprintf(stderr, "kernel_launch: hipFuncSetAttribute failed\n"); grid_blocks = -1; return; }
        if (hipOccupancyMaxActiveBlocksPerMultiprocessor(&per_cu, (const void*)fwd_megakernel, NTHREADS, LDS_BYTES) != hipSuccess || per_cu < 1) { fprintf(stderr, "kernel_launch: occupancy query failed (%d)\n", per_cu); per_cu = 1; }
        (void)hipGetLastError();
        grid_blocks = cus * per_cu;
    }
    if (grid_blocks < 0) return;
    if (hipMemsetAsync((char*)d_ws + WS_BAR, 0, XCD_BAR_WORDS * 4, stream) != hipSuccess) { fprintf(stderr, "kernel_launch: memset failed\n"); return; }
    Params p{};
    for (int i = 0; i < 20; ++i) p.in[i] = (const float*)d_in[i];
    p.out = (float*)d_out; p.ws = (unsigned char*)d_ws;
    void* args[] = {&p};
    hipError_t e = hipLaunchCooperativeKernel((const void*)fwd_megakernel, dim3(grid_blocks), dim3(NTHREADS), args, LDS_BYTES, stream);
    if (e != hipSuccess) fprintf(stderr, "cooperative launch failed: %s (grid %d)\n", hipGetErrorString(e), grid_blocks);
}
```

```cpp
#ifndef PROBE_DUP
#define PROBE_DUP 0
#endif
#include <hip/hip_runtime.h>
#include <hip/hip_cooperative_groups.h>
#include <cstdio>
#include <cstdint>
namespace cg = cooperative_groups;

namespace pg8 {
#define PG8_LAS __attribute__((address_space(3)))
typedef unsigned short bf16_t;
typedef short bf16x8 __attribute__((ext_vector_type(8)));
typedef float f32x4 __attribute__((ext_vector_type(4)));
typedef unsigned u32x4 __attribute__((ext_vector_type(4)));
constexpr int BM = 256, BK = 64, HALF = 128, HTB = HALF * BK * 2, STAGE_BYTES = 8 * HTB, NXCD = 8, WGM = 8;

__host__ __device__ __forceinline__ int lds_byte(int r, int c) { const int st = (r >> 4) * 2 + (c >> 5), rr = r & 15, cc = c & 31, ob = rr * 64 + cc * 2; return st * 1024 + (ob ^ (((ob >> 9) & 1) << 5)); }
__host__ __device__ __forceinline__ void stage_rc(int b, int& R, int& C) { const int st = b / 1024, sb = b % 1024, swz = sb ^ (((sb >> 9) & 1) << 5); R = (st >> 1) * 16 + swz / 64; C = (st & 1) * 32 + (swz % 64) / 2; }
__host__ __device__ __forceinline__ int perm32(int rho) { const int n = rho >> 4, i = rho & 15; return 8 * (i >> 2) + 4 * n + (i & 3); }

struct Unit { int pm, pn; };
struct Gemm { const bf16_t* A; const bf16_t* Bt; int M, N, K, lda; };

struct StaticOrder {
    int nM, nN, nwg, G, c;
    __host__ __device__ void init(int M, int N, int G_, int c_) { nM = M / BM; nN = N / BM; nwg = nM * nN; G = G_; c = c_; }
    __host__ __device__ bool next(int i, Unit& u) const {
        const long L = (long)i * G + c; if (L >= nwg) return false;
        int wgid = (int)L; { const int q = nwg / NXCD, r = nwg % NXCD, xcd = wgid % NXCD, off = wgid / NXCD; wgid = (xcd < r ? xcd * (q + 1) : r * (q + 1) + (xcd - r) * q) + off; }
        const int nig = WGM * nN, gid = wgid / nig, fm = gid * WGM, gsz = (nM - fm) < WGM ? (nM - fm) : WGM;
        u.pm = fm + ((wgid % nig) % gsz); u.pn = (wgid % nig) / gsz; return true;
    }
};

typedef float f32x2_c __attribute__((ext_vector_type(2)));
typedef __bf16 bf16x2_c __attribute__((ext_vector_type(2)));
__device__ __forceinline__ unsigned cvt_pk_bf16(float lo, float hi) { const f32x2_c v = {lo, hi}; return __builtin_bit_cast(unsigned, __builtin_convertvector(v, bf16x2_c)); }

template <class Epi, class Sched>
__device__ __forceinline__ void gemm_phase(PG8_LAS unsigned char* lds, const Gemm g, const Sched& S, const Epi& E) {
    int tid_ = threadIdx.x; asm volatile("" : "+v"(tid_));
    const int tid = tid_, wid = __builtin_amdgcn_readfirstlane(tid >> 6), lane = tid & 63, wr = wid >> 2, wc = wid & 3, fr = lane & 15, fq = lane >> 4;
    const int K = g.K, nt = K / BK, lda = g.lda;
    unsigned voffA[2], voffB[2];
#pragma unroll
    for (int i = 0; i < 2; ++i) { int R, C; stage_rc(tid * 16 + i * 8192, R, C); const int Rb = Epi::PERM ? ((R & ~31) + perm32(R & 31)) : R;
        voffA[i] = (unsigned)(R * lda + C) * 2u; voffB[i] = (unsigned)(Rb * K + C) * 2u; }
    const size_t kstep = (size_t)(BK * 2);
    const size_t hstepA = (size_t)HALF * lda * 2, hstepB = (size_t)HALF * K * 2;
    const size_t tstepA = 2 * hstepA, tstepB = 2 * hstepB;
    const unsigned ldsw = (unsigned)wid * 1024u;
    const int aoff = lds_byte(wr * 64 + fr, fq * 8), boff = lds_byte(wc * 32 + fr, fq * 8);
#define PG8_SA(b, h) (((b) * 2 + (h)) * HTB)
#define PG8_SB(b, h) ((4 + (b) * 2 + (h)) * HTB)
#define PG8_STAGE(bufoff, gbase, voff) do { _Pragma("unroll") for (int _i = 0; _i < 2; ++_i) \
        __builtin_amdgcn_global_load_lds((const unsigned*)((const char*)(gbase) + (voff)[_i]), (PG8_LAS unsigned*)(lds + (bufoff) + ldsw + _i * 8192), 16, 0, 0); } while (0)
#define PG8_LDA(dst, b, h) do { _Pragma("unroll") for (int m = 0; m < 4; ++m) _Pragma("unroll") for (int k = 0; k < 2; ++k) dst[m][k] = *(const PG8_LAS bf16x8*)(lds + PG8_SA(b, h) + aoff + m * 2048 + k * 1024); } while (0)
#define PG8_LDB(dst, b, h) do { _Pragma("unroll") for (int n = 0; n < 2; ++n) _Pragma("unroll") for (int k = 0; k < 2; ++k) dst[n][k] = *(const PG8_LAS bf16x8*)(lds + PG8_SB(b, h) + boff + n * 2048 + k * 1024); } while (0)
#define PG8_MMA(ai, bj, At, Bt) do { __builtin_amdgcn_s_setprio(1); _Pragma("unroll") for (int m = 0; m < 4; ++m) _Pragma("unroll") for (int n = 0; n < 2; ++n) _Pragma("unroll") for (int k = 0; k < 2; ++k) \
        acc[ai][bj][m][n] = __builtin_amdgcn_mfma_f32_16x16x32_bf16(Bt[n][k], At[m][k], acc[ai][bj][m][n], 0, 0, 0); __builtin_amdgcn_s_setprio(0); } while (0)
#define PG8_WAIT_V(n) asm volatile("s_waitcnt vmcnt(" #n ")" ::: "memory")
#define PG8_WAIT_L(n) asm volatile("s_waitcnt lgkmcnt(" #n ")" ::: "memory")
#define PG8_BAR __builtin_amdgcn_s_barrier()
#define PG8_SCHED __builtin_amdgcn_sched_barrier(0)
    Unit cur, nxt; int ui = 0;
    if (!S.next(0, cur)) return;
    f32x4 acc[2][2][4][2];
#pragma unroll
    for (int a = 0; a < 2; ++a)
#pragma unroll
        for (int b = 0; b < 2; ++b)
#pragma unroll
            for (int m = 0; m < 4; ++m)
#pragma unroll
                for (int n = 0; n < 2; ++n) acc[a][b][m][n] = (f32x4){0.f, 0.f, 0.f, 0.f};
    bf16x8 At[4][2], B0[2][2], B1[2][2];
    const char* cA = (const char*)g.A + (size_t)cur.pm * tstepA; const char* cB = (const char*)g.Bt + (size_t)cur.pn * tstepB;
    PG8_STAGE(PG8_SB(0, 0), cB, voffB); PG8_STAGE(PG8_SB(0, 1), cB + hstepB, voffB); PG8_STAGE(PG8_SA(0, 0), cA, voffA); PG8_STAGE(PG8_SA(0, 1), cA + hstepA, voffA);
    if (wr == 1) PG8_BAR;
    PG8_WAIT_V(2); PG8_BAR;
    PG8_STAGE(PG8_SB(1, 0), cB + kstep, voffB); PG8_STAGE(PG8_SA(1, 0), cA + kstep, voffA); PG8_STAGE(PG8_SB(1, 1), cB + hstepB + kstep, voffB);
    PG8_WAIT_V(6); PG8_BAR;
    for (;;) {
        const bool has_next = S.next(ui + 1, nxt);
        const char* nA = has_next ? (const char*)g.A + (size_t)nxt.pm * tstepA : cA; const char* nB = has_next ? (const char*)g.Bt + (size_t)nxt.pn * tstepB : cB;
#pragma unroll 1
        for (int t = 0; t < nt; t += 2) {
            if constexpr (Epi::MIDSCALE) { if (t == nt / 2) E.mid(acc, cur); }
            const bool last = (t == nt - 2);
            const char* a1 = cA + (size_t)(t + 1) * kstep;
            const char* a2 = last ? nA : cA + (size_t)(t + 2) * kstep; const char* b2 = last ? nB : cB + (size_t)(t + 2) * kstep;
            const char* a3 = a2 + kstep; const char* b3 = b2 + kstep;
            PG8_LDB(B0, 0, 0); PG8_LDB(B1, 0, 1); PG8_SCHED; PG8_LDA(At, 0, 0); PG8_STAGE(PG8_SA(1, 1), a1 + hstepA, voffA);
            PG8_WAIT_V(8); PG8_WAIT_L(0); PG8_BAR; PG8_MMA(0, 0, At, B0); PG8_MMA(0, 1, At, B1); PG8_BAR; PG8_SCHED;
            PG8_LDA(At, 0, 1); PG8_STAGE(PG8_SB(0, 0), b2, voffB); PG8_STAGE(PG8_SB(0, 1), b2 + hstepB, voffB); PG8_STAGE(PG8_SA(0, 0), a2, voffA);
            PG8_WAIT_V(8); PG8_WAIT_L(0); PG8_BAR; PG8_MMA(1, 0, At, B0); PG8_MMA(1, 1, At, B1); PG8_BAR; PG8_SCHED;
            PG8_LDB(B0, 1, 0); PG8_LDB(B1, 1, 1); PG8_SCHED; PG8_LDA(At, 1, 0); PG8_STAGE(PG8_SA(0, 1), a2 + hstepA, voffA);
            PG8_WAIT_V(8); PG8_WAIT_L(0); PG8_BAR; PG8_MMA(0, 0, At, B0); PG8_MMA(0, 1, At, B1); PG8_BAR; PG8_SCHED;
            PG8_LDA(At, 1, 1); PG8_STAGE(PG8_SB(1, 0), b3, voffB); PG8_STAGE(PG8_SB(1, 1), b3 + hstepB, voffB); PG8_STAGE(PG8_SA(1, 0), a3, voffA);
            PG8_WAIT_V(8); PG8_WAIT_L(0); PG8_BAR; PG8_MMA(1, 0, At, B0); PG8_MMA(1, 1, At, B1); PG8_BAR; PG8_SCHED;
        }
        if (wr == 0) PG8_BAR;
        E(acc, cur, wr, wc, fr, fq);
        if (!has_next) break;
#pragma unroll
        for (int a = 0; a < 2; ++a)
#pragma unroll
            for (int b = 0; b < 2; ++b)
#pragma unroll
                for (int m = 0; m < 4; ++m)
#pragma unroll
                    for (int n = 0; n < 2; ++n) acc[a][b][m][n] = (f32x4){0.f, 0.f, 0.f, 0.f};
        cur = nxt; cA = nA; cB = nB; ++ui;
        if (wr == 1) PG8_BAR;
    }
    PG8_WAIT_V(0);
    PG8_BAR;
#undef PG8_SA
#undef PG8_SB
#undef PG8_STAGE
#undef PG8_LDA
#undef PG8_LDB
#undef PG8_MMA
#undef PG8_WAIT_V
#undef PG8_WAIT_L
#undef PG8_BAR
#undef PG8_SCHED
}
}

typedef unsigned short bf16;
typedef short bf16x8 __attribute__((ext_vector_type(8)));
typedef short s16x4 __attribute__((ext_vector_type(4)));
typedef float f32x16 __attribute__((ext_vector_type(16)));
typedef float f32x4 __attribute__((ext_vector_type(4)));
typedef float f32x2 __attribute__((ext_vector_type(2)));
typedef unsigned u32x4 __attribute__((ext_vector_type(4)));
typedef unsigned u32x2 __attribute__((ext_vector_type(2)));
#define LAS __attribute__((address_space(3)))

constexpr int BATCH = 4, SEQ = 8192, DM = 1024, M = BATCH * SEQ, NH = 8;
constexpr int D_IN = 4768, PITCH = 4864;
constexpr int C_RQ = 0, C_RK = 512, C_RV = 1024, C_MG = 2048, C_RG = 3072, C_CQ = 4096, C_CKV = 4480, C_KR = 4736;
constexpr float EPS = 1e-6f;
constexpr float QSC = 0.10206207261596575f * 1.4426950408889634f;
constexpr float LOG2E = 1.4426950408889634f;
constexpr int NTHREADS = 512, NWAVES = 8;

constexpr size_t MiB = 1u << 20;
constexpr size_t WS_PROJ = 0;
constexpr size_t WS_K = 304 * MiB;
constexpr size_t WS_V = 352 * MiB;
constexpr size_t WS_WIN = 416 * MiB;
constexpr size_t WS_WQ = 426 * MiB;
constexpr size_t WS_WKV = 427 * MiB;
constexpr size_t WS_WO = 428 * MiB;
constexpr size_t WS_CS64 = 432 * MiB;
constexpr size_t WS_CS32 = 440 * MiB;
constexpr size_t WS_MOD = 444 * MiB;
constexpr size_t WS_STAT = 445 * MiB;
constexpr size_t WS_SS = 447 * MiB;
constexpr size_t WS_BAR = 446 * MiB;
constexpr size_t WS_END = 448 * MiB;
constexpr size_t OUT_QO = 0, OUT_KVS = 64 * MiB;

constexpr int LDS_BYTES = 135168;
constexpr int LDS_CTL_OFF = 133120;

struct Params { const float* in[20]; float* out; unsigned char* ws; };

__device__ __forceinline__ unsigned cvtpk(float lo, float hi) { return pg8::cvt_pk_bf16(lo, hi); }
__device__ __forceinline__ float bf_lo(unsigned w) { return __uint_as_float(w << 16); }
__device__ __forceinline__ float bf_hi(unsigned w) { return __uint_as_float(w & 0xffff0000u); }
__device__ __forceinline__ float wave_sum(float v) {
#pragma unroll
    for (int o = 1; o < 64; o <<= 1) v += __shfl_xor(v, o);
    return v;
}
__device__ __forceinline__ float silu_f(float v) { return v * __builtin_amdgcn_rcpf(1.f + __builtin_amdgcn_exp2f(-v * LOG2E)); }
__device__ __forceinline__ float sumsq8(u32x4 a) {
    float s = 0.f;
#pragma unroll
    for (int i = 0; i < 4; ++i) { const float x = bf_lo(a[i]), y = bf_hi(a[i]); s += x * x + y * y; }
    return s;
}

__device__ __forceinline__ int fresh_tid() { int t = threadIdx.x; asm volatile("" : "+v"(t)); return t; }
#define EPI_LANES() const int t_ = fresh_tid(), l_ = t_ & 63, wi_ = t_ >> 6, wr = wi_ >> 2, wc = wi_ & 3, fr = l_ & 15, fq = l_ >> 4


#define RLX_AGENT __ATOMIC_RELAXED, __HIP_MEMORY_SCOPE_AGENT
#define XB_TMO      128
#define XB_XCNT(j)  (256  + 64 * (j))
#define XB_XSUB(j)  (1280 + 64 * (j))
#define XB_XGEN(j)  (2304 + 64 * (j))
#define XB_TOP      3328
#define XB_TOPGEN   3392
#define XCD_BAR_WORDS 3456
#define XB_SPIN_CAP (1u << 18)

__device__ __forceinline__ unsigned xb_ld(unsigned* p)              { return __hip_atomic_load(p, __ATOMIC_RELAXED, __HIP_MEMORY_SCOPE_AGENT); }
__device__ __forceinline__ unsigned xb_add(unsigned* p, unsigned v) { return __hip_atomic_fetch_add(p, v, __ATOMIC_RELAXED, __HIP_MEMORY_SCOPE_AGENT); }
__device__ __forceinline__ unsigned xb_xcc_id() { return (unsigned)__builtin_amdgcn_s_getreg((3 << 11) | 20) & 0xFu; }
#define XB_SPIN(cond, bar) do { unsigned _sp = 0; while (cond) { __builtin_amdgcn_s_sleep(1); \
    if ((++_sp & 255u) == 0u) { if (xb_ld(&(bar)[XB_TMO])) break; if (_sp > XB_SPIN_CAP) { atomicAdd(&(bar)[XB_TMO], 1u); break; } } } } while (0)

struct XcdBarrier {
    unsigned* bar; unsigned x;
    volatile LAS unsigned* st;
};

__device__ __forceinline__ XcdBarrier xcd_barrier_post(unsigned* bar, volatile LAS unsigned* st) {
    XcdBarrier b; b.bar = bar; b.x = xb_xcc_id(); b.st = st;
    if (threadIdx.x == 0) (void)xb_add(&bar[XB_XCNT(b.x)], 1u);
    return b;
}
__device__ __forceinline__ void xcd_barrier_complete(unsigned* bar, unsigned x, unsigned& nloc, unsigned& nx) {
    const unsigned G = gridDim.x * gridDim.y * gridDim.z;
    unsigned sum, cnt, mine, sp = 0u;
    for (;;) {
        sum = 0u; cnt = 0u; mine = 0u;
#pragma unroll
        for (unsigned j = 0; j < 16; ++j) { const unsigned c = xb_ld(&bar[XB_XCNT(j)]); sum += c; cnt += (c > 0u) ? 1u : 0u; mine = (j == x) ? c : mine; }
        if (sum == G) break;
        __builtin_amdgcn_s_sleep(1);
        if ((++sp & 255u) == 0u) { if (xb_ld(&bar[XB_TMO])) break; if (sp > XB_SPIN_CAP) { atomicAdd(&bar[XB_TMO], 1u); break; } }
    }
    nloc = mine > 0u ? mine : 1u; nx = cnt > 0u ? cnt : 1u;
}

__device__ __forceinline__ void xcd_barrier(const XcdBarrier& b) {
    asm volatile("s_waitcnt vmcnt(0)" ::: "memory");
    __syncthreads();
    if (threadIdx.x == 0) {
        unsigned* bar = b.bar;
        __builtin_amdgcn_s_waitcnt(0);
        unsigned nloc = b.st[0], nx = b.st[1];
        if (nloc == 0u) { xcd_barrier_complete(bar, b.x, nloc, nx); b.st[0] = nloc; b.st[1] = nx; }
        const unsigned old = xb_add(&bar[XB_XSUB(b.x)], 1u);
        const unsigned gen = old / nloc;
        if (old + 1u == (gen + 1u) * nloc) {
            __builtin_amdgcn_fence(__ATOMIC_RELEASE, "agent");
            asm volatile("s_waitcnt vmcnt(0)" ::: "memory");
            const unsigned og = xb_add(&bar[XB_TOP], 1u);
            const unsigned tg = og / nx;
            if (og + 1u == (tg + 1u) * nx) xb_add(&bar[XB_TOPGEN], 1u);
            else XB_SPIN(xb_ld(&bar[XB_TOPGEN]) == tg, bar);
            __builtin_amdgcn_fence(__ATOMIC_ACQUIRE, "agent");
            xb_add(&bar[XB_XGEN(b.x)], 1u);
            asm volatile("s_waitcnt vmcnt(0)" ::: "memory");
        } else {
            XB_SPIN(xb_ld(&bar[XB_XGEN(b.x)]) == gen, bar);
            __builtin_amdgcn_fence(__ATOMIC_ACQUIRE, "agent");
            asm volatile("s_waitcnt vmcnt(0)" ::: "memory");
        }
    }
    __syncthreads();
}


__device__ __forceinline__ int win_colmap(int n) {
    if (n < 1024) { const int base = n & ~63, j = n & 63; return base + (j >> 1) + 32 * (j & 1); }
    if (n < 2048) return n;
    if (n < 3072) return 3744 + (n - 2048);
    if (n < 4096) return 2048 + (n - 3072);
    if (n < 4480) return 3072 + (n - 4096);
    if (n < 4736) return 3456 + (n - 4480);
    if (n < 4768) return 3712 + (n - 4736);
    return -1;
}
__device__ __forceinline__ int nope_map(int n, int per_head) {
    const int t = n >> 8, c = n & 255, bj = c >> 7, wc = (c >> 5) & 3, j = c & 31;
    return (4 * t + wc) * per_head + 32 * bj + j;
}
__device__ __forceinline__ int wq_colmap(int n) {
    if (n < 512) return nope_map(n, 96);
    const int c = n - 512, head = c >> 5, j = c & 31; return head * 96 + 64 + (j >> 1) + 16 * (j & 1);
}
__device__ __forceinline__ int wkv_colmap(int n) {
    if (n < 512) return nope_map(n, 192);
    const int c = n - 512, head = c >> 7, dim = c & 127; return head * 192 + 64 + dim;
}

struct EpiIn {
    static constexpr bool PERM = true, MIDSCALE = false;
    bf16* P; const float* cs64;
    __device__ __forceinline__ void operator()(const pg8::f32x4 (&acc)[2][2][4][2], const pg8::Unit& u, int, int, int, int) const {
        EPI_LANES();
        const int row0 = u.pm * 256 + wr * 64 + fr, colt = u.pn * 256, cl = wc * 32 + 8 * fq;
        const int mode = u.pn < 4 ? 1 : ((u.pn >= 8 && u.pn < 16) ? 2 : 0);
        const float rs = u.pn < 2 ? 1.f : 0.125f;
        const int p0 = (wc & 1) * 16 + 4 * fq;
        f32x4 n0 = {1.f, 0.f, 1.f, 0.f}, n1 = {1.f, 0.f, 1.f, 0.f};
        if (mode == 1) { const f32x4* t = (const f32x4*)(cs64 + ((size_t)row0 * 32 + p0) * 2); n0 = t[0]; n1 = t[1]; }
#pragma unroll
        for (int ai = 0; ai < 2; ++ai)
#pragma unroll
            for (int m = 0; m < 4; ++m) {
                const int row = row0 + ai * 128 + m * 16;
                bf16* rowp = P + (size_t)row * PITCH + colt + cl;
                const f32x4 c0 = n0, c1 = n1;
                if (mode == 1 && (ai * 4 + m) < 7) { const int rown = row0 + ((ai * 4 + m + 1) >> 2) * 128 + ((ai * 4 + m + 1) & 3) * 16;
                    const f32x4* t = (const f32x4*)(cs64 + ((size_t)rown * 32 + p0) * 2); n0 = t[0]; n1 = t[1]; }
#pragma unroll
                for (int bj = 0; bj < 2; ++bj) {
                    f32x4 v0 = acc[ai][bj][m][0], v1 = acc[ai][bj][m][1];
                    if (mode == 1) {
                        f32x4 o0, o1;
                        o0[0] = (v0[0] * c0[0] - v0[1] * c0[1]) * rs; o0[1] = (v0[1] * c0[0] + v0[0] * c0[1]) * rs;
                        o0[2] = (v0[2] * c0[2] - v0[3] * c0[3]) * rs; o0[3] = (v0[3] * c0[2] + v0[2] * c0[3]) * rs;
                        o1[0] = (v1[0] * c1[0] - v1[1] * c1[1]) * rs; o1[1] = (v1[1] * c1[0] + v1[0] * c1[1]) * rs;
                        o1[2] = (v1[2] * c1[2] - v1[3] * c1[3]) * rs; o1[3] = (v1[3] * c1[2] + v1[2] * c1[3]) * rs;
                        v0 = o0; v1 = o1;
                    } else if (mode == 2) {
#pragma unroll
                        for (int i = 0; i < 4; ++i) { v0[i] = silu_f(v0[i]); v1[i] = silu_f(v1[i]); }
                    }
                    u32x4 w; w.x = cvtpk(v0[0], v0[1]); w.y = cvtpk(v0[2], v0[3]); w.z = cvtpk(v1[0], v1[1]); w.w = cvtpk(v1[2], v1[3]);
                    *(u32x4*)(rowp + bj * 128) = w;
                }
                asm volatile("" ::: "memory");
            }
    }
};

template <int MODE> struct EpiUp {
    static constexpr bool IS_Q = MODE != 2, MIDSCALE = false;
    static constexpr bool PERM = true;
    bf16* O;
    bf16* Vo;
    const f32x2* stat;
    const float* wn;
    const float* wr_;
    const float* cs32;
    __device__ __forceinline__ void operator()(const pg8::f32x4 (&acc)[2][2][4][2], const pg8::Unit& u, int, int, int, int) const {
        EPI_LANES();
        const int row0 = u.pm * 256 + wr * 64 + fr;
        const int b = row0 / SEQ;
        constexpr int OP = IS_Q ? 128 : 96;
        float ms8[8];
#pragma unroll
        for (int i = 0; i < 8; ++i) { const f32x2 st = stat[row0 + (i >> 2) * 128 + (i & 3) * 16]; ms8[i] = IS_Q ? st.x : st.y; }
        if (MODE == 0 || ((MODE == 2 || MODE == 3) && u.pn < 2)) {
            const int head = 4 * u.pn + wc;
            const f32x4 w00 = *(const f32x4*)(wn + 8 * fq), w01 = *(const f32x4*)(wn + 8 * fq + 4), w10 = *(const f32x4*)(wn + 32 + 8 * fq), w11 = *(const f32x4*)(wn + 36 + 8 * fq);
#pragma unroll
            for (int ai = 0; ai < 2; ++ai)
#pragma unroll
                for (int m = 0; m < 4; ++m) {
                    const int row = row0 + ai * 128 + m * 16;
                    const f32x4 a0 = acc[ai][0][m][0], a1 = acc[ai][0][m][1], b0 = acc[ai][1][m][0], b1 = acc[ai][1][m][1];
                    float ss = 0.f;
#pragma unroll
                    for (int i = 0; i < 4; ++i) ss += a0[i] * a0[i] + a1[i] * a1[i] + b0[i] * b0[i] + b1[i] * b1[i];
                    ss += __shfl_xor(ss, 16); ss += __shfl_xor(ss, 32);
                    const float ms = ms8[ai * 4 + m];
                    const float sc = __builtin_amdgcn_rsqf(ss * (1.f / 64.f) + EPS * (ms + EPS)) * (IS_Q ? QSC : 1.f);
                    bf16* op = O + ((size_t)(b * NH + head) * SEQ + (row - b * SEQ)) * OP;
                    const f32x4 x0 = a0 * sc * w00, x1 = a1 * sc * w01, y0 = b0 * sc * w10, y1 = b1 * sc * w11;
                    u32x4 w; w.x = cvtpk(x0[0], x0[1]); w.y = cvtpk(x0[2], x0[3]); w.z = cvtpk(x1[0], x1[1]); w.w = cvtpk(x1[2], x1[3]);
                    *(u32x4*)(op + 8 * fq) = w;
                    w.x = cvtpk(y0[0], y0[1]); w.y = cvtpk(y0[2], y0[3]); w.z = cvtpk(y1[0], y1[1]); w.w = cvtpk(y1[2], y1[3]);
                    *(u32x4*)(op + 32 + 8 * fq) = w;
                }
        } else if (MODE == 1 || MODE == 3) {
            const f32x4 wl = *(const f32x4*)(wr_ + 4 * fq), wh = *(const f32x4*)(wr_ + 16 + 4 * fq);
            f32x4 n0, n1; { const f32x4* t = (const f32x4*)(cs32 + ((size_t)row0 * 16 + 4 * fq) * 2); n0 = t[0]; n1 = t[1]; }
#pragma unroll
            for (int ai = 0; ai < 2; ++ai)
#pragma unroll
                for (int m = 0; m < 4; ++m) {
                    const int row = row0 + ai * 128 + m * 16;
                    const float epsq = EPS * (ms8[ai * 4 + m] + EPS);
                    const f32x4 c0 = n0, c1 = n1;
                    if ((ai * 4 + m) < 7) { const int rown = row0 + ((ai * 4 + m + 1) >> 2) * 128 + ((ai * 4 + m + 1) & 3) * 16;
                        const f32x4* t = (const f32x4*)(cs32 + ((size_t)rown * 16 + 4 * fq) * 2); n0 = t[0]; n1 = t[1]; }
#pragma unroll
                    for (int bj = 0; bj < 2; ++bj) {
                        const f32x4 v0 = acc[ai][bj][m][0], v1 = acc[ai][bj][m][1];
                        float ss = 0.f;
#pragma unroll
                        for (int i = 0; i < 4; ++i) ss += v0[i] * v0[i] + v1[i] * v1[i];
                        ss += __shfl_xor(ss, 16); ss += __shfl_xor(ss, 32);
                        const float sc = __builtin_amdgcn_rsqf(ss * (1.f / 32.f) + epsq) * QSC;
                        const float x1a = v0[0] * sc * wl[0], x2a = v0[1] * sc * wh[0], x1b = v0[2] * sc * wl[1], x2b = v0[3] * sc * wh[1];
                        const float x1c = v1[0] * sc * wl[2], x2c = v1[1] * sc * wh[2], x1d = v1[2] * sc * wl[3], x2d = v1[3] * sc * wh[3];
                        u32x4 w;
                        w.x = cvtpk(x1a * c0[0] - x2a * c0[1], x2a * c0[0] + x1a * c0[1]);
                        w.y = cvtpk(x1b * c0[2] - x2b * c0[3], x2b * c0[2] + x1b * c0[3]);
                        w.z = cvtpk(x1c * c1[0] - x2c * c1[1], x2c * c1[0] + x1c * c1[1]);
                        w.w = cvtpk(x1d * c1[2] - x2d * c1[3], x2d * c1[2] + x1d * c1[3]);
                        const int head = 4 * bj + wc;
                        bf16* op = O + ((size_t)(b * NH + head) * SEQ + (row - b * SEQ)) * OP;
                        *(u32x4*)(op + 64 + 8 * fq) = w;
                    }
                    asm volatile("" ::: "memory");
                }
        } else {
#pragma unroll
            for (int ai = 0; ai < 2; ++ai)
#pragma unroll
                for (int m = 0; m < 4; ++m) {
                    const int row = row0 + ai * 128 + m * 16;
                    const float sc = __builtin_amdgcn_rsqf(ms8[ai * 4 + m] + EPS);
#pragma unroll
                    for (int bj = 0; bj < 2; ++bj) {
                        const f32x4 v0 = acc[ai][bj][m][0] * sc, v1 = acc[ai][bj][m][1] * sc;
                        const int head = 2 * (u.pn - 2) + bj;
                        bf16* op = Vo + ((size_t)(b * NH + head) * SEQ + (row - b * SEQ)) * 128 + 32 * wc + 8 * fq;
                        u32x4 w; w.x = cvtpk(v0[0], v0[1]); w.y = cvtpk(v0[2], v0[3]); w.z = cvtpk(v1[0], v1[1]); w.w = cvtpk(v1[2], v1[3]);
                        *(u32x4*)op = w;
                    }
                }
        }
    }
};

struct EpiOut {
    static constexpr bool PERM = false, MIDSCALE = true;
    const float* x; float* out; const float* mod; const float* ss;
    __device__ __forceinline__ void mid(pg8::f32x4 (&acc)[2][2][4][2], const pg8::Unit& u) const {
        EPI_LANES(); (void)wc; (void)fq;
        const int row0 = u.pm * 256 + wr * 64 + fr;
#pragma unroll
        for (int ai = 0; ai < 2; ++ai)
#pragma unroll
            for (int m = 0; m < 4; ++m) {
                const f32x4* sp = (const f32x4*)(ss + (size_t)(row0 + ai * 128 + m * 16) * 8);
                const f32x4 s0 = sp[0], s1 = sp[1];
                const float rstd = __builtin_amdgcn_rsqf(((s0[0] + s0[1]) + (s0[2] + s0[3]) + (s1[0] + s1[1]) + (s1[2] + s1[3])) * (1.f / 1024.f) + EPS);
#pragma unroll
                for (int bj = 0; bj < 2; ++bj)
#pragma unroll
                    for (int n = 0; n < 2; ++n) acc[ai][bj][m][n] *= rstd;
            }
    }
    __device__ __forceinline__ void operator()(const pg8::f32x4 (&acc)[2][2][4][2], const pg8::Unit& u, int, int, int, int) const {
        EPI_LANES();
        const int row0 = u.pm * 256 + wr * 64 + fr, b = row0 / SEQ;
        const int col0 = u.pn * 256 + wc * 32 + 4 * fq;
        f32x4 gv[2][2];
#pragma unroll
        for (int bj = 0; bj < 2; ++bj)
#pragma unroll
            for (int n = 0; n < 2; ++n) gv[bj][n] = *(const f32x4*)(mod + b * 3072 + 2048 + col0 + bj * 128 + n * 16);
#pragma unroll
        for (int ai = 0; ai < 2; ++ai)
#pragma unroll
            for (int m = 0; m < 4; ++m) {
                const size_t off = (size_t)(row0 + ai * 128 + m * 16) * DM + col0;
#pragma unroll
                for (int bj = 0; bj < 2; ++bj)
#pragma unroll
                    for (int n = 0; n < 2; ++n) {
                        const f32x4 xv = *(const f32x4*)(x + off + bj * 128 + n * 16);
                        *(f32x4*)(out + off + bj * 128 + n * 16) = xv + gv[bj][n] * acc[ai][bj][m][n];
                    }
            }
    }
};

#define KSWZ(row, colB) ((row) * 256 + ((colB) ^ (((row) & 7) << 4)))
#define SBAR() __builtin_amdgcn_sched_barrier(0)
constexpr int KVBLK = 64;
constexpr size_t SHM_V = KVBLK * 128 * 2, SHM_K = KVBLK * 128 * 2;
constexpr float ATT_SCALE = 0.10206207261596575f;
constexpr float THR = 8.f;
__device__ __forceinline__ f32x16 zero16() { float z; asm volatile("v_mov_b32 %0, 0" : "=v"(z)); f32x16 r;
#pragma unroll
    for (int i = 0; i < 16; ++i) r[i] = z;
    return r; }
__device__ __forceinline__ int crow(int r, int hi) { return (r & 3) + 8 * (r >> 2) + 4 * hi; }
__device__ __forceinline__ int v_st(int k, int c) { const int kk = (k & ~0xC) | ((k & 4) << 1) | ((k & 8) >> 1); return ((kk >> 3) * 4 + (c >> 5)) * 512 + ((kk & 7) * 32 + (c & 31)) * 2; }
__device__ __forceinline__ int v_st_raw(int k, int c) { return ((k >> 3) * 4 + (c >> 5)) * 512 + ((k & 7) * 32 + (c & 31)) * 2; }
__device__ __forceinline__ int v_rd_base(int lane) { return ((lane & 3) << 3) | (((lane >> 2) & 3) << 6) | (((lane >> 4) & 1) << 5) | (((lane >> 5) & 1) << 8); }
constexpr int v_rd_off(int d0, int ks, int half) { return d0 * 512 + ks * 4096 + half * 2048; }
template <int OFF> __device__ __forceinline__ s16x4 tr_read(int vb) {
    s16x4 r; asm volatile("ds_read_b64_tr_b16 %0, %1 offset:%2" : "=&v"(r) : "v"(vb), "i"(OFF) : "memory"); return r;
}
#define PKF(L, H) (bf16x8){L[0], L[1], L[2], L[3], H[0], H[1], H[2], H[3]}
template <int D0> __device__ __forceinline__ void pv_one(f32x16& od, int vb, bf16x8 pa0, bf16x8 pa1, bf16x8 pa2, bf16x8 pa3) {
    const s16x4 l0 = tr_read<v_rd_off(D0, 0, 0)>(vb), h0 = tr_read<v_rd_off(D0, 0, 1)>(vb), l1 = tr_read<v_rd_off(D0, 1, 0)>(vb), h1 = tr_read<v_rd_off(D0, 1, 1)>(vb);
    const s16x4 l2 = tr_read<v_rd_off(D0, 2, 0)>(vb), h2 = tr_read<v_rd_off(D0, 2, 1)>(vb), l3 = tr_read<v_rd_off(D0, 3, 0)>(vb), h3 = tr_read<v_rd_off(D0, 3, 1)>(vb);
    asm volatile("s_waitcnt lgkmcnt(0)" ::: "memory"); SBAR();
    od = __builtin_amdgcn_mfma_f32_32x32x16_bf16(pa0, PKF(l0, h0), od, 0, 0, 0);
    od = __builtin_amdgcn_mfma_f32_32x32x16_bf16(pa1, PKF(l1, h1), od, 0, 0, 0);
    od = __builtin_amdgcn_mfma_f32_32x32x16_bf16(pa2, PKF(l2, h2), od, 0, 0, 0);
    od = __builtin_amdgcn_mfma_f32_32x32x16_bf16(pa3, PKF(l3, h3), od, 0, 0, 0);
}
__device__ __forceinline__ void pv_d0(f32x16* o, int vb, bf16x8 pa0, bf16x8 pa1, bf16x8 pa2, bf16x8 pa3) {
    pv_one<0>(o[0], vb, pa0, pa1, pa2, pa3); pv_one<1>(o[1], vb, pa0, pa1, pa2, pa3); pv_one<2>(o[2], vb, pa0, pa1, pa2, pa3); pv_one<3>(o[3], vb, pa0, pa1, pa2, pa3);
}
#define PK4(P, BASE, OUT) do { u32x4 w = {cvtpk(P[BASE + 0], P[BASE + 1]), cvtpk(P[BASE + 2], P[BASE + 3]), cvtpk(P[BASE + 4], P[BASE + 5]), cvtpk(P[BASE + 6], P[BASE + 7])}; \
    OUT = *reinterpret_cast<bf16x8*>(&w); } while (0)

__device__ __forceinline__ void partialSM(f32x16& p0, f32x16& p1) {
    (void)p1;
#pragma unroll
    for (int r = 0; r < 16; ++r) p0[r] = __builtin_amdgcn_exp2f(p0[r]);
}
__device__ __forceinline__ void finishSM(f32x16& p0, f32x16& p1, float& l_reg, bf16x8& pa0, bf16x8& pa1, bf16x8& pa2, bf16x8& pa3) {
#pragma unroll
    for (int r = 0; r < 16; ++r) p1[r] = __builtin_amdgcn_exp2f(p1[r]);
    float ps = 0;
#pragma unroll
    for (int r = 0; r < 16; ++r) ps += p0[r];
#pragma unroll
    for (int r = 0; r < 16; ++r) ps += p1[r];
    { auto rr = __builtin_amdgcn_permlane32_swap(__float_as_uint(ps), __float_as_uint(ps), false, false);
      ps = __uint_as_float(rr[0]) + __uint_as_float(rr[1]); }
    l_reg += ps;
    PK4(p0, 0, pa0); PK4(p0, 8, pa1); PK4(p1, 0, pa2); PK4(p1, 8, pa3);
}
__device__ __forceinline__ void qkt6(f32x16& p0, f32x16& p1, const char* Ks, const bf16x8* qr, int r32, int hi) {
    asm volatile("" : "+v"(r32));
    p0 = f32x16{}; p1 = f32x16{};
#pragma unroll
    for (int d0 = 0; d0 < 6; ++d0) { const int cb = (d0 * 16 + hi * 8) * 2;
        const bf16x8 b0 = *reinterpret_cast<const bf16x8*>(Ks + KSWZ(r32, cb));
        const bf16x8 b1 = *reinterpret_cast<const bf16x8*>(Ks + KSWZ(32 + r32, cb));
        p0 = __builtin_amdgcn_mfma_f32_32x32x16_bf16(b0, qr[d0], p0, 0, 0, 0);
        p1 = __builtin_amdgcn_mfma_f32_32x32x16_bf16(b1, qr[d0], p1, 0, 0, 0);
        asm volatile("" :: "v"(b0), "v"(b1), "v"(qr[d0])); }
}

__device__ __forceinline__ void attn_unit(bf16* __restrict__ QOb, const bf16* __restrict__ Kh, const bf16* __restrict__ Vh, int seq, char* lds,
                                          bf16* __restrict__ mgb  , float* __restrict__ ssb  , const float* __restrict__ wnh  ) {
    constexpr int LDQ = 128, LDKK = 96, LDV = 128;
    int tid_ = threadIdx.x; asm volatile("" : "+v"(tid_));
    const int tid = tid_, wid = tid >> 6, lane = tid & 63, r32 = lane & 31, hi = lane >> 5;
    char* V_lds = lds; char* K_lds = lds + 3 * SHM_V;
    float* ws = (float*)(lds + 3 * SHM_V + 3 * SHM_K) + wid * 64; float* li_l = ws;
    float l_reg = 0; f32x16 o[4] = {}; bf16x8 qr[6];
    const bf16* Qw = QOb + (long)(wid * 32 + r32) * LDQ + hi * 8;
#pragma unroll
    for (int d0 = 0; d0 < 6; ++d0) qr[d0] = *reinterpret_cast<const bf16x8*>(Qw + d0 * 16);
    const int sr = tid >> 4, sc = (tid & 15) * 8, vst0 = v_st_raw(sr, sc), vst1 = v_st_raw(32 + sr, sc);
    const int sck = sc < 96 ? sc : 88;
    const int vb0 = (int)(uintptr_t)V_lds + v_rd_base(lane);
    struct { bf16x8 vs0, vs1, ks0, ks1; } sr_[2];
    const char* Vhb = (const char*)Vh; const char* Khb = (const char*)Kh;
    const unsigned voV = (unsigned)(sr * LDV + sc) * 2u, voK = (unsigned)(sr * LDKK + sck) * 2u;
#define SLOAD(i, k0) do { const char* vt_ = Vhb + (size_t)(k0) * (LDV * 2); const char* kt_ = Khb + (size_t)(k0) * (LDKK * 2); \
    sr_[i].vs0 = *(const bf16x8*)(vt_ + voV); sr_[i].vs1 = *(const bf16x8*)(vt_ + 32 * LDV * 2 + voV); \
    sr_[i].ks0 = *(const bf16x8*)(kt_ + voK); sr_[i].ks1 = *(const bf16x8*)(kt_ + 32 * LDKK * 2 + voK); } while (0)
#define SWRITE(b, i) do {   *(bf16x8*)(V_lds + (b) * SHM_V + vst0) = sr_[i].vs0; *(bf16x8*)(V_lds + (b) * SHM_V + vst1) = sr_[i].vs1; const int kc = sc * 2; \
    *(bf16x8*)(K_lds + (b) * SHM_K + KSWZ(sr, kc)) = sr_[i].ks0; *(bf16x8*)(K_lds + (b) * SHM_K + KSWZ(32 + sr, kc)) = sr_[i].ks1; } while (0)
#define SWAIT() asm volatile("s_waitcnt vmcnt(4)" ::: "memory")
    f32x16 pA0, pA1, pB0, pB1; bf16x8 pa0, pa1, pa2, pa3; const int NT = seq / KVBLK;
    constexpr int SE = 0, SO = 1;
#define ASTEP(PC0, PC1, PP0, PP1, KS, VS, WS, RW, RL, LT, LCOND) do { \
        SBAR(); qkt6(PC0, PC1, K_lds + (KS) * SHM_K, qr, r32, hi); \
        finishSM(PP0, PP1, l_reg, pa0, pa1, pa2, pa3); SBAR(); \
        if (LCOND) SLOAD(RL, (LT) * KVBLK); SBAR(); \
        pv_d0(o, vb0 + (VS) * (int)SHM_V, pa0, pa1, pa2, pa3); partialSM(PC0, PC1); \
        SWRITE(WS, RW); __syncthreads(); } while (0)
    SLOAD(0, 0); SLOAD(1, KVBLK);
    SWRITE(0, 0); __syncthreads();
    SLOAD(0, 2 * KVBLK);
    qkt6(pA0, pA1, K_lds, qr, r32, hi); partialSM(pA0, pA1);
    SWRITE(1, 1); __syncthreads();
    for (int j = 1; j + 5 < NT; j += 6) {
        ASTEP(pB0, pB1, pA0, pA1, 1, 0, 2, 0, 1, j + 2, true);
        ASTEP(pA0, pA1, pB0, pB1, 2, 1, 0, 1, 0, j + 3, true);
        ASTEP(pB0, pB1, pA0, pA1, 0, 2, 1, 0, 1, j + 4, true);
        ASTEP(pA0, pA1, pB0, pB1, 1, 0, 2, 1, 0, j + 5, true);
        ASTEP(pB0, pB1, pA0, pA1, 2, 1, 0, 0, 1, j + 6, true);
        ASTEP(pA0, pA1, pB0, pB1, 0, 2, 1, 1, 0, j + 7, j + 7 < NT);
    }
    SBAR(); qkt6(pB0, pB1, K_lds + 1 * SHM_K, qr, r32, hi);
    finishSM(pA0, pA1, l_reg, pa0, pa1, pa2, pa3); SBAR();
    pv_d0(o, vb0 + 0 * (int)SHM_V, pa0, pa1, pa2, pa3); partialSM(pB0, pB1);
    finishSM(pB0, pB1, l_reg, pa0, pa1, pa2, pa3); SBAR();
    pv_d0(o, vb0 + 1 * (int)SHM_V, pa0, pa1, pa2, pa3);
    __syncthreads();
#undef ASTEP
    { const int t2_ = fresh_tid(), wid = t2_ >> 6, lane = t2_ & 63, r32 = lane & 31, hi = lane >> 5;
      float* li_l = (float*)(lds + 3 * SHM_V + 3 * SHM_K) + wid * 64;
      char* stg = lds + wid * 8192;
      if (hi == 0) li_l[r32] = l_reg; asm volatile("s_waitcnt lgkmcnt(0)" ::: "memory");
      float wv[4];
#pragma unroll
      for (int d0 = 0; d0 < 4; ++d0) wv[d0] = wnh[d0 * 32 + r32];
#pragma unroll
      for (int r = 0; r < 16; ++r) { const int orow = crow(r, hi); const float rl = __builtin_amdgcn_rcpf(li_l[orow]);
          const float a0 = o[0][r] * rl, a1 = o[1][r] * rl, a2 = o[2][r] * rl, a3 = o[3][r] * rl;
          float sq = (a0 * a0 + a1 * a1) + (a2 * a2 + a3 * a3);
#pragma unroll
          for (int ofs = 1; ofs < 32; ofs <<= 1) sq += __shfl_xor(sq, ofs);
          if (r32 == 0) ssb[(size_t)(wid * 32 + orow) * 8] = sq;
          bf16* sp = (bf16*)(stg + orow * 256) + r32;
          sp[0] = (bf16)(cvtpk(a0 * wv[0], 0.f) & 0xffffu); sp[32] = (bf16)(cvtpk(a1 * wv[1], 0.f) & 0xffffu);
          sp[64] = (bf16)(cvtpk(a2 * wv[2], 0.f) & 0xffffu); sp[96] = (bf16)(cvtpk(a3 * wv[3], 0.f) & 0xffffu); }
      const char* gbase = (const char*)(mgb + (size_t)(wid * 32) * PITCH);
      const unsigned goff = (unsigned)((lane >> 4) * PITCH + (lane & 15) * 8) * 2u;
      u32x4 gv[8];
#pragma unroll
      for (int k = 0; k < 8; ++k) gv[k] = *(const u32x4*)(gbase + (size_t)k * (4 * PITCH * 2) + goff);
#pragma unroll
      for (int k = 0; k < 8; ++k) {
          const u32x4 nv = *(const u32x4*)(stg + (4 * k + (lane >> 4)) * 256 + (lane & 15) * 16);
          u32x4 ov;
#pragma unroll
          for (int q = 0; q < 4; ++q) ov[q] = cvtpk(bf_lo(nv[q]) * bf_lo(gv[k][q]), bf_hi(nv[q]) * bf_hi(gv[k][q]));
          *(u32x4*)((char*)gbase + (size_t)k * (4 * PITCH * 2) + goff) = ov;
      } }
#undef SLOAD
#undef SWRITE
#undef SWAIT
}

__device__ __forceinline__ const char* uptr(const char* p) { const unsigned long long a = (unsigned long long)p;
    const unsigned lo = __builtin_amdgcn_readfirstlane((unsigned)a), hi = __builtin_amdgcn_readfirstlane((unsigned)(a >> 32));
    return (const char*)(((unsigned long long)hi << 32) | lo); }

__device__ __forceinline__ void ret_state_phase(const bf16* __restrict__ proj, bf16* __restrict__ kvs, const float* __restrict__ dl_f, const float* __restrict__ dl_b, int bid, int G, char* lds) {
    const int tid = fresh_tid(), wid = tid >> 6, lane = tid & 63, r32 = lane & 31, hi = lane >> 5;
    char* KX = lds;
    char* VT = lds + 32768;
    const unsigned koff = (unsigned)((tid >> 3) * PITCH + (tid & 7) * 8) * 2u, voff = (unsigned)((tid >> 4) * PITCH + (tid & 15) * 8) * 2u;
    const int rb = wid & 3, cg2 = wid >> 2;
    const int kb = (int)(uintptr_t)KX + v_rd_base(lane) + rb * 512;
    const int vb = (int)(uintptr_t)VT + v_rd_base(lane) + cg2 * 1024;
    u32x4 kreg[2], vreg[4];
#define RS_LOAD(U) do { const int bh_ = (U) >> 6, c_ = (U) & 63, b_ = bh_ >> 3, h_ = bh_ & 7; const size_t row0_ = (size_t)b_ * SEQ + (size_t)c_ * 128; \
        const char* kbase_ = (const char*)(proj + row0_ * PITCH + C_RK + h_ * 64); const char* vbase_ = (const char*)(proj + row0_ * PITCH + C_RV + h_ * 128); \
        _Pragma("unroll") for (int i = 0; i < 2; ++i) kreg[i] = *(const u32x4*)(uptr(kbase_ + (size_t)i * (64 * PITCH * 2)) + koff); \
        _Pragma("unroll") for (int i = 0; i < 4; ++i) vreg[i] = *(const u32x4*)(uptr(vbase_ + (size_t)i * (32 * PITCH * 2)) + voff); } while (0)
    int u = bid;
    if (u < BATCH * NH * 64) RS_LOAD(u);
    for (; u < BATCH * NH * 64; u += G) {
        const int bh = u >> 6, c = u & 63, h = bh & 7;
        const float lgf2 = -log1pf(expf(-dl_f[h])) * LOG2E, lgb2 = -log1pf(expf(-dl_b[h])) * LOG2E;
#pragma unroll
        for (int i = 0; i < 2; ++i) {
            const int key = (tid >> 3) + 64 * i, ch = tid & 7;
            const float df = __builtin_amdgcn_exp2f(lgf2 * (float)(127 - key)), db = __builtin_amdgcn_exp2f(lgb2 * (float)key);
            u32x4 wf, wb;
#pragma unroll
            for (int q = 0; q < 4; ++q) { const float x = bf_lo(kreg[i][q]), y = bf_hi(kreg[i][q]); wf[q] = cvtpk(x * df, y * df); wb[q] = cvtpk(x * db, y * db); }
            char* t = KX + (key >> 6) * 16384;
            *(u32x4*)(t + v_st(key & 63, ch * 8)) = wf;
            *(u32x4*)(t + v_st(key & 63, 64 + ch * 8)) = wb;
        }
#pragma unroll
        for (int i = 0; i < 4; ++i) {
            const int key = (tid >> 4) + 32 * i, ch = tid & 15;
            *(u32x4*)(VT + (key >> 6) * 16384 + v_st(key & 63, ch * 8)) = vreg[i];
        }
        __syncthreads();
        if (u + G < BATCH * NH * 64) RS_LOAD(u + G);
        f32x16 acc0 = {}, acc1 = {};
#define RS_STEP(T, KS) do { \
        const s16x4 al = tr_read<(T) * 16384 + (KS) * 4096>(kb), ah = tr_read<(T) * 16384 + (KS) * 4096 + 2048>(kb); \
        const s16x4 bl0 = tr_read<(T) * 16384 + (KS) * 4096>(vb), bh0 = tr_read<(T) * 16384 + (KS) * 4096 + 2048>(vb); \
        const s16x4 bl1 = tr_read<(T) * 16384 + (KS) * 4096 + 512>(vb), bh1 = tr_read<(T) * 16384 + (KS) * 4096 + 2048 + 512>(vb); \
        asm volatile("s_waitcnt lgkmcnt(0)" ::: "memory"); SBAR(); \
        acc0 = __builtin_amdgcn_mfma_f32_32x32x16_bf16(PKF(al, ah), PKF(bl0, bh0), acc0, 0, 0, 0); \
        acc1 = __builtin_amdgcn_mfma_f32_32x32x16_bf16(PKF(al, ah), PKF(bl1, bh1), acc1, 0, 0, 0); } while (0)
        RS_STEP(0, 0); RS_STEP(0, 1); RS_STEP(0, 2); RS_STEP(0, 3); RS_STEP(1, 0); RS_STEP(1, 1); RS_STEP(1, 2); RS_STEP(1, 3);
#undef RS_STEP
        const int dir = rb >> 1;
        bf16* op = kvs + (((size_t)(bh * 64 + c) * 2 + dir) * 64) * 128;
#pragma unroll
        for (int r = 0; r < 16; ++r) { const int dk = 32 * (rb & 1) + crow(r, hi);
            op[dk * 128 + (2 * cg2) * 32 + r32] = (bf16)(cvtpk(acc0[r], 0.f) & 0xffffu);
            op[dk * 128 + (2 * cg2 + 1) * 32 + r32] = (bf16)(cvtpk(acc1[r], 0.f) & 0xffffu); }
        __syncthreads();
    }
#undef RS_LOAD
}

__device__ __forceinline__ void ret_main_phase(bf16* __restrict__ proj, const bf16* __restrict__ kvs, const float* __restrict__ gnw, const float* __restrict__ dl_f, const float* __restrict__ dl_b, int bid, int G, char* lds) {
    const int tid = fresh_tid(), wid = tid >> 6, lane = tid & 63, r32 = lane & 31, hi = lane >> 5;
    char* KT = lds;
    char* VT = lds + 32768;
    const unsigned koff = (unsigned)((tid >> 3) * PITCH + (tid & 7) * 8) * 2u, voff = (unsigned)((tid >> 4) * PITCH + (tid & 15) * 8) * 2u;
    const int c = wid >> 2, iloc = 32 * (wid & 3) + r32;
    const unsigned qoff = (unsigned)((128 * c + iloc) * PITCH + hi * 8) * 2u;
    const int vb0 = (int)(uintptr_t)VT + v_rd_base(lane);
    u32x4 kreg[4], vreg[8]; bf16x8 qr[4];
#define RM_LOAD(U) do { const int bh_ = (U) >> 5, cp_ = (U) & 31, b_ = bh_ >> 3, h_ = bh_ & 7; const size_t row0_ = (size_t)b_ * SEQ + (size_t)cp_ * 256; \
        const char* kbase_ = (const char*)(proj + row0_ * PITCH + C_RK + h_ * 64); const char* vbase_ = (const char*)(proj + row0_ * PITCH + C_RV + h_ * 128); \
        const char* qbase_ = (const char*)(proj + row0_ * PITCH + C_RQ + h_ * 64); \
        _Pragma("unroll") for (int i = 0; i < 4; ++i) kreg[i] = *(const u32x4*)(uptr(kbase_ + (size_t)i * (64 * PITCH * 2)) + koff); \
        _Pragma("unroll") for (int i = 0; i < 8; ++i) vreg[i] = *(const u32x4*)(uptr(vbase_ + (size_t)i * (32 * PITCH * 2)) + voff); \
        _Pragma("unroll") for (int d0 = 0; d0 < 4; ++d0) qr[d0] = *(const bf16x8*)(uptr(qbase_ + d0 * 32) + qoff); } while (0)
    int u = bid;
    if (u < 1024) RM_LOAD(u);
    for (; u < 1024; u += G) {
        const int bh = u >> 5, cp = u & 31, b = bh >> 3, h = bh & 7;
        const float lgf2 = -log1pf(expf(-dl_f[h])) * LOG2E, lgb2 = -log1pf(expf(-dl_b[h])) * LOG2E;
        const size_t row0 = (size_t)b * SEQ + (size_t)cp * 256;
        int iloc_l = iloc, hi_l = hi; asm volatile("" : "+v"(iloc_l), "+v"(hi_l));
#pragma unroll
        for (int i = 0; i < 4; ++i) { const int key = (tid >> 3) + 64 * i, ch = tid & 7; *(u32x4*)(KT + key * 128 + ((ch ^ (key & 7)) << 4)) = kreg[i]; }
#pragma unroll
        for (int i = 0; i < 8; ++i) { const int key = (tid >> 4) + 32 * i, ch = tid & 15; *(u32x4*)(VT + (key >> 6) * 16384 + v_st_raw(key & 63, ch * 8)) = vreg[i]; }
        __syncthreads();
        u32x4 sreg[8];
        { const char* sbase = (const char*)(kvs + (size_t)(bh * 64 + 2 * cp) * (128 * 128));
#pragma unroll
          for (int i = 0; i < 8; ++i) sreg[i] = *(const u32x4*)(uptr(sbase + (size_t)i * 8192) + (unsigned)tid * 16u); }
        f32x16 o[4] = {};
#pragma unroll
        for (int kt = 0; kt < 2; ++kt) {
            const int T = 2 * c + kt;
            f32x16 p0 = {}, p1 = {};
#pragma unroll
            for (int d0 = 0; d0 < 4; ++d0) { const int ch = d0 * 2 + hi; const int k0 = T * 64 + r32, k1 = k0 + 32;
                const bf16x8 b0 = *(const bf16x8*)(KT + k0 * 128 + ((ch ^ (k0 & 7)) << 4));
                const bf16x8 b1 = *(const bf16x8*)(KT + k1 * 128 + ((ch ^ (k1 & 7)) << 4));
                p0 = __builtin_amdgcn_mfma_f32_32x32x16_bf16(b0, qr[d0], p0, 0, 0, 0);
                p1 = __builtin_amdgcn_mfma_f32_32x32x16_bf16(b1, qr[d0], p1, 0, 0, 0); }
#pragma unroll
            for (int r = 0; r < 16; ++r) {
                const int j0 = 64 * kt + crow(r, hi_l), d0_ = iloc_l - j0, d1_ = d0_ - 32;
                const float e0 = (d0_ >= 0 ? lgf2 : -lgb2) * (float)d0_;
                const float e1 = (d1_ >= 0 ? lgf2 : -lgb2) * (float)d1_;
                p0[r] *= __builtin_amdgcn_exp2f(e0); p1[r] *= __builtin_amdgcn_exp2f(e1);
            }
            bf16x8 pa0, pa1, pa2, pa3;
            PK4(p0, 0, pa0); PK4(p0, 8, pa1); PK4(p1, 0, pa2); PK4(p1, 8, pa3);
            pv_d0(o, vb0 + T * 16384, pa0, pa1, pa2, pa3);
        }
        __syncthreads();
#pragma unroll
        for (int i = 0; i < 8; ++i) { const int trow = (tid >> 4) + 32 * i, ch = tid & 15, tile = trow >> 6, dk = trow & 63;
            *(u32x4*)(VT + tile * 16384 + v_st(dk, ch * 8)) = sreg[i]; }
        __syncthreads();
#pragma unroll
        for (int dir = 0; dir < 2; ++dir) {
            const float dec = dir == 0 ? __builtin_amdgcn_exp2f(lgf2 * (float)(iloc_l + 1)) : __builtin_amdgcn_exp2f(lgb2 * (float)(128 - iloc_l));
            bf16x8 pa[4];
#pragma unroll
            for (int k = 0; k < 4; ++k) { const u32x4 w = *reinterpret_cast<const u32x4*>(&qr[k]); u32x4 o4;
#pragma unroll
                for (int q = 0; q < 4; ++q) o4[q] = cvtpk(bf_lo(w[q]) * dec, bf_hi(w[q]) * dec);
                pa[k] = *reinterpret_cast<bf16x8*>(&o4); }
            pv_d0(o, vb0 + (2 * c + dir) * 16384, pa[0], pa[1], pa[2], pa[3]);
        }
        if (u + G < 1024) RM_LOAD(u + G);
        __syncthreads();
        char* stg = VT + wid * 8192;
        float gw[4];
#pragma unroll
        for (int d0 = 0; d0 < 4; ++d0) gw[d0] = gnw[h * 128 + d0 * 32 + r32];
#pragma unroll
        for (int r = 0; r < 16; ++r) {
            float s1 = (o[0][r] + o[1][r]) + (o[2][r] + o[3][r]);
            float s2 = (o[0][r] * o[0][r] + o[1][r] * o[1][r]) + (o[2][r] * o[2][r] + o[3][r] * o[3][r]);
#pragma unroll
            for (int ofs = 1; ofs < 32; ofs <<= 1) { s1 += __shfl_xor(s1, ofs); s2 += __shfl_xor(s2, ofs); }
            const float mu = s1 * (1.f / 128.f), var = fmaxf(s2 * (1.f / 128.f) - mu * mu, 0.f), rs = __builtin_amdgcn_rsqf(var + EPS);
            bf16* sp = (bf16*)(stg + crow(r, hi_l) * 256) + r32;
#pragma unroll
            for (int d0 = 0; d0 < 4; ++d0) sp[d0 * 32] = (bf16)(cvtpk((o[d0][r] - mu) * rs * gw[d0], 0.f) & 0xffffu);
        }
        { const char* gbase = (const char*)(proj + (row0 + 128 * c + 32 * (wid & 3)) * PITCH + C_RG + h * 128);
          const unsigned goff = (unsigned)((lane >> 4) * PITCH + (lane & 15) * 8) * 2u;
          u32x4 gv[8];
#pragma unroll
          for (int k = 0; k < 8; ++k) gv[k] = *(const u32x4*)(uptr(gbase + (size_t)k * (4 * PITCH * 2)) + goff);
#pragma unroll
          for (int k = 0; k < 8; ++k) {
              const u32x4 nv = *(const u32x4*)(stg + (4 * k + (lane >> 4)) * 256 + (lane & 15) * 16);
              u32x4 ov;
#pragma unroll
              for (int q = 0; q < 4; ++q) ov[q] = cvtpk(bf_lo(nv[q]) * bf_lo(gv[k][q]), bf_hi(nv[q]) * bf_hi(gv[k][q]));
              *(u32x4*)((char*)uptr(gbase + (size_t)k * (4 * PITCH * 2)) + goff) = ov;
          } }
        __syncthreads();
    }
#undef RM_LOAD
}

__global__ void __launch_bounds__(NTHREADS) fwd_megakernel(Params p) {
    extern __shared__ __attribute__((aligned(16))) unsigned char lds[];
    cg::grid_group grid = cg::this_grid();
    const int G = gridDim.x, bid = blockIdx.x;
    const int NGW = G * NWAVES; const long NGT = (long)G * NTHREADS;
#define PHASE_IDS() const int tid = fresh_tid(), lane = tid & 63, wave = tid >> 6, gw = bid * NWAVES + wave; const long gt = (long)bid * NTHREADS + tid; (void)lane; (void)gw; (void)gt
    unsigned char* ws = p.ws;
    const float* x = p.in[0]; const float* cvec = p.in[1]; const int* positions = (const int*)p.in[2];
    const float* norm_w = p.in[3]; const float* w_ada = p.in[4]; const float* b_ada = p.in[5]; const float* w_in = p.in[6];
    const float* dl_f = p.in[7]; const float* dl_b = p.in[8]; const float* gn_w = p.in[9];
    const float* q_norm_w = p.in[10]; const float* w_uq = p.in[11]; const float* kv_norm_w = p.in[12]; const float* w_ukv = p.in[13];
    const float* qn_nope_w = p.in[14]; const float* qn_rope_w = p.in[15]; const float* kn_nope_w = p.in[16]; const float* kn_rope_w = p.in[17];
    const float* mla_norm_w = p.in[18]; const float* w_out = p.in[19];
    bf16* PROJ = (bf16*)(ws + WS_PROJ); bf16* KB = (bf16*)(ws + WS_K); bf16* VB = (bf16*)(ws + WS_V);
    bf16* WIN = (bf16*)(ws + WS_WIN); bf16* WQ = (bf16*)(ws + WS_WQ); bf16* WKV = (bf16*)(ws + WS_WKV); bf16* WO = (bf16*)(ws + WS_WO);
    float* CS64 = (float*)(ws + WS_CS64); float* CS32 = (float*)(ws + WS_CS32); float* MOD = (float*)(ws + WS_MOD); f32x2* STAT = (f32x2*)(ws + WS_STAT);
    float* SSB = (float*)(ws + WS_SS);
    bf16* HB = (bf16*)p.out; bf16* QO = (bf16*)((unsigned char*)p.out + OUT_QO); bf16* KVS = (bf16*)((unsigned char*)p.out + OUT_KVS);

    if (threadIdx.x < 4) ((volatile LAS unsigned*)((LAS unsigned char*)lds + LDS_CTL_OFF))[threadIdx.x] = 0u;
    __syncthreads();
    const XcdBarrier xbar = xcd_barrier_post((unsigned*)(ws + WS_BAR), (volatile LAS unsigned*)((LAS unsigned char*)lds + LDS_CTL_OFF));
#define GRID_BAR() xcd_barrier(xbar)
    {
        PHASE_IDS();
        float* sc = (float*)lds; float* red = (float*)(lds + 16384);
        for (int it = bid; it < 192; it += G) {
            for (int i = tid; i < 4096; i += NTHREADS) sc[i] = silu_f(cvec[i]);
            __syncthreads();
            const int ks4 = lane >> 4, col = lane & 15, kb0 = wave * 128 + ks4 * 32;
            const float* wp = w_ada + (size_t)kb0 * 3072 + it * 16 + col;
            float a0 = 0.f, a1 = 0.f, a2 = 0.f, a3 = 0.f;
#pragma unroll 8
            for (int i = 0; i < 32; ++i) { const float wv = wp[(size_t)i * 3072]; const int k = kb0 + i;
                a0 += sc[k] * wv; a1 += sc[1024 + k] * wv; a2 += sc[2048 + k] * wv; a3 += sc[3072 + k] * wv; }
            a0 += __shfl_xor(a0, 16); a0 += __shfl_xor(a0, 32); a1 += __shfl_xor(a1, 16); a1 += __shfl_xor(a1, 32);
            a2 += __shfl_xor(a2, 16); a2 += __shfl_xor(a2, 32); a3 += __shfl_xor(a3, 16); a3 += __shfl_xor(a3, 32);
            if (lane < 16) { red[(wave * 4 + 0) * 16 + lane] = a0; red[(wave * 4 + 1) * 16 + lane] = a1; red[(wave * 4 + 2) * 16 + lane] = a2; red[(wave * 4 + 3) * 16 + lane] = a3; }
            __syncthreads();
            if (tid < 64) { const int bb = tid >> 4, l = tid & 15; float s = b_ada[it * 16 + l];
#pragma unroll
                for (int w = 0; w < 8; ++w) s += red[(w * 4 + bb) * 16 + l];
                MOD[bb * 3072 + it * 16 + l] = s; }
            __syncthreads();
        }
    }
    if (p.ws == nullptr) grid.sync();
    GRID_BAR();
#if PROBE_DUP == 4
    for (int rep_ = 0; rep_ < 2; ++rep_)
#endif
    {
    {
        PHASE_IDS();
        constexpr long I1 = 4864L * 128, I2 = 768L * 48, I3 = 1536L * 32, I4 = 1024L * 256;
        for (long it = gt; it < I1 + I2 + I3 + I4; it += NGT) {
            long r = it; const float* W; const float* ksc = nullptr; int n, kc, Kd, No, oc; bf16* WT;
            if (r < I1) { n = (int)(r % 4864); kc = (int)(r / 4864); W = w_in; Kd = 1024; No = D_IN; oc = win_colmap(n); WT = WIN; }
            else if ((r -= I1) < I2) { n = (int)(r % 768); kc = (int)(r / 768); W = w_uq; Kd = 384; No = 768; oc = wq_colmap(n); WT = WQ; ksc = q_norm_w; }
            else if ((r -= I2) < I3) { n = (int)(r % 1536); kc = (int)(r / 1536); W = w_ukv; Kd = 256; No = 1536; oc = wkv_colmap(n); WT = WKV; ksc = kv_norm_w; }
            else { r -= I3; n = (int)(r % 1024); kc = (int)(r / 1024); W = w_out; Kd = 2048; No = 1024; oc = n; WT = WO; }
            float v[8];
#pragma unroll
            for (int i = 0; i < 8; ++i) { const int k = kc * 8 + i; const int ks_ = (W == w_out) ? (k < 1024 ? k + 1024 : k - 1024) : k;
                float t = oc >= 0 ? W[(size_t)ks_ * No + oc] : 0.f; if (ksc) t *= ksc[k]; v[i] = t; }
            u32x4 w; w.x = cvtpk(v[0], v[1]); w.y = cvtpk(v[2], v[3]); w.z = cvtpk(v[4], v[5]); w.w = cvtpk(v[6], v[7]);
            *(u32x4*)(WT + (size_t)n * Kd + kc * 8) = w;
        }
        for (long it = gt; it < (long)M * 48; it += NGT) {
            const int m = (int)(it / 48), i = (int)(it % 48);
            const float pos = (float)positions[m];
            const float fe = i < 32 ? (float)(2 * i) * (1.f / 64.f) : (float)(2 * (i - 32)) * (1.f / 32.f);
            const float invf = exp2f(-fe * 13.287712379549449f);
            const float ang = pos * invf;
            double rev = (double)ang * 0.15915494309189535; rev -= floor(rev);
            const float rf = (float)rev;
            const float cs = __builtin_amdgcn_cosf(rf), sn = __builtin_amdgcn_sinf(rf);
            float* dst = i < 32 ? CS64 + ((size_t)m * 32 + i) * 2 : CS32 + ((size_t)m * 16 + (i - 32)) * 2;
            *(f32x2*)dst = (f32x2){cs, sn};
        }
    }
    { PHASE_IDS();
    for (int m0 = gw; m0 < M; m0 += 2 * NGW) {
        const int m1 = m0 + NGW; const bool has1 = m1 < M;
        const f32x4* xr0 = (const f32x4*)(x + (size_t)m0 * DM) + lane; const f32x4* xr1 = (const f32x4*)(x + (size_t)(has1 ? m1 : m0) * DM) + lane;
        f32x4 v0[4], v1[4]; float s0 = 0.f, s1 = 0.f;
#pragma unroll
        for (int j = 0; j < 4; ++j) { v0[j] = xr0[64 * j]; v1[j] = xr1[64 * j]; }
#pragma unroll
        for (int j = 0; j < 4; ++j) { s0 += (v0[j].x * v0[j].x + v0[j].y * v0[j].y) + (v0[j].z * v0[j].z + v0[j].w * v0[j].w);
                                      s1 += (v1[j].x * v1[j].x + v1[j].y * v1[j].y) + (v1[j].z * v1[j].z + v1[j].w * v1[j].w); }
        const float rstd0 = __builtin_amdgcn_rsqf(wave_sum(s0) * (1.f / DM) + EPS), rstd1 = __builtin_amdgcn_rsqf(wave_sum(s1) * (1.f / DM) + EPS);
        const int b0 = m0 / SEQ, b1 = (has1 ? m1 : m0) / SEQ;
        u32x2* o80 = (u32x2*)(HB + (size_t)m0 * DM) + lane; u32x2* o81 = (u32x2*)(HB + (size_t)m1 * DM) + lane;
#pragma unroll
        for (int j = 0; j < 4; ++j) {
            const int col = 4 * lane + 256 * j;
            const f32x4 nw = *(const f32x4*)(norm_w + col);
            { const f32x4 sh = *(const f32x4*)(MOD + b0 * 3072 + col), scl = *(const f32x4*)(MOD + b0 * 3072 + 1024 + col);
              const f32x4 hv = v0[j] * rstd0 * nw * (scl + 1.f) + sh; o80[64 * j] = (u32x2){cvtpk(hv.x, hv.y), cvtpk(hv.z, hv.w)}; }
            if (has1) { const f32x4 sh = *(const f32x4*)(MOD + b1 * 3072 + col), scl = *(const f32x4*)(MOD + b1 * 3072 + 1024 + col);
              const f32x4 hv = v1[j] * rstd1 * nw * (scl + 1.f) + sh; o81[64 * j] = (u32x2){cvtpk(hv.x, hv.y), cvtpk(hv.z, hv.w)}; }
        }
    } }
    }
    GRID_BAR();

    {
        pg8::Gemm g{HB, WIN, M, PITCH, DM, DM}; pg8::StaticOrder S; S.init(M, PITCH, G, bid);
        EpiIn E{PROJ, CS64};
        pg8::gemm_phase<EpiIn, pg8::StaticOrder>((LAS unsigned char*)lds, g, S, E);
    }
    GRID_BAR();

#if PROBE_DUP == 1
    for (int rep_ = 0; rep_ < 2; ++rep_)
#endif
    {
    { PHASE_IDS();
    const int sub = lane >> 4, l16 = lane & 15;
    for (int m0 = gw * 4; m0 < M; m0 += NGW * 4) {
        const int m = m0 + sub, b = m / SEQ, s = m - b * SEQ;
        const bf16* pr = PROJ + (size_t)m * PITCH + C_CQ + 8 * l16;
        u32x4 v[6];
#pragma unroll
        for (int i = 0; i < 5; ++i) v[i] = *(const u32x4*)(pr + 128 * i);
        v[5] = (u32x4){0u, 0u, 0u, 0u}; if (l16 < 4) v[5] = *(const u32x4*)(pr + 640);
        float s_cq = sumsq8(v[0]) + sumsq8(v[1]) + sumsq8(v[2]);
        float s_ckv = sumsq8(v[3]) + sumsq8(v[4]);
        float s_kr = sumsq8(v[5]);
#pragma unroll
        for (int ofs = 1; ofs < 16; ofs <<= 1) { s_cq += __shfl_xor(s_cq, ofs); s_ckv += __shfl_xor(s_ckv, ofs); s_kr += __shfl_xor(s_kr, ofs); }
        if (l16 == 0) STAT[m] = (f32x2){s_cq * (1.f / 384.f), s_ckv * (1.f / 256.f)};
        const float rk = __builtin_amdgcn_rsqf(s_kr * (1.f / 32.f) + EPS);
        const u32x4 b2 = v[5];
        u32x4 pw; pw.x = __shfl_xor(b2.x, 2); pw.y = __shfl_xor(b2.y, 2); pw.z = __shfl_xor(b2.z, 2); pw.w = __shfl_xor(b2.w, 2);
        if (l16 < 2) {
            const int pb = 8 * l16;
            unsigned ow[8];
#pragma unroll
            for (int q = 0; q < 4; ++q) {
#pragma unroll
                for (int e = 0; e < 2; ++e) {
                    const int pidx = pb + 2 * q + e;
                    const float x1 = (e ? bf_hi(b2[q]) : bf_lo(b2[q])) * rk * kn_rope_w[pidx];
                    const float x2 = (e ? bf_hi(pw[q]) : bf_lo(pw[q])) * rk * kn_rope_w[pidx + 16];
                    const f32x2 csv = *(const f32x2*)(CS32 + ((size_t)m * 16 + pidx) * 2);
                    ow[2 * q + e] = cvtpk(x1 * csv.x - x2 * csv.y, x2 * csv.x + x1 * csv.y);
                }
            }
            const u32x4 w0 = {ow[0], ow[1], ow[2], ow[3]}, w1 = {ow[4], ow[5], ow[6], ow[7]};
#pragma unroll
            for (int hh = 0; hh < NH; ++hh) { bf16* kp = KB + ((size_t)(b * NH + hh) * SEQ + s) * 96 + 64 + 16 * l16;
                *(u32x4*)kp = w0; *(u32x4*)(kp + 8) = w1; }
        }
    } }
    ret_state_phase(PROJ, KVS, dl_f, dl_b, bid, G, (char*)lds);
    }
    GRID_BAR();

    { PHASE_IDS();
    for (long it = gt; it < 32L * 2 * 2048; it += NGT) {
        const int e4 = (int)(it & 2047), dir = (int)((it >> 11) & 1), bh = (int)(it >> 12), h = bh & 7;
        const float lg2 = -log1pf(expf(-(dir ? dl_b[h] : dl_f[h]))) * LOG2E;
        const float gC = __builtin_amdgcn_exp2f(lg2 * 128.f);
        float s0 = 0.f, s1 = 0.f, s2 = 0.f, s3 = 0.f;
        for (int i = 0; i < 64; ++i) {
            const int c = dir ? 63 - i : i;
            u32x2* ptr = (u32x2*)(KVS + (((size_t)(bh * 64 + c) * 2 + dir) * 8192) + 4 * e4);
            const u32x2 kv = *ptr;
            *ptr = (u32x2){cvtpk(s0, s1), cvtpk(s2, s3)};
            s0 = s0 * gC + bf_lo(kv.x); s1 = s1 * gC + bf_hi(kv.x); s2 = s2 * gC + bf_lo(kv.y); s3 = s3 * gC + bf_hi(kv.y);
        }
    } }
#if PROBE_DUP == 2
    for (int rep_ = 0; rep_ < 2; ++rep_)
#endif
    {
    {
        pg8::Gemm g{PROJ + C_CQ, WQ, M, 768, 384, PITCH}; pg8::StaticOrder S; S.init(M, 768, G, G - 1 - bid);
        EpiUp<3> E{QO, nullptr, STAT, qn_nope_w, qn_rope_w, CS32};
        pg8::gemm_phase<EpiUp<3>, pg8::StaticOrder>((LAS unsigned char*)lds, g, S, E);
    }
    {
        pg8::Gemm g{PROJ + C_CKV, WKV, M, 1536, 256, PITCH}; pg8::StaticOrder S; S.init(M, 1536, G, bid);
        EpiUp<2> E{KB, VB, STAT, kn_nope_w, nullptr, nullptr};
        pg8::gemm_phase<EpiUp<2>, pg8::StaticOrder>((LAS unsigned char*)lds, g, S, E);
    }
    }
    GRID_BAR();

    {
        const int nA = (1024 + G - 1) / G, rslot = (bid & 7) % (nA + 1);
        for (int i = 0; i <= nA; ++i) {
            if (i == rslot) ret_main_phase(PROJ, KVS, gn_w, dl_f, dl_b, bid, G, (char*)lds);
            const int u = i * G + bid;
            if (i < nA && u < 1024) {
                int bh, qb;
                if (G == 256) { bh = (bid & 7) * 4 + i; qb = bid >> 3; } else { bh = u >> 5; qb = u & 31; }
                bf16* qo = QO + ((size_t)bh * SEQ + (size_t)qb * 256) * 128;
                const int b_ = bh >> 3, h_ = bh & 7; const size_t row_ = (size_t)b_ * SEQ + (size_t)qb * 256;
                attn_unit(qo, KB + (size_t)bh * SEQ * 96, VB + (size_t)bh * SEQ * 128, SEQ, (char*)lds,
                          PROJ + row_ * PITCH + C_MG + h_ * 128, SSB + row_ * 8 + h_, mla_norm_w + h_ * 128);
                __syncthreads();
            }
        }
    }
    GRID_BAR();

    {
        pg8::Gemm g{PROJ + C_MG, WO, M, DM, 2048, PITCH}; pg8::StaticOrder S; S.init(M, DM, G, bid);
        EpiOut E{x, p.out, MOD, SSB};
        pg8::gemm_phase<EpiOut, pg8::StaticOrder>((LAS unsigned char*)lds, g, S, E);
    }
}

extern "C" void kernel_launch(void* const* d_in, const int* in_sizes, int n_in, void* d_out, int out_size, void* d_ws, size_t ws_size, hipStream_t stream) {
    static int grid_blocks = 0;
    if (grid_blocks == 0) {
        if (n_in != 20 || out_size != M * DM || ws_size < WS_END) { fprintf(stderr, "kernel_launch: unexpected shapes (n_in %d out %d ws %zu)\n", n_in, out_size, ws_size); grid_blocks = -1; return; }
        int dev = 0, cus = 0, per_cu = 0;
        hipGetDevice(&dev);
        hipDeviceGetAttribute(&cus, hipDeviceAttributeMultiprocessorCount, dev);
        if (hipFuncSetAttribute((const void*)fwd_megakernel, hipFuncAttributeMaxDynamicSharedMemorySize, LDS_BYTES) != hipSuccess) { fprintf(stderr, "kernel_launch: hipFuncSetAttribute failed\n"); grid_blocks = -1; return; }
        if (hipOccupancyMaxActiveBlocksPerMultiprocessor(&per_cu, (const void*)fwd_megakernel, NTHREADS, LDS_BYTES) != hipSuccess || per_cu < 1) { fprintf(stderr, "kernel_launch: occupancy query failed (%d)\n", per_cu); per_cu = 1; }
        (void)hipGetLastError();
        grid_blocks = cus * per_cu;
    }
    if (grid_blocks < 0) return;
    if (hipMemsetAsync((char*)d_ws + WS_BAR, 0, XCD_BAR_WORDS * 4, stream) != hipSuccess) { fprintf(stderr, "kernel_launch: memset failed\n"); return; }
    Params p{};
    for (int i = 0; i < 20; ++i) p.in[i] = (const float*)d_in[i];
    p.out = (float*)d_out; p.ws = (unsigned char*)d_ws;
    void* args[] = {&p};
    hipError_t e = hipLaunchCooperativeKernel((const void*)fwd_megakernel, dim3(grid_blocks), dim3(NTHREADS), args, LDS_BYTES, stream);
    if (e != hipSuccess) fprintf(stderr, "cooperative launch failed: %s (grid %d)\n", hipGetErrorString(e), grid_blocks);
}
```

```cpp
#ifndef PROBE_DUP
#define PROBE_DUP 0
#endif
#include <hip/hip_runtime.h>
#include <hip/hip_cooperative_groups.h>
#include <cstdio>
#include <cstdint>
namespace cg = cooperative_groups;

namespace pg8 {
#define PG8_LAS __attribute__((address_space(3)))
typedef unsigned short bf16_t;
typedef short bf16x8 __attribute__((ext_vector_type(8)));
typedef float f32x4 __attribute__((ext_vector_type(4)));
typedef unsigned u32x4 __attribute__((ext_vector_type(4)));
constexpr int BM = 256, BK = 64, HALF = 128, HTB = HALF * BK * 2, STAGE_BYTES = 8 * HTB, NXCD = 8, WGM = 8;

__host__ __device__ __forceinline__ int lds_byte(int r, int c) { const int st = (r >> 4) * 2 + (c >> 5), rr = r & 15, cc = c & 31, ob = rr * 64 + cc * 2; return st * 1024 + (ob ^ (((ob >> 9) & 1) << 5)); }
__host__ __device__ __forceinline__ void stage_rc(int b, int& R, int& C) { const int st = b / 1024, sb = b % 1024, swz = sb ^ (((sb >> 9) & 1) << 5); R = (st >> 1) * 16 + swz / 64; C = (st & 1) * 32 + (swz % 64) / 2; }
__host__ __device__ __forceinline__ int perm32(int rho) { const int n = rho >> 4, i = rho & 15; return 8 * (i >> 2) + 4 * n + (i & 3); }

struct Unit { int pm, pn; };
struct Gemm { const bf16_t* A; const bf16_t* Bt; int M, N, K, lda; };

struct StaticOrder {
    int nM, nN, nwg, G, c;
    __host__ __device__ void init(int M, int N, int G_, int c_) { nM = M / BM; nN = N / BM; nwg = nM * nN; G = G_; c = c_; }
    __host__ __device__ bool next(int i, Unit& u) const {
        const long L = (long)i * G + c; if (L >= nwg) return false;
        int wgid = (int)L; { const int q = nwg / NXCD, r = nwg % NXCD, xcd = wgid % NXCD, off = wgid / NXCD; wgid = (xcd < r ? xcd * (q + 1) : r * (q + 1) + (xcd - r) * q) + off; }
        const int nig = WGM * nN, gid = wgid / nig, fm = gid * WGM, gsz = (nM - fm) < WGM ? (nM - fm) : WGM;
        u.pm = fm + ((wgid % nig) % gsz); u.pn = (wgid % nig) / gsz; return true;
    }
};

typedef float f32x2_c __attribute__((ext_vector_type(2)));
typedef __bf16 bf16x2_c __attribute__((ext_vector_type(2)));
__device__ __forceinline__ unsigned cvt_pk_bf16(float lo, float hi) { const f32x2_c v = {lo, hi}; return __builtin_bit_cast(unsigned, __builtin_convertvector(v, bf16x2_c)); }

template <class Epi, class Sched>
__device__ __forceinline__ void gemm_phase(PG8_LAS unsigned char* lds, const Gemm g, const Sched& S, const Epi& E) {
    int tid_ = threadIdx.x; asm volatile("" : "+v"(tid_));
    const int tid = tid_, wid = __builtin_amdgcn_readfirstlane(tid >> 6), lane = tid & 63, wr = wid >> 2, wc = wid & 3, fr = lane & 15, fq = lane >> 4;
    const int K = g.K, nt = K / BK, lda = g.lda;
    unsigned voffA[2], voffB[2];
#pragma unroll
    for (int i = 0; i < 2; ++i) { int R, C; stage_rc(tid * 16 + i * 8192, R, C); const int Rb = Epi::PERM ? ((R & ~31) + perm32(R & 31)) : R;
        voffA[i] = (unsigned)(R * lda + C) * 2u; voffB[i] = (unsigned)(Rb * K + C) * 2u; }
    const size_t kstep = (size_t)(BK * 2);
    const size_t hstepA = (size_t)HALF * lda * 2, hstepB = (size_t)HALF * K * 2;
    const size_t tstepA = 2 * hstepA, tstepB = 2 * hstepB;
    const unsigned ldsw = (unsigned)wid * 1024u;
    const int aoff = lds_byte(wr * 64 + fr, fq * 8), boff = lds_byte(wc * 32 + fr, fq * 8);
#define PG8_SA(b, h) (((b) * 2 + (h)) * HTB)
#define PG8_SB(b, h) ((4 + (b) * 2 + (h)) * HTB)
#define PG8_STAGE(bufoff, gbase, voff) do { _Pragma("unroll") for (int _i = 0; _i < 2; ++_i) \
        __builtin_amdgcn_global_load_lds((const unsigned*)((const char*)(gbase) + (voff)[_i]), (PG8_LAS unsigned*)(lds + (bufoff) + ldsw + _i * 8192), 16, 0, 0); } while (0)
#define PG8_LDA(dst, b, h) do { _Pragma("unroll") for (int m = 0; m < 4; ++m) _Pragma("unroll") for (int k = 0; k < 2; ++k) dst[m][k] = *(const PG8_LAS bf16x8*)(lds + PG8_SA(b, h) + aoff + m * 2048 + k * 1024); } while (0)
#define PG8_LDB(dst, b, h) do { _Pragma("unroll") for (int n = 0; n < 2; ++n) _Pragma("unroll") for (int k = 0; k < 2; ++k) dst[n][k] = *(const PG8_LAS bf16x8*)(lds + PG8_SB(b, h) + boff + n * 2048 + k * 1024); } while (0)
#define PG8_MMA(ai, bj, At, Bt) do { __builtin_amdgcn_s_setprio(1); _Pragma("unroll") for (int m = 0; m < 4; ++m) _Pragma("unroll") for (int n = 0; n < 2; ++n) _Pragma("unroll") for (int k = 0; k < 2; ++k) \
        acc[ai][bj][m][n] = __builtin_amdgcn_mfma_f32_16x16x32_bf16(Bt[n][k], At[m][k], acc[ai][bj][m][n], 0, 0, 0); __builtin_amdgcn_s_setprio(0); } while (0)
#define PG8_WAIT_V(n) asm volatile("s_waitcnt vmcnt(" #n ")" ::: "memory")
#define PG8_WAIT_L(n) asm volatile("s_waitcnt lgkmcnt(" #n ")" ::: "memory")
#define PG8_BAR __builtin_amdgcn_s_barrier()
#define PG8_SCHED __builtin_amdgcn_sched_barrier(0)
    Unit cur, nxt; int ui = 0;
    if (!S.next(0, cur)) return;
    f32x4 acc[2][2][4][2];
#pragma unroll
    for (int a = 0; a < 2; ++a)
#pragma unroll
        for (int b = 0; b < 2; ++b)
#pragma unroll
            for (int m = 0; m < 4; ++m)
#pragma unroll
                for (int n = 0; n < 2; ++n) acc[a][b][m][n] = (f32x4){0.f, 0.f, 0.f, 0.f};
    bf16x8 At[4][2], B0[2][2], B1[2][2];
    const char* cA = (const char*)g.A + (size_t)cur.pm * tstepA; const char* cB = (const char*)g.Bt + (size_t)cur.pn * tstepB;
    PG8_STAGE(PG8_SB(0, 0), cB, voffB); PG8_STAGE(PG8_SB(0, 1), cB + hstepB, voffB); PG8_STAGE(PG8_SA(0, 0), cA, voffA); PG8_STAGE(PG8_SA(0, 1), cA + hstepA, voffA);
    if (wr == 1) PG8_BAR;
    PG8_WAIT_V(2); PG8_BAR;
    PG8_STAGE(PG8_SB(1, 0), cB + kstep, voffB); PG8_STAGE(PG8_SA(1, 0), cA + kstep, voffA); PG8_STAGE(PG8_SB(1, 1), cB + hstepB + kstep, voffB);
    PG8_WAIT_V(6); PG8_BAR;
    for (;;) {
        const bool has_next = S.next(ui + 1, nxt);
        const char* nA = has_next ? (const char*)g.A + (size_t)nxt.pm * tstepA : cA; const char* nB = has_next ? (const char*)g.Bt + (size_t)nxt.pn * tstepB : cB;
#pragma unroll 1
        for (int t = 0; t < nt; t += 2) {
            if constexpr (Epi::MIDSCALE) { if (t == nt / 2) E.mid(acc, cur); }
            const bool last = (t == nt - 2);
            const char* a1 = cA + (size_t)(t + 1) * kstep;
            const char* a2 = last ? nA : cA + (size_t)(t + 2) * kstep; const char* b2 = last ? nB : cB + (size_t)(t + 2) * kstep;
            const char* a3 = a2 + kstep; const char* b3 = b2 + kstep;
            PG8_LDB(B0, 0, 0); PG8_LDB(B1, 0, 1); PG8_SCHED; PG8_LDA(At, 0, 0); PG8_STAGE(PG8_SA(1, 1), a1 + hstepA, voffA);
            PG8_WAIT_V(8); PG8_WAIT_L(0); PG8_BAR; PG8_MMA(0, 0, At, B0); PG8_MMA(0, 1, At, B1); PG8_BAR; PG8_SCHED;
            PG8_LDA(At, 0, 1); PG8_STAGE(PG8_SB(0, 0), b2, voffB); PG8_STAGE(PG8_SB(0, 1), b2 + hstepB, voffB); PG8_STAGE(PG8_SA(0, 0), a2, voffA);
            PG8_WAIT_V(8); PG8_WAIT_L(0); PG8_BAR; PG8_MMA(1, 0, At, B0); PG8_MMA(1, 1, At, B1); PG8_BAR; PG8_SCHED;
            PG8_LDB(B0, 1, 0); PG8_LDB(B1, 1, 1); PG8_SCHED; PG8_LDA(At, 1, 0); PG8_STAGE(PG8_SA(0, 1), a2 + hstepA, voffA);
            PG8_WAIT_V(8); PG8_WAIT_L(0); PG8_BAR; PG8_MMA(0, 0, At, B0); PG8_MMA(0, 1, At, B1); PG8_BAR; PG8_SCHED;
            PG8_LDA(At, 1, 1); PG8_STAGE(PG8_SB(1, 0), b3, voffB); PG8_STAGE(PG8_SB(1, 1), b3 + hstepB, voffB); PG8_STAGE(PG8_SA(1, 0), a3, voffA);
            PG8_WAIT_V(8); PG8_WAIT_L(0); PG8_BAR; PG8_MMA(1, 0, At, B0); PG8_MMA(1, 1, At, B1); PG8_BAR; PG8_SCHED;
        }
        if (wr == 0) PG8_BAR;
        E(acc, cur, wr, wc, fr, fq);
        if (!has_next) break;
#pragma unroll
        for (int a = 0; a < 2; ++a)
#pragma unroll
            for (int b = 0; b < 2; ++b)
#pragma unroll
                for (int m = 0; m < 4; ++m)
#pragma unroll
                    for (int n = 0; n < 2; ++n) acc[a][b][m][n] = (f32x4){0.f, 0.f, 0.f, 0.f};
        cur = nxt; cA = nA; cB = nB; ++ui;
        if (wr == 1) PG8_BAR;
    }
    PG8_WAIT_V(0);
    PG8_BAR;
#undef PG8_SA
#undef PG8_SB
#undef PG8_STAGE
#undef PG8_LDA
#undef PG8_LDB
#undef PG8_MMA
#undef PG8_WAIT_V
#undef PG8_WAIT_L
#undef PG8_BAR
#undef PG8_SCHED
}
}

typedef unsigned short bf16;
typedef short bf16x8 __attribute__((ext_vector_type(8)));
typedef short s16x4 __attribute__((ext_vector_type(4)));
typedef float f32x16 __attribute__((ext_vector_type(16)));
typedef float f32x4 __attribute__((ext_vector_type(4)));
typedef float f32x2 __attribute__((ext_vector_type(2)));
typedef unsigned u32x4 __attribute__((ext_vector_type(4)));
typedef unsigned u32x2 __attribute__((ext_vector_type(2)));
#define LAS __attribute__((address_space(3)))

constexpr int BATCH = 4, SEQ = 8192, DM = 1024, M = BATCH * SEQ, NH = 8;
constexpr int D_IN = 4768, PITCH = 4864;
constexpr int C_RQ = 0, C_RK = 512, C_RV = 1024, C_MG = 2048, C_RG = 3072, C_CQ = 4096, C_CKV = 4480, C_KR = 4736;
constexpr float EPS = 1e-6f;
constexpr float QSC = 0.10206207261596575f * 1.4426950408889634f;
constexpr float LOG2E = 1.4426950408889634f;
constexpr int NTHREADS = 512, NWAVES = 8;

constexpr size_t MiB = 1u << 20;
constexpr size_t WS_PROJ = 0;
constexpr size_t WS_K = 304 * MiB;
constexpr size_t WS_V = 352 * MiB;
constexpr size_t WS_WIN = 416 * MiB;
constexpr size_t WS_WQ = 426 * MiB;
constexpr size_t WS_WKV = 427 * MiB;
constexpr size_t WS_WO = 428 * MiB;
constexpr size_t WS_CS64 = 432 * MiB;
constexpr size_t WS_CS32 = 440 * MiB;
constexpr size_t WS_MOD = 444 * MiB;
constexpr size_t WS_STAT = 445 * MiB;
constexpr size_t WS_SS = 447 * MiB;
constexpr size_t WS_BAR = 446 * MiB;
constexpr size_t WS_END = 448 * MiB;
constexpr size_t OUT_QO = 0, OUT_KVS = 64 * MiB;

constexpr int LDS_BYTES = 135168;
constexpr int LDS_CTL_OFF = 133120;

struct Params { const float* in[20]; float* out; unsigned char* ws; };

__device__ __forceinline__ unsigned cvtpk(float lo, float hi) { return pg8::cvt_pk_bf16(lo, hi); }
__device__ __forceinline__ float bf_lo(unsigned w) { return __uint_as_float(w << 16); }
__device__ __forceinline__ float bf_hi(unsigned w) { return __uint_as_float(w & 0xffff0000u); }
__device__ __forceinline__ float wave_sum(float v) {
#pragma unroll
    for (int o = 1; o < 64; o <<= 1) v += __shfl_xor(v, o);
    return v;
}
__device__ __forceinline__ float silu_f(float v) { return v * __builtin_amdgcn_rcpf(1.f + __builtin_amdgcn_exp2f(-v * LOG2E)); }
__device__ __forceinline__ float sumsq8(u32x4 a) {
    float s = 0.f;
#pragma unroll
    for (int i = 0; i < 4; ++i) { const float x = bf_lo(a[i]), y = bf_hi(a[i]); s += x * x + y * y; }
    return s;
}

__device__ __forceinline__ int fresh_tid() { int t = threadIdx.x; asm volatile("" : "+v"(t)); return t; }
#define EPI_LANES() const int t_ = fresh_tid(), l_ = t_ & 63, wi_ = t_ >> 6, wr = wi_ >> 2, wc = wi_ & 3, fr = l_ & 15, fq = l_ >> 4


#define RLX_AGENT __ATOMIC_RELAXED, __HIP_MEMORY_SCOPE_AGENT
#define XB_TMO      128
#define XB_XCNT(j)  (256  + 64 * (j))
#define XB_XSUB(j)  (1280 + 64 * (j))
#define XB_XGEN(j)  (2304 + 64 * (j))
#define XB_TOP      3328
#define XB_TOPGEN   3392
#define XCD_BAR_WORDS 3456
#define XB_SPIN_CAP (1u << 18)

__device__ __forceinline__ unsigned xb_ld(unsigned* p)              { return __hip_atomic_load(p, __ATOMIC_RELAXED, __HIP_MEMORY_SCOPE_AGENT); }
__device__ __forceinline__ unsigned xb_add(unsigned* p, unsigned v) { return __hip_atomic_fetch_add(p, v, __ATOMIC_RELAXED, __HIP_MEMORY_SCOPE_AGENT); }
__device__ __forceinline__ unsigned xb_xcc_id() { return (unsigned)__builtin_amdgcn_s_getreg((3 << 11) | 20) & 0xFu; }
#define XB_SPIN(cond, bar) do { unsigned _sp = 0; while (cond) { __builtin_amdgcn_s_sleep(1); \
    if ((++_sp & 255u) == 0u) { if (xb_ld(&(bar)[XB_TMO])) break; if (_sp > XB_SPIN_CAP) { atomicAdd(&(bar)[XB_TMO], 1u); break; } } } } while (0)

struct XcdBarrier {
    unsigned* bar; unsigned x;
    volatile LAS unsigned* st;
};

__device__ __forceinline__ XcdBarrier xcd_barrier_post(unsigned* bar, volatile LAS unsigned* st) {
    XcdBarrier b; b.bar = bar; b.x = xb_xcc_id(); b.st = st;
    if (threadIdx.x == 0) (void)xb_add(&bar[XB_XCNT(b.x)], 1u);
    return b;
}
__device__ __forceinline__ void xcd_barrier_complete(unsigned* bar, unsigned x, unsigned& nloc, unsigned& nx) {
    const unsigned G = gridDim.x * gridDim.y * gridDim.z;
    unsigned sum, cnt, mine, sp = 0u;
    for (;;) {
        sum = 0u; cnt = 0u; mine = 0u;
#pragma unroll
        for (unsigned j = 0; j < 16; ++j) { const unsigned c = xb_ld(&bar[XB_XCNT(j)]); sum += c; cnt += (c > 0u) ? 1u : 0u; mine = (j == x) ? c : mine; }
        if (sum == G) break;
        __builtin_amdgcn_s_sleep(1);
        if ((++sp & 255u) == 0u) { if (xb_ld(&bar[XB_TMO])) break; if (sp > XB_SPIN_CAP) { atomicAdd(&bar[XB_TMO], 1u); break; } }
    }
    nloc = mine > 0u ? mine : 1u; nx = cnt > 0u ? cnt : 1u;
}

__device__ __forceinline__ void xcd_barrier(const XcdBarrier& b) {
    asm volatile("s_waitcnt vmcnt(0)" ::: "memory");
    __syncthreads();
    if (threadIdx.x == 0) {
        unsigned* bar = b.bar;
        __builtin_amdgcn_s_waitcnt(0);
        unsigned nloc = b.st[0], nx = b.st[1];
        if (nloc == 0u) { xcd_barrier_complete(bar, b.x, nloc, nx); b.st[0] = nloc; b.st[1] = nx; }
        const unsigned old = xb_add(&bar[XB_XSUB(b.x)], 1u);
        const unsigned gen = old / nloc;
        if (old + 1u == (gen + 1u) * nloc) {
            __builtin_amdgcn_fence(__ATOMIC_RELEASE, "agent");
            asm volatile("s_waitcnt vmcnt(0)" ::: "memory");
            const unsigned og = xb_add(&bar[XB_TOP], 1u);
            const unsigned tg = og / nx;
            if (og + 1u == (tg + 1u) * nx) xb_add(&bar[XB_TOPGEN], 1u);
            else XB_SPIN(xb_ld(&bar[XB_TOPGEN]) == tg, bar);
            __builtin_amdgcn_fence(__ATOMIC_ACQUIRE, "agent");
            xb_add(&bar[XB_XGEN(b.x)], 1u);
            asm volatile("s_waitcnt vmcnt(0)" ::: "memory");
        } else {
            XB_SPIN(xb_ld(&bar[XB_XGEN(b.x)]) == gen, bar);
            __builtin_amdgcn_fence(__ATOMIC_ACQUIRE, "agent");
            asm volatile("s_waitcnt vmcnt(0)" ::: "memory");
        }
    }
    __syncthreads();
}


__device__ __forceinline__ int win_colmap(int n) {
    if (n < 1024) { const int base = n & ~63, j = n & 63; return base + (j >> 1) + 32 * (j & 1); }
    if (n < 2048) return n;
    if (n < 3072) return 3744 + (n - 2048);
    if (n < 4096) return 2048 + (n - 3072);
    if (n < 4480) return 3072 + (n - 4096);
    if (n < 4736) return 3456 + (n - 4480);
    if (n < 4768) return 3712 + (n - 4736);
    return -1;
}
__device__ __forceinline__ int nope_map(int n, int per_head) {
    const int t = n >> 8, c = n & 255, bj = c >> 7, wc = (c >> 5) & 3, j = c & 31;
    return (4 * t + wc) * per_head + 32 * bj + j;
}
__device__ __forceinline__ int wq_colmap(int n) {
    if (n < 512) return nope_map(n, 96);
    const int c = n - 512, head = c >> 5, j = c & 31; return head * 96 + 64 + (j >> 1) + 16 * (j & 1);
}
__device__ __forceinline__ int wkv_colmap(int n) {
    if (n < 512) return nope_map(n, 192);
    const int c = n - 512, head = c >> 7, dim = c & 127; return head * 192 + 64 + dim;
}

struct EpiIn {
    static constexpr bool PERM = true, MIDSCALE = false;
    bf16* P; const float* cs64;
    __device__ __forceinline__ void operator()(const pg8::f32x4 (&acc)[2][2][4][2], const pg8::Unit& u, int, int, int, int) const {
        EPI_LANES();
        const int row0 = u.pm * 256 + wr * 64 + fr, colt = u.pn * 256, cl = wc * 32 + 8 * fq;
        const int mode = u.pn < 4 ? 1 : ((u.pn >= 8 && u.pn < 16) ? 2 : 0);
        const float rs = u.pn < 2 ? 1.f : 0.125f;
        const int p0 = (wc & 1) * 16 + 4 * fq;
        f32x4 n0 = {1.f, 0.f, 1.f, 0.f}, n1 = {1.f, 0.f, 1.f, 0.f};
        if (mode == 1) { const f32x4* t = (const f32x4*)(cs64 + ((size_t)row0 * 32 + p0) * 2); n0 = t[0]; n1 = t[1]; }
#pragma unroll
        for (int ai = 0; ai < 2; ++ai)
#pragma unroll
            for (int m = 0; m < 4; ++m) {
                const int row = row0 + ai * 128 + m * 16;
                bf16* rowp = P + (size_t)row * PITCH + colt + cl;
                const f32x4 c0 = n0, c1 = n1;
                if (mode == 1 && (ai * 4 + m) < 7) { const int rown = row0 + ((ai * 4 + m + 1) >> 2) * 128 + ((ai * 4 + m + 1) & 3) * 16;
                    const f32x4* t = (const f32x4*)(cs64 + ((size_t)rown * 32 + p0) * 2); n0 = t[0]; n1 = t[1]; }
#pragma unroll
                for (int bj = 0; bj < 2; ++bj) {
                    f32x4 v0 = acc[ai][bj][m][0], v1 = acc[ai][bj][m][1];
                    if (mode == 1) {
                        f32x4 o0, o1;
                        o0[0] = (v0[0] * c0[0] - v0[1] * c0[1]) * rs; o0[1] = (v0[1] * c0[0] + v0[0] * c0[1]) * rs;
                        o0[2] = (v0[2] * c0[2] - v0[3] * c0[3]) * rs; o0[3] = (v0[3] * c0[2] + v0[2] * c0[3]) * rs;
                        o1[0] = (v1[0] * c1[0] - v1[1] * c1[1]) * rs; o1[1] = (v1[1] * c1[0] + v1[0] * c1[1]) * rs;
                        o1[2] = (v1[2] * c1[2] - v1[3] * c1[3]) * rs; o1[3] = (v1[3] * c1[2] + v1[2] * c1[3]) * rs;
                        v0 = o0; v1 = o1;
                    } else if (mode == 2) {
#pragma unroll
                        for (int i = 0; i < 4; ++i) { v0[i] = silu_f(v0[i]); v1[i] = silu_f(v1[i]); }
                    }
                    u32x4 w; w.x = cvtpk(v0[0], v0[1]); w.y = cvtpk(v0[2], v0[3]); w.z = cvtpk(v1[0], v1[1]); w.w = cvtpk(v1[2], v1[3]);
                    *(u32x4*)(rowp + bj * 128) = w;
                }
                asm volatile("" ::: "memory");
            }
    }
};

template <int MODE> struct EpiUp {
    static constexpr bool IS_Q = MODE != 2, MIDSCALE = false;
    static constexpr bool PERM = true;
    bf16* O;
    bf16* Vo;
    const f32x2* stat;
    const float* wn;
    const float* wr_;
    const float* cs32;
    __device__ __forceinline__ void operator()(const pg8::f32x4 (&acc)[2][2][4][2], const pg8::Unit& u, int, int, int, int) const {
        EPI_LANES();
        const int row0 = u.pm * 256 + wr * 64 + fr;
        const int b = row0 / SEQ;
        constexpr int OP = IS_Q ? 128 : 96;
        float ms8[8];
#pragma unroll
        for (int i = 0; i < 8; ++i) { const f32x2 st = stat[row0 + (i >> 2) * 128 + (i & 3) * 16]; ms8[i] = IS_Q ? st.x : st.y; }
        if (MODE == 0 || ((MODE == 2 || MODE == 3) && u.pn < 2)) {
            const int head = 4 * u.pn + wc;
            const f32x4 w00 = *(const f32x4*)(wn + 8 * fq), w01 = *(const f32x4*)(wn + 8 * fq + 4), w10 = *(const f32x4*)(wn + 32 + 8 * fq), w11 = *(const f32x4*)(wn + 36 + 8 * fq);
#pragma unroll
            for (int ai = 0; ai < 2; ++ai)
#pragma unroll
                for (int m = 0; m < 4; ++m) {
                    const int row = row0 + ai * 128 + m * 16;
                    const f32x4 a0 = acc[ai][0][m][0], a1 = acc[ai][0][m][1], b0 = acc[ai][1][m][0], b1 = acc[ai][1][m][1];
                    float ss = 0.f;
#pragma unroll
                    for (int i = 0; i < 4; ++i) ss += a0[i] * a0[i] + a1[i] * a1[i] + b0[i] * b0[i] + b1[i] * b1[i];
                    ss += __shfl_xor(ss, 16); ss += __shfl_xor(ss, 32);
                    const float ms = ms8[ai * 4 + m];
                    const float sc = __builtin_amdgcn_rsqf(ss * (1.f / 64.f) + EPS * (ms + EPS)) * (IS_Q ? QSC : 1.f);
                    bf16* op = O + ((size_t)(b * NH + head) * SEQ + (row - b * SEQ)) * OP;
                    const f32x4 x0 = a0 * sc * w00, x1 = a1 * sc * w01, y0 = b0 * sc * w10, y1 = b1 * sc * w11;
                    u32x4 w; w.x = cvtpk(x0[0], x0[1]); w.y = cvtpk(x0[2], x0[3]); w.z = cvtpk(x1[0], x1[1]); w.w = cvtpk(x1[2], x1[3]);
                    *(u32x4*)(op + 8 * fq) = w;
                    w.x = cvtpk(y0[0], y0[1]); w.y = cvtpk(y0[2], y0[3]); w.z = cvtpk(y1[0], y1[1]); w.w = cvtpk(y1[2], y1[3]);
                    *(u32x4*)(op + 32 + 8 * fq) = w;
                }
        } else if (MODE == 1 || MODE == 3) {
            const f32x4 wl = *(const f32x4*)(wr_ + 4 * fq), wh = *(const f32x4*)(wr_ + 16 + 4 * fq);
            f32x4 n0, n1; { const f32x4* t = (const f32x4*)(cs32 + ((size_t)row0 * 16 + 4 * fq) * 2); n0 = t[0]; n1 = t[1]; }
#pragma unroll
            for (int ai = 0; ai < 2; ++ai)
#pragma unroll
                for (int m = 0; m < 4; ++m) {
                    const int row = row0 + ai * 128 + m * 16;
                    const float epsq = EPS * (ms8[ai * 4 + m] + EPS);
                    const f32x4 c0 = n0, c1 = n1;
                    if ((ai * 4 + m) < 7) { const int rown = row0 + ((ai * 4 + m + 1) >> 2) * 128 + ((ai * 4 + m + 1) & 3) * 16;
                        const f32x4* t = (const f32x4*)(cs32 + ((size_t)rown * 16 + 4 * fq) * 2); n0 = t[0]; n1 = t[1]; }
#pragma unroll
                    for (int bj = 0; bj < 2; ++bj) {
                        const f32x4 v0 = acc[ai][bj][m][0], v1 = acc[ai][bj][m][1];
                        float ss = 0.f;
#pragma unroll
                        for (int i = 0; i < 4; ++i) ss += v0[i] * v0[i] + v1[i] * v1[i];
                        ss += __shfl_xor(ss, 16); ss += __shfl_xor(ss, 32);
                        const float sc = __builtin_amdgcn_rsqf(ss * (1.f / 32.f) + epsq) * QSC;
                        const float x1a = v0[0] * sc * wl[0], x2a = v0[1] * sc * wh[0], x1b = v0[2] * sc * wl[1], x2b = v0[3] * sc * wh[1];
                        const float x1c = v1[0] * sc * wl[2], x2c = v1[1] * sc * wh[2], x1d = v1[2] * sc * wl[3], x2d = v1[3] * sc * wh[3];
                        u32x4 w;
                        w.x = cvtpk(x1a * c0[0] - x2a * c0[1], x2a * c0[0] + x1a * c0[1]);
                        w.y = cvtpk(x1b * c0[2] - x2b * c0[3], x2b * c0[2] + x1b * c0[3]);
                        w.z = cvtpk(x1c * c1[0] - x2c * c1[1], x2c * c1[0] + x1c * c1[1]);
                        w.w = cvtpk(x1d * c1[2] - x2d * c1[3], x2d * c1[2] + x1d * c1[3]);
                        const int head = 4 * bj + wc;
                        bf16* op = O + ((size_t)(b * NH + head) * SEQ + (row - b * SEQ)) * OP;
                        *(u32x4*)(op + 64 + 8 * fq) = w;
                    }
                    asm volatile("" ::: "memory");
                }
        } else {
#pragma unroll
            for (int ai = 0; ai < 2; ++ai)
#pragma unroll
                for (int m = 0; m < 4; ++m) {
                    const int row = row0 + ai * 128 + m * 16;
                    const float sc = __builtin_amdgcn_rsqf(ms8[ai * 4 + m] + EPS);
#pragma unroll
                    for (int bj = 0; bj < 2; ++bj) {
                        const f32x4 v0 = acc[ai][bj][m][0] * sc, v1 = acc[ai][bj][m][1] * sc;
                        const int head = 2 * (u.pn - 2) + bj;
                        bf16* op = Vo + ((size_t)(b * NH + head) * SEQ + (row - b * SEQ)) * 128 + 32 * wc + 8 * fq;
                        u32x4 w; w.x = cvtpk(v0[0], v0[1]); w.y = cvtpk(v0[2], v0[3]); w.z = cvtpk(v1[0], v1[1]); w.w = cvtpk(v1[2], v1[3]);
                        *(u32x4*)op = w;
                    }
                }
        }
    }
};

struct EpiOut {
    static constexpr bool PERM = false, MIDSCALE = true;
    const float* x; float* out; const float* mod; const float* ss;
    __device__ __forceinline__ void mid(pg8::f32x4 (&acc)[2][2][4][2], const pg8::Unit& u) const {
        EPI_LANES(); (void)wc; (void)fq;
        const int row0 = u.pm * 256 + wr * 64 + fr;
#pragma unroll
        for (int ai = 0; ai < 2; ++ai)
#pragma unroll
            for (int m = 0; m < 4; ++m) {
                const f32x4* sp = (const f32x4*)(ss + (size_t)(row0 + ai * 128 + m * 16) * 8);
                const f32x4 s0 = sp[0], s1 = sp[1];
                const float rstd = __builtin_amdgcn_rsqf(((s0[0] + s0[1]) + (s0[2] + s0[3]) + (s1[0] + s1[1]) + (s1[2] + s1[3])) * (1.f / 1024.f) + EPS);
#pragma unroll
                for (int bj = 0; bj < 2; ++bj)
#pragma unroll
                    for (int n = 0; n < 2; ++n) acc[ai][bj][m][n] *= rstd;
            }
    }
    __device__ __forceinline__ void operator()(const pg8::f32x4 (&acc)[2][2][4][2], const pg8::Unit& u, int, int, int, int) const {
        EPI_LANES();
        const int row0 = u.pm * 256 + wr * 64 + fr, b = row0 / SEQ;
        const int col0 = u.pn * 256 + wc * 32 + 4 * fq;
        f32x4 gv[2][2];
#pragma unroll
        for (int bj = 0; bj < 2; ++bj)
#pragma unroll
            for (int n = 0; n < 2; ++n) gv[bj][n] = *(const f32x4*)(mod + b * 3072 + 2048 + col0 + bj * 128 + n * 16);
#pragma unroll
        for (int ai = 0; ai < 2; ++ai)
#pragma unroll
            for (int m = 0; m < 4; ++m) {
                const size_t off = (size_t)(row0 + ai * 128 + m * 16) * DM + col0;
#pragma unroll
                for (int bj = 0; bj < 2; ++bj)
#pragma unroll
                    for (int n = 0; n < 2; ++n) {
                        const f32x4 xv = *(const f32x4*)(x + off + bj * 128 + n * 16);
                        *(f32x4*)(out + off + bj * 128 + n * 16) = xv + gv[bj][n] * acc[ai][bj][m][n];
                    }
            }
    }
};

#define KSWZ(row, colB) ((row) * 256 + ((colB) ^ (((row) & 7) << 4)))
#define SBAR() __builtin_amdgcn_sched_barrier(0)
constexpr int KVBLK = 64;
constexpr size_t SHM_V = KVBLK * 128 * 2, SHM_K = KVBLK * 128 * 2;
constexpr float ATT_SCALE = 0.10206207261596575f;
constexpr float THR = 8.f;
__device__ __forceinline__ f32x16 zero16() { float z; asm volatile("v_mov_b32 %0, 0" : "=v"(z)); f32x16 r;
#pragma unroll
    for (int i = 0; i < 16; ++i) r[i] = z;
    return r; }
__device__ __forceinline__ int crow(int r, int hi) { return (r & 3) + 8 * (r >> 2) + 4 * hi; }
__device__ __forceinline__ int v_st(int k, int c) { const int kk = (k & ~0xC) | ((k & 4) << 1) | ((k & 8) >> 1); return ((kk >> 3) * 4 + (c >> 5)) * 512 + ((kk & 7) * 32 + (c & 31)) * 2; }
__device__ __forceinline__ int v_st_raw(int k, int c) { return ((k >> 3) * 4 + (c >> 5)) * 512 + ((k & 7) * 32 + (c & 31)) * 2; }
__device__ __forceinline__ int v_rd_base(int lane) { return ((lane & 3) << 3) | (((lane >> 2) & 3) << 6) | (((lane >> 4) & 1) << 5) | (((lane >> 5) & 1) << 8); }
constexpr int v_rd_off(int d0, int ks, int half) { return d0 * 512 + ks * 4096 + half * 2048; }
template <int OFF> __device__ __forceinline__ s16x4 tr_read(int vb) {
    s16x4 r; asm volatile("ds_read_b64_tr_b16 %0, %1 offset:%2" : "=&v"(r) : "v"(vb), "i"(OFF) : "memory"); return r;
}
#define PKF(L, H) (bf16x8){L[0], L[1], L[2], L[3], H[0], H[1], H[2], H[3]}
template <int D0> __device__ __forceinline__ void pv_one(f32x16& od, int vb, bf16x8 pa0, bf16x8 pa1, bf16x8 pa2, bf16x8 pa3) {
    const s16x4 l0 = tr_read<v_rd_off(D0, 0, 0)>(vb), h0 = tr_read<v_rd_off(D0, 0, 1)>(vb), l1 = tr_read<v_rd_off(D0, 1, 0)>(vb), h1 = tr_read<v_rd_off(D0, 1, 1)>(vb);
    const s16x4 l2 = tr_read<v_rd_off(D0, 2, 0)>(vb), h2 = tr_read<v_rd_off(D0, 2, 1)>(vb), l3 = tr_read<v_rd_off(D0, 3, 0)>(vb), h3 = tr_read<v_rd_off(D0, 3, 1)>(vb);
    asm volatile("s_waitcnt lgkmcnt(0)" ::: "memory"); SBAR();
    od = __builtin_amdgcn_mfma_f32_32x32x16_bf16(pa0, PKF(l0, h0), od, 0, 0, 0);
    od = __builtin_amdgcn_mfma_f32_32x32x16_bf16(pa1, PKF(l1, h1), od, 0, 0, 0);
    od = __builtin_amdgcn_mfma_f32_32x32x16_bf16(pa2, PKF(l2, h2), od, 0, 0, 0);
    od = __builtin_amdgcn_mfma_f32_32x32x16_bf16(pa3, PKF(l3, h3), od, 0, 0, 0);
}
__device__ __forceinline__ void pv_d0(f32x16* o, int vb, bf16x8 pa0, bf16x8 pa1, bf16x8 pa2, bf16x8 pa3) {
    pv_one<0>(o[0], vb, pa0, pa1, pa2, pa3); pv_one<1>(o[1], vb, pa0, pa1, pa2, pa3); pv_one<2>(o[2], vb, pa0, pa1, pa2, pa3); pv_one<3>(o[3], vb, pa0, pa1, pa2, pa3);
}
#define PK4(P, BASE, OUT) do { u32x4 w = {cvtpk(P[BASE + 0], P[BASE + 1]), cvtpk(P[BASE + 2], P[BASE + 3]), cvtpk(P[BASE + 4], P[BASE + 5]), cvtpk(P[BASE + 6], P[BASE + 7])}; \
    OUT = *reinterpret_cast<bf16x8*>(&w); } while (0)

__device__ __forceinline__ void partialSM(f32x16& p0, f32x16& p1) {
    (void)p1;
#pragma unroll
    for (int r = 0; r < 16; ++r) p0[r] = __builtin_amdgcn_exp2f(p0[r]);
}
__device__ __forceinline__ void finishSM(f32x16& p0, f32x16& p1, float& l_reg, bf16x8& pa0, bf16x8& pa1, bf16x8& pa2, bf16x8& pa3) {
#pragma unroll
    for (int r = 0; r < 16; ++r) p1[r] = __builtin_amdgcn_exp2f(p1[r]);
    float ps = 0;
#pragma unroll
    for (int r = 0; r < 16; ++r) ps += p0[r];
#pragma unroll
    for (int r = 0; r < 16; ++r) ps += p1[r];
    { auto rr = __builtin_amdgcn_permlane32_swap(__float_as_uint(ps), __float_as_uint(ps), false, false);
      ps = __uint_as_float(rr[0]) + __uint_as_float(rr[1]); }
    l_reg += ps;
    PK4(p0, 0, pa0); PK4(p0, 8, pa1); PK4(p1, 0, pa2); PK4(p1, 8, pa3);
}
__device__ __forceinline__ void qkt6(f32x16& p0, f32x16& p1, const char* Ks, const bf16x8* qr, int r32, int hi) {
    asm volatile("" : "+v"(r32));
    p0 = f32x16{}; p1 = f32x16{};
#pragma unroll
    for (int d0 = 0; d0 < 6; ++d0) { const int cb = (d0 * 16 + hi * 8) * 2;
        const bf16x8 b0 = *reinterpret_cast<const bf16x8*>(Ks + KSWZ(r32, cb));
        const bf16x8 b1 = *reinterpret_cast<const bf16x8*>(Ks + KSWZ(32 + r32, cb));
        p0 = __builtin_amdgcn_mfma_f32_32x32x16_bf16(b0, qr[d0], p0, 0, 0, 0);
        p1 = __builtin_amdgcn_mfma_f32_32x32x16_bf16(b1, qr[d0], p1, 0, 0, 0);
        asm volatile("" :: "v"(b0), "v"(b1), "v"(qr[d0])); }
}

__device__ __forceinline__ void attn_unit(bf16* __restrict__ QOb, const bf16* __restrict__ Kh, const bf16* __restrict__ Vh, int seq, char* lds,
                                          bf16* __restrict__ mgb  , float* __restrict__ ssb  , const float* __restrict__ wnh  ) {
    constexpr int LDQ = 128, LDKK = 96, LDV = 128;
    int tid_ = threadIdx.x; asm volatile("" : "+v"(tid_));
    const int tid = tid_, wid = tid >> 6, lane = tid & 63, r32 = lane & 31, hi = lane >> 5;
    char* V_lds = lds; char* K_lds = lds + 3 * SHM_V;
    float* ws = (float*)(lds + 3 * SHM_V + 3 * SHM_K) + wid * 64; float* li_l = ws;
    float l_reg = 0; f32x16 o[4] = {}; bf16x8 qr[6];
    const bf16* Qw = QOb + (long)(wid * 32 + r32) * LDQ + hi * 8;
#pragma unroll
    for (int d0 = 0; d0 < 6; ++d0) qr[d0] = *reinterpret_cast<const bf16x8*>(Qw + d0 * 16);
    const int sr = tid >> 4, sc = (tid & 15) * 8, vst0 = v_st_raw(sr, sc), vst1 = v_st_raw(32 + sr, sc);
    const int sck = sc < 96 ? sc : 88;
    const int vb0 = (int)(uintptr_t)V_lds + v_rd_base(lane);
    struct { bf16x8 vs0, vs1, ks0, ks1; } sr_[2];
    const char* Vhb = (const char*)Vh; const char* Khb = (const char*)Kh;
    const unsigned voV = (unsigned)(sr * LDV + sc) * 2u, voK = (unsigned)(sr * LDKK + sck) * 2u;
#define SLOAD(i, k0) do { const char* vt_ = Vhb + (size_t)(k0) * (LDV * 2); const char* kt_ = Khb + (size_t)(k0) * (LDKK * 2); \
    sr_[i].vs0 = *(const bf16x8*)(vt_ + voV); sr_[i].vs1 = *(const bf16x8*)(vt_ + 32 * LDV * 2 + voV); \
    sr_[i].ks0 = *(const bf16x8*)(kt_ + voK); sr_[i].ks1 = *(const bf16x8*)(kt_ + 32 * LDKK * 2 + voK); } while (0)
#define SWRITE(b, i) do {   *(bf16x8*)(V_lds + (b) * SHM_V + vst0) = sr_[i].vs0; *(bf16x8*)(V_lds + (b) * SHM_V + vst1) = sr_[i].vs1; const int kc = sc * 2; \
    *(bf16x8*)(K_lds + (b) * SHM_K + KSWZ(sr, kc)) = sr_[i].ks0; *(bf16x8*)(K_lds + (b) * SHM_K + KSWZ(32 + sr, kc)) = sr_[i].ks1; } while (0)
#define SWAIT() asm volatile("s_waitcnt vmcnt(4)" ::: "memory")
    f32x16 pA0, pA1, pB0, pB1; bf16x8 pa0, pa1, pa2, pa3; const int NT = seq / KVBLK;
    constexpr int SE = 0, SO = 1;
#define ASTEP(PC0, PC1, PP0, PP1, KS, VS, WS, RW, RL, LT, LCOND) do { \
        SBAR(); qkt6(PC0, PC1, K_lds + (KS) * SHM_K, qr, r32, hi); \
        finishSM(PP0, PP1, l_reg, pa0, pa1, pa2, pa3); SBAR(); \
        if (LCOND) SLOAD(RL, (LT) * KVBLK); SBAR(); \
        pv_d0(o, vb0 + (VS) * (int)SHM_V, pa0, pa1, pa2, pa3); partialSM(PC0, PC1); \
        SWRITE(WS, RW); __syncthreads(); } while (0)
    SLOAD(0, 0); SLOAD(1, KVBLK);
    SWRITE(0, 0); __syncthreads();
    SLOAD(0, 2 * KVBLK);
    qkt6(pA0, pA1, K_lds, qr, r32, hi); partialSM(pA0, pA1);
    SWRITE(1, 1); __syncthreads();
    for (int j = 1; j + 5 < NT; j += 6) {
        ASTEP(pB0, pB1, pA0, pA1, 1, 0, 2, 0, 1, j + 2, true);
        ASTEP(pA0, pA1, pB0, pB1, 2, 1, 0, 1, 0, j + 3, true);
        ASTEP(pB0, pB1, pA0, pA1, 0, 2, 1, 0, 1, j + 4, true);
        ASTEP(pA0, pA1, pB0, pB1, 1, 0, 2, 1, 0, j + 5, true);
        ASTEP(pB0, pB1, pA0, pA1, 2, 1, 0, 0, 1, j + 6, true);
        ASTEP(pA0, pA1, pB0, pB1, 0, 2, 1, 1, 0, j + 7, j + 7 < NT);
    }
    SBAR(); qkt6(pB0, pB1, K_lds + 1 * SHM_K, qr, r32, hi);
    finishSM(pA0, pA1, l_reg, pa0, pa1, pa2, pa3); SBAR();
    pv_d0(o, vb0 + 0 * (int)SHM_V, pa0, pa1, pa2, pa3); partialSM(pB0, pB1);
    finishSM(pB0, pB1, l_reg, pa0, pa1, pa2, pa3); SBAR();
    pv_d0(o, vb0 + 1 * (int)SHM_V, pa0, pa1, pa2, pa3);
    __syncthreads();
#undef ASTEP
    { const int t2_ = fresh_tid(), wid = t2_ >> 6, lane = t2_ & 63, r32 = lane & 31, hi = lane >> 5;
      float* li_l = (float*)(lds + 3 * SHM_V + 3 * SHM_K) + wid * 64;
      char* stg = lds + wid * 8192;
      if (hi == 0) li_l[r32] = l_reg; asm volatile("s_waitcnt lgkmcnt(0)" ::: "memory");
      float wv[4];
#pragma unroll
      for (int d0 = 0; d0 < 4; ++d0) wv[d0] = wnh[d0 * 32 + r32];
#pragma unroll
      for (int r = 0; r < 16; ++r) { const int orow = crow(r, hi); const float rl = __builtin_amdgcn_rcpf(li_l[orow]);
          const float a0 = o[0][r] * rl, a1 = o[1][r] * rl, a2 = o[2][r] * rl, a3 = o[3][r] * rl;
          float sq = (a0 * a0 + a1 * a1) + (a2 * a2 + a3 * a3);
#pragma unroll
          for (int ofs = 1; ofs < 32; ofs <<= 1) sq += __shfl_xor(sq, ofs);
          if (r32 == 0) ssb[(size_t)(wid * 32 + orow) * 8] = sq;
          bf16* sp = (bf16*)(stg + orow * 256) + r32;
          sp[0] = (bf16)(cvtpk(a0 * wv[0], 0.f) & 0xffffu); sp[32] = (bf16)(cvtpk(a1 * wv[1], 0.f) & 0xffffu);
          sp[64] = (bf16)(cvtpk(a2 * wv[2], 0.f) & 0xffffu); sp[96] = (bf16)(cvtpk(a3 * wv[3], 0.f) & 0xffffu); }
      const char* gbase = (const char*)(mgb + (size_t)(wid * 32) * PITCH);
      const unsigned goff = (unsigned)((lane >> 4) * PITCH + (lane & 15) * 8) * 2u;
      u32x4 gv[8];
#pragma unroll
      for (int k = 0; k < 8; ++k) gv[k] = *(const u32x4*)(gbase + (size_t)k * (4 * PITCH * 2) + goff);
#pragma unroll
      for (int k = 0; k < 8; ++k) {
          const u32x4 nv = *(const u32x4*)(stg + (4 * k + (lane >> 4)) * 256 + (lane & 15) * 16);
          u32x4 ov;
#pragma unroll
          for (int q = 0; q < 4; ++q) ov[q] = cvtpk(bf_lo(nv[q]) * bf_lo(gv[k][q]), bf_hi(nv[q]) * bf_hi(gv[k][q]));
          *(u32x4*)((char*)gbase + (size_t)k * (4 * PITCH * 2) + goff) = ov;
      } }
#undef SLOAD
#undef SWRITE
#undef SWAIT
}

__device__ __forceinline__ const char* uptr(const char* p) { const unsigned long long a = (unsigned long long)p;
    const unsigned lo = __builtin_amdgcn_readfirstlane((unsigned)a), hi = __builtin_amdgcn_readfirstlane((unsigned)(a >> 32));
    return (const char*)(((unsigned long long)hi << 32) | lo); }

__device__ __forceinline__ void ret_state_phase(const bf16* __restrict__ proj, bf16* __restrict__ kvs, const float* __restrict__ dl_f, const float* __restrict__ dl_b, int bid, int G, char* lds) {
    const int tid = fresh_tid(), wid = tid >> 6, lane = tid & 63, r32 = lane & 31, hi = lane >> 5;
    char* KX = lds;
    char* VT = lds + 32768;
    const unsigned koff = (unsigned)((tid >> 3) * PITCH + (tid & 7) * 8) * 2u, voff = (unsigned)((tid >> 4) * PITCH + (tid & 15) * 8) * 2u;
    const int rb = wid & 3, cg2 = wid >> 2;
    const int kb = (int)(uintptr_t)KX + v_rd_base(lane) + rb * 512;
    const int vb = (int)(uintptr_t)VT + v_rd_base(lane) + cg2 * 1024;
    u32x4 kreg[2], vreg[4];
#define RS_LOAD(U) do { const int bh_ = (U) >> 6, c_ = (U) & 63, b_ = bh_ >> 3, h_ = bh_ & 7; const size_t row0_ = (size_t)b_ * SEQ + (size_t)c_ * 128; \
        const char* kbase_ = (const char*)(proj + row0_ * PITCH + C_RK + h_ * 64); const char* vbase_ = (const char*)(proj + row0_ * PITCH + C_RV + h_ * 128); \
        _Pragma("unroll") for (int i = 0; i < 2; ++i) kreg[i] = *(const u32x4*)(uptr(kbase_ + (size_t)i * (64 * PITCH * 2)) + koff); \
        _Pragma("unroll") for (int i = 0; i < 4; ++i) vreg[i] = *(const u32x4*)(uptr(vbase_ + (size_t)i * (32 * PITCH * 2)) + voff); } while (0)
    int u = bid;
    if (u < BATCH * NH * 64) RS_LOAD(u);
    for (; u < BATCH * NH * 64; u += G) {
        const int bh = u >> 6, c = u & 63, h = bh & 7;
        const float lgf2 = -log1pf(expf(-dl_f[h])) * LOG2E, lgb2 = -log1pf(expf(-dl_b[h])) * LOG2E;
#pragma unroll
        for (int i = 0; i < 2; ++i) {
            const int key = (tid >> 3) + 64 * i, ch = tid & 7;
            const float df = __builtin_amdgcn_exp2f(lgf2 * (float)(127 - key)), db = __builtin_amdgcn_exp2f(lgb2 * (float)key);
            u32x4 wf, wb;
#pragma unroll
            for (int q = 0; q < 4; ++q) { const float x = bf_lo(kreg[i][q]), y = bf_hi(kreg[i][q]); wf[q] = cvtpk(x * df, y * df); wb[q] = cvtpk(x * db, y * db); }
            char* t = KX + (key >> 6) * 16384;
            *(u32x4*)(t + v_st(key & 63, ch * 8)) = wf;
            *(u32x4*)(t + v_st(key & 63, 64 + ch * 8)) = wb;
        }
#pragma unroll
        for (int i = 0; i < 4; ++i) {
            const int key = (tid >> 4) + 32 * i, ch = tid & 15;
            *(u32x4*)(VT + (key >> 6) * 16384 + v_st(key & 63, ch * 8)) = vreg[i];
        }
        __syncthreads();
        if (u + G < BATCH * NH * 64) RS_LOAD(u + G);
        f32x16 acc0 = {}, acc1 = {};
#define RS_STEP(T, KS) do { \
        const s16x4 al = tr_read<(T) * 16384 + (KS) * 4096>(kb), ah = tr_read<(T) * 16384 + (KS) * 4096 + 2048>(kb); \
        const s16x4 bl0 = tr_read<(T) * 16384 + (KS) * 4096>(vb), bh0 = tr_read<(T) * 16384 + (KS) * 4096 + 2048>(vb); \
        const s16x4 bl1 = tr_read<(T) * 16384 + (KS) * 4096 + 512>(vb), bh1 = tr_read<(T) * 16384 + (KS) * 4096 + 2048 + 512>(vb); \
        asm volatile("s_waitcnt lgkmcnt(0)" ::: "memory"); SBAR(); \
        acc0 = __builtin_amdgcn_mfma_f32_32x32x16_bf16(PKF(al, ah), PKF(bl0, bh0), acc0, 0, 0, 0); \
        acc1 = __builtin_amdgcn_mfma_f32_32x32x16_bf16(PKF(al, ah), PKF(bl1, bh1), acc1, 0, 0, 0); } while (0)
        RS_STEP(0, 0); RS_STEP(0, 1); RS_STEP(0, 2); RS_STEP(0, 3); RS_STEP(1, 0); RS_STEP(1, 1); RS_STEP(1, 2); RS_STEP(1, 3);
#undef RS_STEP
        const int dir = rb >> 1;
        bf16* op = kvs + (((size_t)(bh * 64 + c) * 2 + dir) * 64) * 128;
#pragma unroll
        for (int r = 0; r < 16; ++r) { const int dk = 32 * (rb & 1) + crow(r, hi);
            op[dk * 128 + (2 * cg2) * 32 + r32] = (bf16)(cvtpk(acc0[r], 0.f) & 0xffffu);
            op[dk * 128 + (2 * cg2 + 1) * 32 + r32] = (bf16)(cvtpk(acc1[r], 0.f) & 0xffffu); }
        __syncthreads();
    }
#undef RS_LOAD
}

__device__ __forceinline__ void ret_main_phase(bf16* __restrict__ proj, const bf16* __restrict__ kvs, const float* __restrict__ gnw, const float* __restrict__ dl_f, const float* __restrict__ dl_b, int bid, int G, char* lds) {
    const int tid = fresh_tid(), wid = tid >> 6, lane = tid & 63, r32 = lane & 31, hi = lane >> 5;
    char* KT = lds;
    char* VT = lds + 32768;
    const unsigned koff = (unsigned)((tid >> 3) * PITCH + (tid & 7) * 8) * 2u, voff = (unsigned)((tid >> 4) * PITCH + (tid & 15) * 8) * 2u;
    const int c = wid >> 2, iloc = 32 * (wid & 3) + r32;
    const unsigned qoff = (unsigned)((128 * c + iloc) * PITCH + hi * 8) * 2u;
    const int vb0 = (int)(uintptr_t)VT + v_rd_base(lane);
    u32x4 kreg[4], vreg[8]; bf16x8 qr[4];
#define RM_LOAD(U) do { const int bh_ = (U) >> 5, cp_ = (U) & 31, b_ = bh_ >> 3, h_ = bh_ & 7; const size_t row0_ = (size_t)b_ * SEQ + (size_t)cp_ * 256; \
        const char* kbase_ = (const char*)(proj + row0_ * PITCH + C_RK + h_ * 64); const char* vbase_ = (const char*)(proj + row0_ * PITCH + C_RV + h_ * 128); \
        const char* qbase_ = (const char*)(proj + row0_ * PITCH + C_RQ + h_ * 64); \
        _Pragma("unroll") for (int i = 0; i < 4; ++i) kreg[i] = *(const u32x4*)(uptr(kbase_ + (size_t)i * (64 * PITCH * 2)) + koff); \
        _Pragma("unroll") for (int i = 0; i < 8; ++i) vreg[i] = *(const u32x4*)(uptr(vbase_ + (size_t)i * (32 * PITCH * 2)) + voff); \
        _Pragma("unroll") for (int d0 = 0; d0 < 4; ++d0) qr[d0] = *(const bf16x8*)(uptr(qbase_ + d0 * 32) + qoff); } while (0)
    int u = bid;
    if (u < 1024) RM_LOAD(u);
    for (; u < 1024; u += G) {
        const int bh = u >> 5, cp = u & 31, b = bh >> 3, h = bh & 7;
        const float lgf2 = -log1pf(expf(-dl_f[h])) * LOG2E, lgb2 = -log1pf(expf(-dl_b[h])) * LOG2E;
        const size_t row0 = (size_t)b * SEQ + (size_t)cp * 256;
        int iloc_l = iloc, hi_l = hi; asm volatile("" : "+v"(iloc_l), "+v"(hi_l));
#pragma unroll
        for (int i = 0; i < 4; ++i) { const int key = (tid >> 3) + 64 * i, ch = tid & 7; *(u32x4*)(KT + key * 128 + ((ch ^ (key & 7)) << 4)) = kreg[i]; }
#pragma unroll
        for (int i = 0; i < 8; ++i) { const int key = (tid >> 4) + 32 * i, ch = tid & 15; *(u32x4*)(VT + (key >> 6) * 16384 + v_st_raw(key & 63, ch * 8)) = vreg[i]; }
        __syncthreads();
        u32x4 sreg[8];
        { const char* sbase = (const char*)(kvs + (size_t)(bh * 64 + 2 * cp) * (128 * 128));
#pragma unroll
          for (int i = 0; i < 8; ++i) sreg[i] = *(const u32x4*)(uptr(sbase + (size_t)i * 8192) + (unsigned)tid * 16u); }
        f32x16 o[4] = {};
#pragma unroll
        for (int kt = 0; kt < 2; ++kt) {
            const int T = 2 * c + kt;
            f32x16 p0 = {}, p1 = {};
#pragma unroll
            for (int d0 = 0; d0 < 4; ++d0) { const int ch = d0 * 2 + hi; const int k0 = T * 64 + r32, k1 = k0 + 32;
                const bf16x8 b0 = *(const bf16x8*)(KT + k0 * 128 + ((ch ^ (k0 & 7)) << 4));
                const bf16x8 b1 = *(const bf16x8*)(KT + k1 * 128 + ((ch ^ (k1 & 7)) << 4));
                p0 = __builtin_amdgcn_mfma_f32_32x32x16_bf16(b0, qr[d0], p0, 0, 0, 0);
                p1 = __builtin_amdgcn_mfma_f32_32x32x16_bf16(b1, qr[d0], p1, 0, 0, 0); }
#pragma unroll
            for (int r = 0; r < 16; ++r) {
                const int j0 = 64 * kt + crow(r, hi_l), d0_ = iloc_l - j0, d1_ = d0_ - 32;
                const float e0 = (d0_ >= 0 ? lgf2 : -lgb2) * (float)d0_;
                const float e1 = (d1_ >= 0 ? lgf2 : -lgb2) * (float)d1_;
                p0[r] *= __builtin_amdgcn_exp2f(e0); p1[r] *= __builtin_amdgcn_exp2f(e1);
            }
            bf16x8 pa0, pa1, pa2, pa3;
            PK4(p0, 0, pa0); PK4(p0, 8, pa1); PK4(p1, 0, pa2); PK4(p1, 8, pa3);
            pv_d0(o, vb0 + T * 16384, pa0, pa1, pa2, pa3);
        }
        __syncthreads();
#pragma unroll
        for (int i = 0; i < 8; ++i) { const int trow = (tid >> 4) + 32 * i, ch = tid & 15, tile = trow >> 6, dk = trow & 63;
            *(u32x4*)(VT + tile * 16384 + v_st(dk, ch * 8)) = sreg[i]; }
        __syncthreads();
#pragma unroll
        for (int dir = 0; dir < 2; ++dir) {
            const float dec = dir == 0 ? __builtin_amdgcn_exp2f(lgf2 * (float)(iloc_l + 1)) : __builtin_amdgcn_exp2f(lgb2 * (float)(128 - iloc_l));
            bf16x8 pa[4];
#pragma unroll
            for (int k = 0; k < 4; ++k) { const u32x4 w = *reinterpret_cast<const u32x4*>(&qr[k]); u32x4 o4;
#pragma unroll
                for (int q = 0; q < 4; ++q) o4[q] = cvtpk(bf_lo(w[q]) * dec, bf_hi(w[q]) * dec);
                pa[k] = *reinterpret_cast<bf16x8*>(&o4); }
            pv_d0(o, vb0 + (2 * c + dir) * 16384, pa[0], pa[1], pa[2], pa[3]);
        }
        if (u + G < 1024) RM_LOAD(u + G);
        __syncthreads();
        char* stg = VT + wid * 8192;
        float gw[4];
#pragma unroll
        for (int d0 = 0; d0 < 4; ++d0) gw[d0] = gnw[h * 128 + d0 * 32 + r32];
#pragma unroll
        for (int r = 0; r < 16; ++r) {
            float s1 = (o[0][r] + o[1][r]) + (o[2][r] + o[3][r]);
            float s2 = (o[0][r] * o[0][r] + o[1][r] * o[1][r]) + (o[2][r] * o[2][r] + o[3][r] * o[3][r]);
#pragma unroll
            for (int ofs = 1; ofs < 32; ofs <<= 1) { s1 += __shfl_xor(s1, ofs); s2 += __shfl_xor(s2, ofs); }
            const float mu = s1 * (1.f / 128.f), var = fmaxf(s2 * (1.f / 128.f) - mu * mu, 0.f), rs = __builtin_amdgcn_rsqf(var + EPS);
            bf16* sp = (bf16*)(stg + crow(r, hi_l) * 256) + r32;
#pragma unroll
            for (int d0 = 0; d0 < 4; ++d0) sp[d0 * 32] = (bf16)(cvtpk((o[d0][r] - mu) * rs * gw[d0], 0.f) & 0xffffu);
        }
        { const char* gbase = (const char*)(proj + (row0 + 128 * c + 32 * (wid & 3)) * PITCH + C_RG + h * 128);
          const unsigned goff = (unsigned)((lane >> 4) * PITCH + (lane & 15) * 8) * 2u;
          u32x4 gv[8];
#pragma unroll
          for (int k = 0; k < 8; ++k) gv[k] = *(const u32x4*)(uptr(gbase + (size_t)k * (4 * PITCH * 2)) + goff);
#pragma unroll
          for (int k = 0; k < 8; ++k) {
              const u32x4 nv = *(const u32x4*)(stg + (4 * k + (lane >> 4)) * 256 + (lane & 15) * 16);
              u32x4 ov;
#pragma unroll
              for (int q = 0; q < 4; ++q) ov[q] = cvtpk(bf_lo(nv[q]) * bf_lo(gv[k][q]), bf_hi(nv[q]) * bf_hi(gv[k][q]));
              *(u32x4*)((char*)uptr(gbase + (size_t)k * (4 * PITCH * 2)) + goff) = ov;
          } }
        __syncthreads();
    }
#undef RM_LOAD
}

__global__ void __launch_bounds__(NTHREADS) fwd_megakernel(Params p) {
    extern __shared__ __attribute__((aligned(16))) unsigned char lds[];
    cg::grid_group grid = cg::this_grid();
    const int G = gridDim.x, bid = blockIdx.x;
    const int NGW = G * NWAVES; const long NGT = (long)G * NTHREADS;
#define PHASE_IDS() const int tid = fresh_tid(), lane = tid & 63, wave = tid >> 6, gw = bid * NWAVES + wave; const long gt = (long)bid * NTHREADS + tid; (void)lane; (void)gw; (void)gt
    unsigned char* ws = p.ws;
    const float* x = p.in[0]; const float* cvec = p.in[1]; const int* positions = (const int*)p.in[2];
    const float* norm_w = p.in[3]; const float* w_ada = p.in[4]; const float* b_ada = p.in[5]; const float* w_in = p.in[6];
    const float* dl_f = p.in[7]; const float* dl_b = p.in[8]; const float* gn_w = p.in[9];
    const float* q_norm_w = p.in[10]; const float* w_uq = p.in[11]; const float* kv_norm_w = p.in[12]; const float* w_ukv = p.in[13];
    const float* qn_nope_w = p.in[14]; const float* qn_rope_w = p.in[15]; const float* kn_nope_w = p.in[16]; const float* kn_rope_w = p.in[17];
    const float* mla_norm_w = p.in[18]; const float* w_out = p.in[19];
    bf16* PROJ = (bf16*)(ws + WS_PROJ); bf16* KB = (bf16*)(ws + WS_K); bf16* VB = (bf16*)(ws + WS_V);
    bf16* WIN = (bf16*)(ws + WS_WIN); bf16* WQ = (bf16*)(ws + WS_WQ); bf16* WKV = (bf16*)(ws + WS_WKV); bf16* WO = (bf16*)(ws + WS_WO);
    float* CS64 = (float*)(ws + WS_CS64); float* CS32 = (float*)(ws + WS_CS32); float* MOD = (float*)(ws + WS_MOD); f32x2* STAT = (f32x2*)(ws + WS_STAT);
    float* SSB = (float*)(ws + WS_SS);
    bf16* HB = (bf16*)p.out; bf16* QO = (bf16*)((unsigned char*)p.out + OUT_QO); bf16* KVS = (bf16*)((unsigned char*)p.out + OUT_KVS);

    if (threadIdx.x < 4) ((volatile LAS unsigned*)((LAS unsigned char*)lds + LDS_CTL_OFF))[threadIdx.x] = 0u;
    __syncthreads();
    const XcdBarrier xbar = xcd_barrier_post((unsigned*)(ws + WS_BAR), (volatile LAS unsigned*)((LAS unsigned char*)lds + LDS_CTL_OFF));
#define GRID_BAR() xcd_barrier(xbar)
    {
        PHASE_IDS();
        float* sc = (float*)lds; float* red = (float*)(lds + 16384);
        for (int it = bid; it < 192; it += G) {
            for (int i = tid; i < 4096; i += NTHREADS) sc[i] = silu_f(cvec[i]);
            __syncthreads();
            const int ks4 = lane >> 4, col = lane & 15, kb0 = wave * 128 + ks4 * 32;
            const float* wp = w_ada + (size_t)kb0 * 3072 + it * 16 + col;
            float a0 = 0.f, a1 = 0.f, a2 = 0.f, a3 = 0.f;
#pragma unroll 8
            for (int i = 0; i < 32; ++i) { const float wv = wp[(size_t)i * 3072]; const int k = kb0 + i;
                a0 += sc[k] * wv; a1 += sc[1024 + k] * wv; a2 += sc[2048 + k] * wv; a3 += sc[3072 + k] * wv; }
            a0 += __shfl_xor(a0, 16); a0 += __shfl_xor(a0, 32); a1 += __shfl_xor(a1, 16); a1 += __shfl_xor(a1, 32);
            a2 += __shfl_xor(a2, 16); a2 += __shfl_xor(a2, 32); a3 += __shfl_xor(a3, 16); a3 += __shfl_xor(a3, 32);
            if (lane < 16) { red[(wave * 4 + 0) * 16 + lane] = a0; red[(wave * 4 + 1) * 16 + lane] = a1; red[(wave * 4 + 2) * 16 + lane] = a2; red[(wave * 4 + 3) * 16 + lane] = a3; }
            __syncthreads();
            if (tid < 64) { const int bb = tid >> 4, l = tid & 15; float s = b_ada[it * 16 + l];
#pragma unroll
                for (int w = 0; w < 8; ++w) s += red[(w * 4 + bb) * 16 + l];
                MOD[bb * 3072 + it * 16 + l] = s; }
            __syncthreads();
        }
    }
    if (p.ws == nullptr) grid.sync();
    GRID_BAR();
    for (int pass_ = 0; pass_ < 2; ++pass_)
    {
    if ((pass_ ^ (bid & 1)) == 0) {
        PHASE_IDS();
        constexpr long I1 = 4864L * 128, I2 = 768L * 48, I3 = 1536L * 32, I4 = 1024L * 256;
        for (long it = gt; it < I1 + I2 + I3 + I4; it += NGT) {
            long r = it; const float* W; const float* ksc = nullptr; int n, kc, Kd, No, oc; bf16* WT;
            if (r < I1) { n = (int)(r % 4864); kc = (int)(r / 4864); W = w_in; Kd = 1024; No = D_IN; oc = win_colmap(n); WT = WIN; }
            else if ((r -= I1) < I2) { n = (int)(r % 768); kc = (int)(r / 768); W = w_uq; Kd = 384; No = 768; oc = wq_colmap(n); WT = WQ; ksc = q_norm_w; }
            else if ((r -= I2) < I3) { n = (int)(r % 1536); kc = (int)(r / 1536); W = w_ukv; Kd = 256; No = 1536; oc = wkv_colmap(n); WT = WKV; ksc = kv_norm_w; }
            else { r -= I3; n = (int)(r % 1024); kc = (int)(r / 1024); W = w_out; Kd = 2048; No = 1024; oc = n; WT = WO; }
            float v[8];
#pragma unroll
            for (int i = 0; i < 8; ++i) { const int k = kc * 8 + i; const int ks_ = (W == w_out) ? (k < 1024 ? k + 1024 : k - 1024) : k;
                float t = oc >= 0 ? W[(size_t)ks_ * No + oc] : 0.f; if (ksc) t *= ksc[k]; v[i] = t; }
            u32x4 w; w.x = cvtpk(v[0], v[1]); w.y = cvtpk(v[2], v[3]); w.z = cvtpk(v[4], v[5]); w.w = cvtpk(v[6], v[7]);
            *(u32x4*)(WT + (size_t)n * Kd + kc * 8) = w;
        }
        for (long it = gt; it < (long)M * 48; it += NGT) {
            const int m = (int)(it / 48), i = (int)(it % 48);
            const float pos = (float)positions[m];
            const float fe = i < 32 ? (float)(2 * i) * (1.f / 64.f) : (float)(2 * (i - 32)) * (1.f / 32.f);
            const float invf = exp2f(-fe * 13.287712379549449f);
            const float ang = pos * invf;
            double rev = (double)ang * 0.15915494309189535; rev -= floor(rev);
            const float rf = (float)rev;
            const float cs = __builtin_amdgcn_cosf(rf), sn = __builtin_amdgcn_sinf(rf);
            float* dst = i < 32 ? CS64 + ((size_t)m * 32 + i) * 2 : CS32 + ((size_t)m * 16 + (i - 32)) * 2;
            *(f32x2*)dst = (f32x2){cs, sn};
        }
    }
    else { PHASE_IDS();
    for (int m0 = gw; m0 < M; m0 += 2 * NGW) {
        const int m1 = m0 + NGW; const bool has1 = m1 < M;
        const f32x4* xr0 = (const f32x4*)(x + (size_t)m0 * DM) + lane; const f32x4* xr1 = (const f32x4*)(x + (size_t)(has1 ? m1 : m0) * DM) + lane;
        f32x4 v0[4], v1[4]; float s0 = 0.f, s1 = 0.f;
#pragma unroll
        for (int j = 0; j < 4; ++j) { v0[j] = xr0[64 * j]; v1[j] = xr1[64 * j]; }
#pragma unroll
        for (int j = 0; j < 4; ++j) { s0 += (v0[j].x * v0[j].x + v0[j].y * v0[j].y) + (v0[j].z * v0[j].z + v0[j].w * v0[j].w);
                                      s1 += (v1[j].x * v1[j].x + v1[j].y * v1[j].y) + (v1[j].z * v1[j].z + v1[j].w * v1[j].w); }
        const float rstd0 = __builtin_amdgcn_rsqf(wave_sum(s0) * (1.f / DM) + EPS), rstd1 = __builtin_amdgcn_rsqf(wave_sum(s1) * (1.f / DM) + EPS);
        const int b0 = m0 / SEQ, b1 = (has1 ? m1 : m0) / SEQ;
        u32x2* o80 = (u32x2*)(HB + (size_t)m0 * DM) + lane; u32x2* o81 = (u32x2*)(HB + (size_t)m1 * DM) + lane;
#pragma unroll
        for (int j = 0; j < 4; ++j) {
            const int col = 4 * lane + 256 * j;
            const f32x4 nw = *(const f32x4*)(norm_w + col);
            { const f32x4 sh = *(const f32x4*)(MOD + b0 * 3072 + col), scl = *(const f32x4*)(MOD + b0 * 3072 + 1024 + col);
              const f32x4 hv = v0[j] * rstd0 * nw * (scl + 1.f) + sh; o80[64 * j] = (u32x2){cvtpk(hv.x, hv.y), cvtpk(hv.z, hv.w)}; }
            if (has1) { const f32x4 sh = *(const f32x4*)(MOD + b1 * 3072 + col), scl = *(const f32x4*)(MOD + b1 * 3072 + 1024 + col);
              const f32x4 hv = v1[j] * rstd1 * nw * (scl + 1.f) + sh; o81[64 * j] = (u32x2){cvtpk(hv.x, hv.y), cvtpk(hv.z, hv.w)}; }
        }
    } }
    }
    GRID_BAR();

    {
        pg8::Gemm g{HB, WIN, M, PITCH, DM, DM}; pg8::StaticOrder S; S.init(M, PITCH, G, bid);
        EpiIn E{PROJ, CS64};
        pg8::gemm_phase<EpiIn, pg8::StaticOrder>((LAS unsigned char*)lds, g, S, E);
    }
    GRID_BAR();

#if PROBE_DUP == 1
    for (int rep_ = 0; rep_ < 2; ++rep_)
#endif
    {
    { PHASE_IDS();
    const int sub = lane >> 4, l16 = lane & 15;
    for (int m0 = gw * 4; m0 < M; m0 += NGW * 4) {
        const int m = m0 + sub, b = m / SEQ, s = m - b * SEQ;
        const bf16* pr = PROJ + (size_t)m * PITCH + C_CQ + 8 * l16;
        u32x4 v[6];
#pragma unroll
        for (int i = 0; i < 5; ++i) v[i] = *(const u32x4*)(pr + 128 * i);
        v[5] = (u32x4){0u, 0u, 0u, 0u}; if (l16 < 4) v[5] = *(const u32x4*)(pr + 640);
        float s_cq = sumsq8(v[0]) + sumsq8(v[1]) + sumsq8(v[2]);
        float s_ckv = sumsq8(v[3]) + sumsq8(v[4]);
        float s_kr = sumsq8(v[5]);
#pragma unroll
        for (int ofs = 1; ofs < 16; ofs <<= 1) { s_cq += __shfl_xor(s_cq, ofs); s_ckv += __shfl_xor(s_ckv, ofs); s_kr += __shfl_xor(s_kr, ofs); }
        if (l16 == 0) STAT[m] = (f32x2){s_cq * (1.f / 384.f), s_ckv * (1.f / 256.f)};
        const float rk = __builtin_amdgcn_rsqf(s_kr * (1.f / 32.f) + EPS);
        const u32x4 b2 = v[5];
        u32x4 pw; pw.x = __shfl_xor(b2.x, 2); pw.y = __shfl_xor(b2.y, 2); pw.z = __shfl_xor(b2.z, 2); pw.w = __shfl_xor(b2.w, 2);
        if (l16 < 2) {
            const int pb = 8 * l16;
            unsigned ow[8];
#pragma unroll
            for (int q = 0; q < 4; ++q) {
#pragma unroll
                for (int e = 0; e < 2; ++e) {
                    const int pidx = pb + 2 * q + e;
                    const float x1 = (e ? bf_hi(b2[q]) : bf_lo(b2[q])) * rk * kn_rope_w[pidx];
                    const float x2 = (e ? bf_hi(pw[q]) : bf_lo(pw[q])) * rk * kn_rope_w[pidx + 16];
                    const f32x2 csv = *(const f32x2*)(CS32 + ((size_t)m * 16 + pidx) * 2);
                    ow[2 * q + e] = cvtpk(x1 * csv.x - x2 * csv.y, x2 * csv.x + x1 * csv.y);
                }
            }
            const u32x4 w0 = {ow[0], ow[1], ow[2], ow[3]}, w1 = {ow[4], ow[5], ow[6], ow[7]};
#pragma unroll
            for (int hh = 0; hh < NH; ++hh) { bf16* kp = KB + ((size_t)(b * NH + hh) * SEQ + s) * 96 + 64 + 16 * l16;
                *(u32x4*)kp = w0; *(u32x4*)(kp + 8) = w1; }
        }
    } }
    ret_state_phase(PROJ, KVS, dl_f, dl_b, bid, G, (char*)lds);
    }
    GRID_BAR();

    { PHASE_IDS();
    for (long it = gt; it < 32L * 2 * 2048; it += NGT) {
        const int e4 = (int)(it & 2047), dir = (int)((it >> 11) & 1), bh = (int)(it >> 12), h = bh & 7;
        const float lg2 = -log1pf(expf(-(dir ? dl_b[h] : dl_f[h]))) * LOG2E;
        const float gC = __builtin_amdgcn_exp2f(lg2 * 128.f);
        float s0 = 0.f, s1 = 0.f, s2 = 0.f, s3 = 0.f;
        for (int i = 0; i < 64; ++i) {
            const int c = dir ? 63 - i : i;
            u32x2* ptr = (u32x2*)(KVS + (((size_t)(bh * 64 + c) * 2 + dir) * 8192) + 4 * e4);
            const u32x2 kv = *ptr;
            *ptr = (u32x2){cvtpk(s0, s1), cvtpk(s2, s3)};
            s0 = s0 * gC + bf_lo(kv.x); s1 = s1 * gC + bf_hi(kv.x); s2 = s2 * gC + bf_lo(kv.y); s3 = s3 * gC + bf_hi(kv.y);
        }
    } }
#if PROBE_DUP == 2
    for (int rep_ = 0; rep_ < 2; ++rep_)
#endif
    {
    {
        pg8::Gemm g{PROJ + C_CQ, WQ, M, 768, 384, PITCH}; pg8::StaticOrder S; S.init(M, 768, G, G - 1 - bid);
        EpiUp<3> E{QO, nullptr, STAT, qn_nope_w, qn_rope_w, CS32};
        pg8::gemm_phase<EpiUp<3>, pg8::StaticOrder>((LAS unsigned char*)lds, g, S, E);
    }
    {
        pg8::Gemm g{PROJ + C_CKV, WKV, M, 1536, 256, PITCH}; pg8::StaticOrder S; S.init(M, 1536, G, bid);
        EpiUp<2> E{KB, VB, STAT, kn_nope_w, nullptr, nullptr};
        pg8::gemm_phase<EpiUp<2>, pg8::StaticOrder>((LAS unsigned char*)lds, g, S, E);
    }
    }
    GRID_BAR();

    {
        const int nA = (1024 + G - 1) / G, rslot = (bid & 7) % (nA + 1);
        for (int i = 0; i <= nA; ++i) {
            if (i == rslot) ret_main_phase(PROJ, KVS, gn_w, dl_f, dl_b, bid, G, (char*)lds);
            const int u = i * G + bid;
            if (i < nA && u < 1024) {
                int bh, qb;
                if (G == 256) { bh = (bid & 7) * 4 + i; qb = bid >> 3; } else { bh = u >> 5; qb = u & 31; }
                bf16* qo = QO + ((size_t)bh * SEQ + (size_t)qb * 256) * 128;
                const int b_ = bh >> 3, h_ = bh & 7; const size_t row_ = (size_t)b_ * SEQ + (size_t)qb * 256;
                attn_unit(qo, KB + (size_t)bh * SEQ * 96, VB + (size_t)bh * SEQ * 128, SEQ, (char*)lds,
                          PROJ + row_ * PITCH + C_MG + h_ * 128, SSB + row_ * 8 + h_, mla_norm_w + h_ * 128);
                __syncthreads();
            }
        }
    }
    GRID_BAR();

    {
        pg8::Gemm g{PROJ + C_MG, WO, M, DM, 2048, PITCH}; pg8::StaticOrder S; S.init(M, DM, G, bid);
        EpiOut E{x, p.out, MOD, SSB};
        pg8::gemm_phase<EpiOut, pg8::StaticOrder>((LAS unsigned char*)lds, g, S, E);
    }
}

extern "C" void kernel_launch(void* const* d_in, const int* in_sizes, int n_in, void* d_out, int out_size, void* d_ws, size_t ws_size, hipStream_t stream) {
    static int grid_blocks = 0;
    if (grid_blocks == 0) {
        if (n_in != 20 || out_size != M * DM || ws_size < WS_END) { fprintf(stderr, "kernel_launch: unexpected shapes (n_in %d out %d ws %zu)\n", n_in, out_size, ws_size); grid_blocks = -1; return; }
        int dev = 0, cus = 0, per_cu = 0;
        hipGetDevice(&dev);
        hipDeviceGetAttribute(&cus, hipDeviceAttributeMultiprocessorCount, dev);
        if (hipFuncSetAttribute((const void*)fwd_megakernel, hipFuncAttributeMaxDynamicSharedMemorySize, LDS_BYTES) != hipSuccess) { fprintf(stderr, "kernel_launch: hipFuncSetAttribute failed\n"); grid_blocks = -1; return; }
        if (hipOccupancyMaxActiveBlocksPerMultiprocessor(&per_cu, (const void*)fwd_megakernel, NTHREADS, LDS_BYTES) != hipSuccess || per_cu < 1) { fprintf(stderr, "kernel_launch: occupancy query failed (%d)\n", per_cu); per_cu = 1; }
        (void)hipGetLastError();
        grid_blocks = cus * per_cu;
    }
    if (grid_blocks < 0) return;
    if (hipMemsetAsync((char*)d_ws + WS_BAR, 0, XCD_BAR_WORDS * 4, stream) != hipSuccess) { fprintf(stderr, "kernel_launch: memset failed\n"); return; }
    Params p{};
    for (int i = 0; i < 20; ++i) p.in[i] = (const float*)d_in[i];
    p.out = (float*)d_out; p.ws = (unsigned char*)d_ws;
    void* args[] = {&p};
    hipError_t e = hipLaunchCooperativeKernel((const void*)fwd_megakernel, dim3(grid_blocks), dim3(NTHREADS), args, LDS_BYTES, stream);
    if (e != hipSuccess) fprintf(stderr, "cooperative launch failed: %s (grid %d)\n", hipGetErrorString(e), grid_blocks);
}
```

```cpp
#ifndef PROBE_DUP
#define PROBE_DUP 0
#endif
#include <hip/hip_runtime.h>
#include <hip/hip_cooperative_groups.h>
#include <cstdio>
#include <cstdint>
namespace cg = cooperative_groups;

namespace pg8 {
#define PG8_LAS __attribute__((address_space(3)))
typedef unsigned short bf16_t;
typedef short bf16x8 __attribute__((ext_vector_type(8)));
typedef float f32x4 __attribute__((ext_vector_type(4)));
typedef unsigned u32x4 __attribute__((ext_vector_type(4)));
constexpr int BM = 256, BK = 64, HALF = 128, HTB = HALF * BK * 2, STAGE_BYTES = 8 * HTB, NXCD = 8, WGM = 8;

__host__ __device__ __forceinline__ int lds_byte(int r, int c) { const int st = (r >> 4) * 2 + (c >> 5), rr = r & 15, cc = c & 31, ob = rr * 64 + cc * 2; return st * 1024 + (ob ^ (((ob >> 9) & 1) << 5)); }
__host__ __device__ __forceinline__ void stage_rc(int b, int& R, int& C) { const int st = b / 1024, sb = b % 1024, swz = sb ^ (((sb >> 9) & 1) << 5); R = (st >> 1) * 16 + swz / 64; C = (st & 1) * 32 + (swz % 64) / 2; }
__host__ __device__ __forceinline__ int perm32(int rho) { const int n = rho >> 4, i = rho & 15; return 8 * (i >> 2) + 4 * n + (i & 3); }

struct Unit { int pm, pn; };
struct Gemm { const bf16_t* A; const bf16_t* Bt; int M, N, K, lda; };

struct StaticOrder {
    int nM, nN, nwg, G, c;
    __host__ __device__ void init(int M, int N, int G_, int c_) { nM = M / BM; nN = N / BM; nwg = nM * nN; G = G_; c = c_; }
    __host__ __device__ bool next(int i, Unit& u) const {
        const long L = (long)i * G + c; if (L >= nwg) return false;
        int wgid = (int)L; { const int q = nwg / NXCD, r = nwg % NXCD, xcd = wgid % NXCD, off = wgid / NXCD; wgid = (xcd < r ? xcd * (q + 1) : r * (q + 1) + (xcd - r) * q) + off; }
        const int nig = WGM * nN, gid = wgid / nig, fm = gid * WGM, gsz = (nM - fm) < WGM ? (nM - fm) : WGM;
        u.pm = fm + ((wgid % nig) % gsz); u.pn = (wgid % nig) / gsz; return true;
    }
};

typedef float f32x2_c __attribute__((ext_vector_type(2)));
typedef __bf16 bf16x2_c __attribute__((ext_vector_type(2)));
__device__ __forceinline__ unsigned cvt_pk_bf16(float lo, float hi) { const f32x2_c v = {lo, hi}; return __builtin_bit_cast(unsigned, __builtin_convertvector(v, bf16x2_c)); }

template <class Epi, class Sched>
__device__ __forceinline__ void gemm_phase(PG8_LAS unsigned char* lds, const Gemm g, const Sched& S, const Epi& E) {
    int tid_ = threadIdx.x; asm volatile("" : "+v"(tid_));
    const int tid = tid_, wid = __builtin_amdgcn_readfirstlane(tid >> 6), lane = tid & 63, wr = wid >> 2, wc = wid & 3, fr = lane & 15, fq = lane >> 4;
    const int K = g.K, nt = K / BK, lda = g.lda;
    unsigned voffA[2], voffB[2];
#pragma unroll
    for (int i = 0; i < 2; ++i) { int R, C; stage_rc(tid * 16 + i * 8192, R, C); const int Rb = Epi::PERM ? ((R & ~31) + perm32(R & 31)) : R;
        voffA[i] = (unsigned)(R * lda + C) * 2u; voffB[i] = (unsigned)(Rb * K + C) * 2u; }
    const size_t kstep = (size_t)(BK * 2);
    const size_t hstepA = (size_t)HALF * lda * 2, hstepB = (size_t)HALF * K * 2;
    const size_t tstepA = 2 * hstepA, tstepB = 2 * hstepB;
    const unsigned ldsw = (unsigned)wid * 1024u;
    const int aoff = lds_byte(wr * 64 + fr, fq * 8), boff = lds_byte(wc * 32 + fr, fq * 8);
#define PG8_SA(b, h) (((b) * 2 + (h)) * HTB)
#define PG8_SB(b, h) ((4 + (b) * 2 + (h)) * HTB)
#define PG8_STAGE(bufoff, gbase, voff) do { _Pragma("unroll") for (int _i = 0; _i < 2; ++_i) \
        __builtin_amdgcn_global_load_lds((const unsigned*)((const char*)(gbase) + (voff)[_i]), (PG8_LAS unsigned*)(lds + (bufoff) + ldsw + _i * 8192), 16, 0, 0); } while (0)
#define PG8_LDA(dst, b, h) do { _Pragma("unroll") for (int m = 0; m < 4; ++m) _Pragma("unroll") for (int k = 0; k < 2; ++k) dst[m][k] = *(const PG8_LAS bf16x8*)(lds + PG8_SA(b, h) + aoff + m * 2048 + k * 1024); } while (0)
#define PG8_LDB(dst, b, h) do { _Pragma("unroll") for (int n = 0; n < 2; ++n) _Pragma("unroll") for (int k = 0; k < 2; ++k) dst[n][k] = *(const PG8_LAS bf16x8*)(lds + PG8_SB(b, h) + boff + n * 2048 + k * 1024); } while (0)
#define PG8_MMA(ai, bj, At, Bt) do { __builtin_amdgcn_s_setprio(1); _Pragma("unroll") for (int m = 0; m < 4; ++m) _Pragma("unroll") for (int n = 0; n < 2; ++n) _Pragma("unroll") for (int k = 0; k < 2; ++k) \
        acc[ai][bj][m][n] = __builtin_amdgcn_mfma_f32_16x16x32_bf16(Bt[n][k], At[m][k], acc[ai][bj][m][n], 0, 0, 0); __builtin_amdgcn_s_setprio(0); } while (0)
#define PG8_WAIT_V(n) asm volatile("s_waitcnt vmcnt(" #n ")" ::: "memory")
#define PG8_WAIT_L(n) asm volatile("s_waitcnt lgkmcnt(" #n ")" ::: "memory")
#define PG8_BAR __builtin_amdgcn_s_barrier()
#define PG8_SCHED __builtin_amdgcn_sched_barrier(0)
    Unit cur, nxt; int ui = 0;
    if (!S.next(0, cur)) return;
    f32x4 acc[2][2][4][2];
#pragma unroll
    for (int a = 0; a < 2; ++a)
#pragma unroll
        for (int b = 0; b < 2; ++b)
#pragma unroll
            for (int m = 0; m < 4; ++m)
#pragma unroll
                for (int n = 0; n < 2; ++n) acc[a][b][m][n] = (f32x4){0.f, 0.f, 0.f, 0.f};
    bf16x8 At[4][2], B0[2][2], B1[2][2];
    const char* cA = (const char*)g.A + (size_t)cur.pm * tstepA; const char* cB = (const char*)g.Bt + (size_t)cur.pn * tstepB;
    PG8_STAGE(PG8_SB(0, 0), cB, voffB); PG8_STAGE(PG8_SB(0, 1), cB + hstepB, voffB); PG8_STAGE(PG8_SA(0, 0), cA, voffA); PG8_STAGE(PG8_SA(0, 1), cA + hstepA, voffA);
    if (wr == 1) PG8_BAR;
    PG8_WAIT_V(2); PG8_BAR;
    PG8_STAGE(PG8_SB(1, 0), cB + kstep, voffB); PG8_STAGE(PG8_SA(1, 0), cA + kstep, voffA); PG8_STAGE(PG8_SB(1, 1), cB + hstepB + kstep, voffB);
    PG8_WAIT_V(6); PG8_BAR;
    for (;;) {
        const bool has_next = S.next(ui + 1, nxt);
        const char* nA = has_next ? (const char*)g.A + (size_t)nxt.pm * tstepA : cA; const char* nB = has_next ? (const char*)g.Bt + (size_t)nxt.pn * tstepB : cB;
#pragma unroll 1
        for (int t = 0; t < nt; t += 2) {
            if constexpr (Epi::MIDSCALE) { if (t == nt / 2) E.mid(acc, cur); }
            const bool last = (t == nt - 2);
            const char* a1 = cA + (size_t)(t + 1) * kstep;
            const char* a2 = last ? nA : cA + (size_t)(t + 2) * kstep; const char* b2 = last ? nB : cB + (size_t)(t + 2) * kstep;
            const char* a3 = a2 + kstep; const char* b3 = b2 + kstep;
            PG8_LDB(B0, 0, 0); PG8_LDB(B1, 0, 1); PG8_SCHED; PG8_LDA(At, 0, 0); PG8_STAGE(PG8_SA(1, 1), a1 + hstepA, voffA);
            PG8_WAIT_V(8); PG8_WAIT_L(0); PG8_BAR; PG8_MMA(0, 0, At, B0); PG8_MMA(0, 1, At, B1); PG8_BAR; PG8_SCHED;
            PG8_LDA(At, 0, 1); PG8_STAGE(PG8_SB(0, 0), b2, voffB); PG8_STAGE(PG8_SB(0, 1), b2 + hstepB, voffB); PG8_STAGE(PG8_SA(0, 0), a2, voffA);
            PG8_WAIT_V(8); PG8_WAIT_L(0); PG8_BAR; PG8_MMA(1, 0, At, B0); PG8_MMA(1, 1, At, B1); PG8_BAR; PG8_SCHED;
            PG8_LDB(B0, 1, 0); PG8_LDB(B1, 1, 1); PG8_SCHED; PG8_LDA(At, 1, 0); PG8_STAGE(PG8_SA(0, 1), a2 + hstepA, voffA);
            PG8_WAIT_V(8); PG8_WAIT_L(0); PG8_BAR; PG8_MMA(0, 0, At, B0); PG8_MMA(0, 1, At, B1); PG8_BAR; PG8_SCHED;
            PG8_LDA(At, 1, 1); PG8_STAGE(PG8_SB(1, 0), b3, voffB); PG8_STAGE(PG8_SB(1, 1), b3 + hstepB, voffB); PG8_STAGE(PG8_SA(1, 0), a3, voffA);
            PG8_WAIT_V(8); PG8_WAIT_L(0); PG8_BAR; PG8_MMA(1, 0, At, B0); PG8_MMA(1, 1, At, B1); PG8_BAR; PG8_SCHED;
        }
        if (wr == 0) PG8_BAR;
        E(acc, cur, wr, wc, fr, fq);
        if (!has_next) break;
#pragma unroll
        for (int a = 0; a < 2; ++a)
#pragma unroll
            for (int b = 0; b < 2; ++b)
#pragma unroll
                for (int m = 0; m < 4; ++m)
#pragma unroll
                    for (int n = 0; n < 2; ++n) acc[a][b][m][n] = (f32x4){0.f, 0.f, 0.f, 0.f};
        cur = nxt; cA = nA; cB = nB; ++ui;
        if (wr == 1) PG8_BAR;
    }
    PG8_WAIT_V(0);
    PG8_BAR;
#undef PG8_SA
#undef PG8_SB
#undef PG8_STAGE
#undef PG8_LDA
#undef PG8_LDB
#undef PG8_MMA
#undef PG8_WAIT_V
#undef PG8_WAIT_L
#undef PG8_BAR
#undef PG8_SCHED
}
}

typedef unsigned short bf16;
typedef short bf16x8 __attribute__((ext_vector_type(8)));
typedef short s16x4 __attribute__((ext_vector_type(4)));
typedef float f32x16 __attribute__((ext_vector_type(16)));
typedef float f32x4 __attribute__((ext_vector_type(4)));
typedef float f32x2 __attribute__((ext_vector_type(2)));
typedef unsigned u32x4 __attribute__((ext_vector_type(4)));
typedef unsigned u32x2 __attribute__((ext_vector_type(2)));
#define LAS __attribute__((address_space(3)))

constexpr int BATCH = 4, SEQ = 8192, DM = 1024, M = BATCH * SEQ, NH = 8;
constexpr int D_IN = 4768, PITCH = 4864;
constexpr int C_RQ = 0, C_RK = 512, C_RV = 1024, C_MG = 2048, C_RG = 3072, C_CQ = 4096, C_CKV = 4480, C_KR = 4736;
constexpr float EPS = 1e-6f;
constexpr float QSC = 0.10206207261596575f * 1.4426950408889634f;
constexpr float LOG2E = 1.4426950408889634f;
constexpr int NTHREADS = 512, NWAVES = 8;

constexpr size_t MiB = 1u << 20;
constexpr size_t WS_PROJ = 0;
constexpr size_t WS_K = 304 * MiB;
constexpr size_t WS_V = 352 * MiB;
constexpr size_t WS_WIN = 416 * MiB;
constexpr size_t WS_WQ = 426 * MiB;
constexpr size_t WS_WKV = 427 * MiB;
constexpr size_t WS_WO = 428 * MiB;
constexpr size_t WS_CS64 = 432 * MiB;
constexpr size_t WS_CS32 = 440 * MiB;
constexpr size_t WS_MOD = 444 * MiB;
constexpr size_t WS_STAT = 445 * MiB;
constexpr size_t WS_SS = 447 * MiB;
constexpr size_t WS_BAR = 446 * MiB;
constexpr size_t WS_END = 448 * MiB;
constexpr size_t OUT_QO = 0, OUT_KVS = 64 * MiB;

constexpr int LDS_BYTES = 135168;
constexpr int LDS_CTL_OFF = 133120;

struct Params { const float* in[20]; float* out; unsigned char* ws; };

__device__ __forceinline__ unsigned cvtpk(float lo, float hi) { return pg8::cvt_pk_bf16(lo, hi); }
__device__ __forceinline__ float bf_lo(unsigned w) { return __uint_as_float(w << 16); }
__device__ __forceinline__ float bf_hi(unsigned w) { return __uint_as_float(w & 0xffff0000u); }
__device__ __forceinline__ float wave_sum(float v) {
#pragma unroll
    for (int o = 1; o < 64; o <<= 1) v += __shfl_xor(v, o);
    return v;
}
__device__ __forceinline__ float silu_f(float v) { return v * __builtin_amdgcn_rcpf(1.f + __builtin_amdgcn_exp2f(-v * LOG2E)); }
__device__ __forceinline__ float sumsq8(u32x4 a) {
    float s = 0.f;
#pragma unroll
    for (int i = 0; i < 4; ++i) { const float x = bf_lo(a[i]), y = bf_hi(a[i]); s += x * x + y * y; }
    return s;
}

__device__ __forceinline__ int fresh_tid() { int t = threadIdx.x; asm volatile("" : "+v"(t)); return t; }
#define EPI_LANES() const int t_ = fresh_tid(), l_ = t_ & 63, wi_ = t_ >> 6, wr = wi_ >> 2, wc = wi_ & 3, fr = l_ & 15, fq = l_ >> 4


#define RLX_AGENT __ATOMIC_RELAXED, __HIP_MEMORY_SCOPE_AGENT
#define XB_TMO      128
#define XB_XCNT(j)  (256  + 64 * (j))
#define XB_XSUB(j)  (1280 + 64 * (j))
#define XB_XGEN(j)  (2304 + 64 * (j))
#define XB_TOP      3328
#define XB_TOPGEN   3392
#define XCD_BAR_WORDS 3456
#define XB_SPIN_CAP (1u << 18)

__device__ __forceinline__ unsigned xb_ld(unsigned* p)              { return __hip_atomic_load(p, __ATOMIC_RELAXED, __HIP_MEMORY_SCOPE_AGENT); }
__device__ __forceinline__ unsigned xb_add(unsigned* p, unsigned v) { return __hip_atomic_fetch_add(p, v, __ATOMIC_RELAXED, __HIP_MEMORY_SCOPE_AGENT); }
__device__ __forceinline__ unsigned xb_xcc_id() { return (unsigned)__builtin_amdgcn_s_getreg((3 << 11) | 20) & 0xFu; }
#define XB_SPIN(cond, bar) do { unsigned _sp = 0; while (cond) { __builtin_amdgcn_s_sleep(1); \
    if ((++_sp & 255u) == 0u) { if (xb_ld(&(bar)[XB_TMO])) break; if (_sp > XB_SPIN_CAP) { atomicAdd(&(bar)[XB_TMO], 1u); break; } } } } while (0)

struct XcdBarrier {
    unsigned* bar; unsigned x;
    volatile LAS unsigned* st;
};

__device__ __forceinline__ XcdBarrier xcd_barrier_post(unsigned* bar, volatile LAS unsigned* st) {
    XcdBarrier b; b.bar = bar; b.x = xb_xcc_id(); b.st = st;
    if (threadIdx.x == 0) (void)xb_add(&bar[XB_XCNT(b.x)], 1u);
    return b;
}
__device__ __forceinline__ void xcd_barrier_complete(unsigned* bar, unsigned x, unsigned& nloc, unsigned& nx) {
    const unsigned G = gridDim.x * gridDim.y * gridDim.z;
    unsigned sum, cnt, mine, sp = 0u;
    for (;;) {
        sum = 0u; cnt = 0u; mine = 0u;
#pragma unroll
        for (unsigned j = 0; j < 16; ++j) { const unsigned c = xb_ld(&bar[XB_XCNT(j)]); sum += c; cnt += (c > 0u) ? 1u : 0u; mine = (j == x) ? c : mine; }
        if (sum == G) break;
        __builtin_amdgcn_s_sleep(1);
        if ((++sp & 255u) == 0u) { if (xb_ld(&bar[XB_TMO])) break; if (sp > XB_SPIN_CAP) { atomicAdd(&bar[XB_TMO], 1u); break; } }
    }
    nloc = mine > 0u ? mine : 1u; nx = cnt > 0u ? cnt : 1u;
}

__device__ __forceinline__ void xcd_barrier(const XcdBarrier& b) {
    asm volatile("s_waitcnt vmcnt(0)" ::: "memory");
    __syncthreads();
    if (threadIdx.x == 0) {
        unsigned* bar = b.bar;
        __builtin_amdgcn_s_waitcnt(0);
        unsigned nloc = b.st[0], nx = b.st[1];
        if (nloc == 0u) { xcd_barrier_complete(bar, b.x, nloc, nx); b.st[0] = nloc; b.st[1] = nx; }
        const unsigned old = xb_add(&bar[XB_XSUB(b.x)], 1u);
        const unsigned gen = old / nloc;
        if (old + 1u == (gen + 1u) * nloc) {
            __builtin_amdgcn_fence(__ATOMIC_RELEASE, "agent");
            asm volatile("s_waitcnt vmcnt(0)" ::: "memory");
            const unsigned og = xb_add(&bar[XB_TOP], 1u);
            const unsigned tg = og / nx;
            if (og + 1u == (tg + 1u) * nx) xb_add(&bar[XB_TOPGEN], 1u);
            else XB_SPIN(xb_ld(&bar[XB_TOPGEN]) == tg, bar);
            __builtin_amdgcn_fence(__ATOMIC_ACQUIRE, "agent");
            xb_add(&bar[XB_XGEN(b.x)], 1u);
            asm volatile("s_waitcnt vmcnt(0)" ::: "memory");
        } else {
            XB_SPIN(xb_ld(&bar[XB_XGEN(b.x)]) == gen, bar);
            __builtin_amdgcn_fence(__ATOMIC_ACQUIRE, "agent");
            asm volatile("s_waitcnt vmcnt(0)" ::: "memory");
        }
    }
    __syncthreads();
}


__device__ __forceinline__ int win_colmap(int n) {
    if (n < 1024) { const int base = n & ~63, j = n & 63; return base + (j >> 1) + 32 * (j & 1); }
    if (n < 2048) return n;
    if (n < 3072) return 3744 + (n - 2048);
    if (n < 4096) return 2048 + (n - 3072);
    if (n < 4480) return 3072 + (n - 4096);
    if (n < 4736) return 3456 + (n - 4480);
    if (n < 4768) return 3712 + (n - 4736);
    return -1;
}
__device__ __forceinline__ int nope_map(int n, int per_head) {
    const int t = n >> 8, c = n & 255, bj = c >> 7, wc = (c >> 5) & 3, j = c & 31;
    return (4 * t + wc) * per_head + 32 * bj + j;
}
__device__ __forceinline__ int wq_colmap(int n) {
    if (n < 512) return nope_map(n, 96);
    const int c = n - 512, head = c >> 5, j = c & 31; return head * 96 + 64 + (j >> 1) + 16 * (j & 1);
}
__device__ __forceinline__ int wkv_colmap(int n) {
    if (n < 512) return nope_map(n, 192);
    const int c = n - 512, head = c >> 7, dim = c & 127; return head * 192 + 64 + dim;
}

struct EpiIn {
    static constexpr bool PERM = true, MIDSCALE = false;
    bf16* P; const float* cs64;
    __device__ __forceinline__ void operator()(const pg8::f32x4 (&acc)[2][2][4][2], const pg8::Unit& u, int, int, int, int) const {
        EPI_LANES();
        const int row0 = u.pm * 256 + wr * 64 + fr, colt = u.pn * 256, cl = wc * 32 + 8 * fq;
        const int mode = u.pn < 4 ? 1 : ((u.pn >= 8 && u.pn < 16) ? 2 : 0);
        const float rs = u.pn < 2 ? 1.f : 0.125f;
        const int p0 = (wc & 1) * 16 + 4 * fq;
        f32x4 n0 = {1.f, 0.f, 1.f, 0.f}, n1 = {1.f, 0.f, 1.f, 0.f};
        if (mode == 1) { const f32x4* t = (const f32x4*)(cs64 + ((size_t)row0 * 32 + p0) * 2); n0 = t[0]; n1 = t[1]; }
#pragma unroll
        for (int ai = 0; ai < 2; ++ai)
#pragma unroll
            for (int m = 0; m < 4; ++m) {
                const int row = row0 + ai * 128 + m * 16;
                bf16* rowp = P + (size_t)row * PITCH + colt + cl;
                const f32x4 c0 = n0, c1 = n1;
                if (mode == 1 && (ai * 4 + m) < 7) { const int rown = row0 + ((ai * 4 + m + 1) >> 2) * 128 + ((ai * 4 + m + 1) & 3) * 16;
                    const f32x4* t = (const f32x4*)(cs64 + ((size_t)rown * 32 + p0) * 2); n0 = t[0]; n1 = t[1]; }
#pragma unroll
                for (int bj = 0; bj < 2; ++bj) {
                    f32x4 v0 = acc[ai][bj][m][0], v1 = acc[ai][bj][m][1];
                    if (mode == 1) {
                        f32x4 o0, o1;
                        o0[0] = (v0[0] * c0[0] - v0[1] * c0[1]) * rs; o0[1] = (v0[1] * c0[0] + v0[0] * c0[1]) * rs;
                        o0[2] = (v0[2] * c0[2] - v0[3] * c0[3]) * rs; o0[3] = (v0[3] * c0[2] + v0[2] * c0[3]) * rs;
                        o1[0] = (v1[0] * c1[0] - v1[1] * c1[1]) * rs; o1[1] = (v1[1] * c1[0] + v1[0] * c1[1]) * rs;
                        o1[2] = (v1[2] * c1[2] - v1[3] * c1[3]) * rs; o1[3] = (v1[3] * c1[2] + v1[2] * c1[3]) * rs;
                        v0 = o0; v1 = o1;
                    } else if (mode == 2) {
#pragma unroll
                        for (int i = 0; i < 4; ++i) { v0[i] = silu_f(v0[i]); v1[i] = silu_f(v1[i]); }
                    }
                    u32x4 w; w.x = cvtpk(v0[0], v0[1]); w.y = cvtpk(v0[2], v0[3]); w.z = cvtpk(v1[0], v1[1]); w.w = cvtpk(v1[2], v1[3]);
                    *(u32x4*)(rowp + bj * 128) = w;
                }
                asm volatile("" ::: "memory");
            }
    }
};

template <int MODE> struct EpiUp {
    static constexpr bool IS_Q = MODE != 2, MIDSCALE = false;
    static constexpr bool PERM = true;
    bf16* O;
    bf16* Vo;
    const f32x2* stat;
    const float* wn;
    const float* wr_;
    const float* cs32;
    __device__ __forceinline__ void operator()(const pg8::f32x4 (&acc)[2][2][4][2], const pg8::Unit& u, int, int, int, int) const {
        EPI_LANES();
        const int row0 = u.pm * 256 + wr * 64 + fr;
        const int b = row0 / SEQ;
        constexpr int OP = IS_Q ? 128 : 96;
        float ms8[8];
#pragma unroll
        for (int i = 0; i < 8; ++i) { const f32x2 st = stat[row0 + (i >> 2) * 128 + (i & 3) * 16]; ms8[i] = IS_Q ? st.x : st.y; }
        if (MODE == 0 || ((MODE == 2 || MODE == 3) && u.pn < 2)) {
            const int head = 4 * u.pn + wc;
            const f32x4 w00 = *(const f32x4*)(wn + 8 * fq), w01 = *(const f32x4*)(wn + 8 * fq + 4), w10 = *(const f32x4*)(wn + 32 + 8 * fq), w11 = *(const f32x4*)(wn + 36 + 8 * fq);
#pragma unroll
            for (int ai = 0; ai < 2; ++ai)
#pragma unroll
                for (int m = 0; m < 4; ++m) {
                    const int row = row0 + ai * 128 + m * 16;
                    const f32x4 a0 = acc[ai][0][m][0], a1 = acc[ai][0][m][1], b0 = acc[ai][1][m][0], b1 = acc[ai][1][m][1];
                    float ss = 0.f;
#pragma unroll
                    for (int i = 0; i < 4; ++i) ss += a0[i] * a0[i] + a1[i] * a1[i] + b0[i] * b0[i] + b1[i] * b1[i];
                    ss += __shfl_xor(ss, 16); ss += __shfl_xor(ss, 32);
                    const float ms = ms8[ai * 4 + m];
                    const float sc = __builtin_amdgcn_rsqf(ss * (1.f / 64.f) + EPS * (ms + EPS)) * (IS_Q ? QSC : 1.f);
                    bf16* op = O + ((size_t)(b * NH + head) * SEQ + (row - b * SEQ)) * OP;
                    const f32x4 x0 = a0 * sc * w00, x1 = a1 * sc * w01, y0 = b0 * sc * w10, y1 = b1 * sc * w11;
                    u32x4 w; w.x = cvtpk(x0[0], x0[1]); w.y = cvtpk(x0[2], x0[3]); w.z = cvtpk(x1[0], x1[1]); w.w = cvtpk(x1[2], x1[3]);
                    *(u32x4*)(op + 8 * fq) = w;
                    w.x = cvtpk(y0[0], y0[1]); w.y = cvtpk(y0[2], y0[3]); w.z = cvtpk(y1[0], y1[1]); w.w = cvtpk(y1[2], y1[3]);
                    *(u32x4*)(op + 32 + 8 * fq) = w;
                }
        } else if (MODE == 1 || MODE == 3) {
            const f32x4 wl = *(const f32x4*)(wr_ + 4 * fq), wh = *(const f32x4*)(wr_ + 16 + 4 * fq);
            f32x4 n0, n1; { const f32x4* t = (const f32x4*)(cs32 + ((size_t)row0 * 16 + 4 * fq) * 2); n0 = t[0]; n1 = t[1]; }
#pragma unroll
            for (int ai = 0; ai < 2; ++ai)
#pragma unroll
                for (int m = 0; m < 4; ++m) {
                    const int row = row0 + ai * 128 + m * 16;
                    const float epsq = EPS * (ms8[ai * 4 + m] + EPS);
                    const f32x4 c0 = n0, c1 = n1;
                    if ((ai * 4 + m) < 7) { const int rown = row0 + ((ai * 4 + m + 1) >> 2) * 128 + ((ai * 4 + m + 1) & 3) * 16;
                        const f32x4* t = (const f32x4*)(cs32 + ((size_t)rown * 16 + 4 * fq) * 2); n0 = t[0]; n1 = t[1]; }
#pragma unroll
                    for (int bj = 0; bj < 2; ++bj) {
                        const f32x4 v0 = acc[ai][bj][m][0], v1 = acc[ai][bj][m][1];
                        float ss = 0.f;
#pragma unroll
                        for (int i = 0; i < 4; ++i) ss += v0[i] * v0[i] + v1[i] * v1[i];
                        ss += __shfl_xor(ss, 16); ss += __shfl_xor(ss, 32);
                        const float sc = __builtin_amdgcn_rsqf(ss * (1.f / 32.f) + epsq) * QSC;
                        const float x1a = v0[0] * sc * wl[0], x2a = v0[1] * sc * wh[0], x1b = v0[2] * sc * wl[1], x2b = v0[3] * sc * wh[1];
                        const float x1c = v1[0] * sc * wl[2], x2c = v1[1] * sc * wh[2], x1d = v1[2] * sc * wl[3], x2d = v1[3] * sc * wh[3];
                        u32x4 w;
                        w.x = cvtpk(x1a * c0[0] - x2a * c0[1], x2a * c0[0] + x1a * c0[1]);
                        w.y = cvtpk(x1b * c0[2] - x2b * c0[3], x2b * c0[2] + x1b * c0[3]);
                        w.z = cvtpk(x1c * c1[0] - x2c * c1[1], x2c * c1[0] + x1c * c1[1]);
                        w.w = cvtpk(x1d * c1[2] - x2d * c1[3], x2d * c1[2] + x1d * c1[3]);
                        const int head = 4 * bj + wc;
                        bf16* op = O + ((size_t)(b * NH + head) * SEQ + (row - b * SEQ)) * OP;
                        *(u32x4*)(op + 64 + 8 * fq) = w;
                    }
                    asm volatile("" ::: "memory");
                }
        } else {
#pragma unroll
            for (int ai = 0; ai < 2; ++ai)
#pragma unroll
                for (int m = 0; m < 4; ++m) {
                    const int row = row0 + ai * 128 + m * 16;
                    const float sc = __builtin_amdgcn_rsqf(ms8[ai * 4 + m] + EPS);
#pragma unroll
                    for (int bj = 0; bj < 2; ++bj) {
                        const f32x4 v0 = acc[ai][bj][m][0] * sc, v1 = acc[ai][bj][m][1] * sc;
                        const int head = 2 * (u.pn - 2) + bj;
                        bf16* op = Vo + ((size_t)(b * NH + head) * SEQ + (row - b * SEQ)) * 128 + 32 * wc + 8 * fq;
                        u32x4 w; w.x = cvtpk(v0[0], v0[1]); w.y = cvtpk(v0[2], v0[3]); w.z = cvtpk(v1[0], v1[1]); w.w = cvtpk(v1[2], v1[3]);
                        *(u32x4*)op = w;
                    }
                }
        }
    }
};

struct EpiOut {
    static constexpr bool PERM = false, MIDSCALE = true;
    const float* x; float* out; const float* mod; const float* ss;
    __device__ __forceinline__ void mid(pg8::f32x4 (&acc)[2][2][4][2], const pg8::Unit& u) const {
        EPI_LANES(); (void)wc; (void)fq;
        const int row0 = u.pm * 256 + wr * 64 + fr;
#pragma unroll
        for (int ai = 0; ai < 2; ++ai)
#pragma unroll
            for (int m = 0; m < 4; ++m) {
                const f32x4* sp = (const f32x4*)(ss + (size_t)(row0 + ai * 128 + m * 16) * 8);
                const f32x4 s0 = sp[0], s1 = sp[1];
                const float rstd = __builtin_amdgcn_rsqf(((s0[0] + s0[1]) + (s0[2] + s0[3]) + (s1[0] + s1[1]) + (s1[2] + s1[3])) * (1.f / 1024.f) + EPS);
#pragma unroll
                for (int bj = 0; bj < 2; ++bj)
#pragma unroll
                    for (int n = 0; n < 2; ++n) acc[ai][bj][m][n] *= rstd;
            }
    }
    __device__ __forceinline__ void operator()(const pg8::f32x4 (&acc)[2][2][4][2], const pg8::Unit& u, int, int, int, int) const {
        EPI_LANES();
        const int row0 = u.pm * 256 + wr * 64 + fr, b = row0 / SEQ;
        const int col0 = u.pn * 256 + wc * 32 + 4 * fq;
        f32x4 gv[2][2];
#pragma unroll
        for (int bj = 0; bj < 2; ++bj)
#pragma unroll
            for (int n = 0; n < 2; ++n) gv[bj][n] = *(const f32x4*)(mod + b * 3072 + 2048 + col0 + bj * 128 + n * 16);
#pragma unroll
        for (int ai = 0; ai < 2; ++ai)
#pragma unroll
            for (int m = 0; m < 4; ++m) {
                const size_t off = (size_t)(row0 + ai * 128 + m * 16) * DM + col0;
#pragma unroll
                for (int bj = 0; bj < 2; ++bj)
#pragma unroll
                    for (int n = 0; n < 2; ++n) {
                        const f32x4 xv = *(const f32x4*)(x + off + bj * 128 + n * 16);
                        *(f32x4*)(out + off + bj * 128 + n * 16) = xv + gv[bj][n] * acc[ai][bj][m][n];
                    }
            }
    }
};

#define KSWZ(row, colB) ((row) * 256 + ((colB) ^ (((row) & 7) << 4)))
#define SBAR() __builtin_amdgcn_sched_barrier(0)
constexpr int KVBLK = 64;
constexpr size_t SHM_V = KVBLK * 128 * 2, SHM_K = KVBLK * 128 * 2;
constexpr float ATT_SCALE = 0.10206207261596575f;
constexpr float THR = 8.f;
__device__ __forceinline__ f32x16 zero16() { float z; asm volatile("v_mov_b32 %0, 0" : "=v"(z)); f32x16 r;
#pragma unroll
    for (int i = 0; i < 16; ++i) r[i] = z;
    return r; }
__device__ __forceinline__ int crow(int r, int hi) { return (r & 3) + 8 * (r >> 2) + 4 * hi; }
__device__ __forceinline__ int v_st(int k, int c) { const int kk = (k & ~0xC) | ((k & 4) << 1) | ((k & 8) >> 1); return ((kk >> 3) * 4 + (c >> 5)) * 512 + ((kk & 7) * 32 + (c & 31)) * 2; }
__device__ __forceinline__ int v_st_raw(int k, int c) { return ((k >> 3) * 4 + (c >> 5)) * 512 + ((k & 7) * 32 + (c & 31)) * 2; }
__device__ __forceinline__ int v_rd_base(int lane) { return ((lane & 3) << 3) | (((lane >> 2) & 3) << 6) | (((lane >> 4) & 1) << 5) | (((lane >> 5) & 1) << 8); }
constexpr int v_rd_off(int d0, int ks, int half) { return d0 * 512 + ks * 4096 + half * 2048; }
template <int OFF> __device__ __forceinline__ s16x4 tr_read(int vb) {
    s16x4 r; asm volatile("ds_read_b64_tr_b16 %0, %1 offset:%2" : "=&v"(r) : "v"(vb), "i"(OFF) : "memory"); return r;
}
#define PKF(L, H) (bf16x8){L[0], L[1], L[2], L[3], H[0], H[1], H[2], H[3]}
template <int D0> __device__ __forceinline__ void pv_one(f32x16& od, int vb, bf16x8 pa0, bf16x8 pa1, bf16x8 pa2, bf16x8 pa3) {
    const s16x4 l0 = tr_read<v_rd_off(D0, 0, 0)>(vb), h0 = tr_read<v_rd_off(D0, 0, 1)>(vb), l1 = tr_read<v_rd_off(D0, 1, 0)>(vb), h1 = tr_read<v_rd_off(D0, 1, 1)>(vb);
    const s16x4 l2 = tr_read<v_rd_off(D0, 2, 0)>(vb), h2 = tr_read<v_rd_off(D0, 2, 1)>(vb), l3 = tr_read<v_rd_off(D0, 3, 0)>(vb), h3 = tr_read<v_rd_off(D0, 3, 1)>(vb);
    asm volatile("s_waitcnt lgkmcnt(0)" ::: "memory"); SBAR();
    od = __builtin_amdgcn_mfma_f32_32x32x16_bf16(pa0, PKF(l0, h0), od, 0, 0, 0);
    od = __builtin_amdgcn_mfma_f32_32x32x16_bf16(pa1, PKF(l1, h1), od, 0, 0, 0);
    od = __builtin_amdgcn_mfma_f32_32x32x16_bf16(pa2, PKF(l2, h2), od, 0, 0, 0);
    od = __builtin_amdgcn_mfma_f32_32x32x16_bf16(pa3, PKF(l3, h3), od, 0, 0, 0);
}
__device__ __forceinline__ void pv_d0(f32x16* o, int vb, bf16x8 pa0, bf16x8 pa1, bf16x8 pa2, bf16x8 pa3) {
    pv_one<0>(o[0], vb, pa0, pa1, pa2, pa3); pv_one<1>(o[1], vb, pa0, pa1, pa2, pa3); pv_one<2>(o[2], vb, pa0, pa1, pa2, pa3); pv_one<3>(o[3], vb, pa0, pa1, pa2, pa3);
}
#define PK4(P, BASE, OUT) do { u32x4 w = {cvtpk(P[BASE + 0], P[BASE + 1]), cvtpk(P[BASE + 2], P[BASE + 3]), cvtpk(P[BASE + 4], P[BASE + 5]), cvtpk(P[BASE + 6], P[BASE + 7])}; \
    OUT = *reinterpret_cast<bf16x8*>(&w); } while (0)

__device__ __forceinline__ void partialSM(f32x16& p0, f32x16& p1) {
    (void)p1;
#pragma unroll
    for (int r = 0; r < 16; ++r) p0[r] = __builtin_amdgcn_exp2f(p0[r]);
}
__device__ __forceinline__ void finishSM(f32x16& p0, f32x16& p1, float& l_reg, bf16x8& pa0, bf16x8& pa1, bf16x8& pa2, bf16x8& pa3) {
#pragma unroll
    for (int r = 0; r < 16; ++r) p1[r] = __builtin_amdgcn_exp2f(p1[r]);
    float ps = 0;
#pragma unroll
    for (int r = 0; r < 16; ++r) ps += p0[r];
#pragma unroll
    for (int r = 0; r < 16; ++r) ps += p1[r];
    { auto rr = __builtin_amdgcn_permlane32_swap(__float_as_uint(ps), __float_as_uint(ps), false, false);
      ps = __uint_as_float(rr[0]) + __uint_as_float(rr[1]); }
    l_reg += ps;
    PK4(p0, 0, pa0); PK4(p0, 8, pa1); PK4(p1, 0, pa2); PK4(p1, 8, pa3);
}
__device__ __forceinline__ void qkt6(f32x16& p0, f32x16& p1, const char* Ks, const bf16x8* qr, int r32, int hi) {
    asm volatile("" : "+v"(r32));
    p0 = f32x16{}; p1 = f32x16{};
#pragma unroll
    for (int d0 = 0; d0 < 6; ++d0) { const int cb = (d0 * 16 + hi * 8) * 2;
        const bf16x8 b0 = *reinterpret_cast<const bf16x8*>(Ks + KSWZ(r32, cb));
        const bf16x8 b1 = *reinterpret_cast<const bf16x8*>(Ks + KSWZ(32 + r32, cb));
        p0 = __builtin_amdgcn_mfma_f32_32x32x16_bf16(b0, qr[d0], p0, 0, 0, 0);
        p1 = __builtin_amdgcn_mfma_f32_32x32x16_bf16(b1, qr[d0], p1, 0, 0, 0);
        asm volatile("" :: "v"(b0), "v"(b1), "v"(qr[d0])); }
}

__device__ __forceinline__ void attn_unit(bf16* __restrict__ QOb, const bf16* __restrict__ Kh, const bf16* __restrict__ Vh, int seq, char* lds,
                                          bf16* __restrict__ mgb  , float* __restrict__ ssb  , const float* __restrict__ wnh  ) {
    constexpr int LDQ = 128, LDKK = 96, LDV = 128;
    int tid_ = threadIdx.x; asm volatile("" : "+v"(tid_));
    const int tid = tid_, wid = tid >> 6, lane = tid & 63, r32 = lane & 31, hi = lane >> 5;
    char* V_lds = lds; char* K_lds = lds + 3 * SHM_V;
    float* ws = (float*)(lds + 3 * SHM_V + 3 * SHM_K) + wid * 64; float* li_l = ws;
    float l_reg = 0; f32x16 o[4] = {}; bf16x8 qr[6];
    const bf16* Qw = QOb + (long)(wid * 32 + r32) * LDQ + hi * 8;
#pragma unroll
    for (int d0 = 0; d0 < 6; ++d0) qr[d0] = *reinterpret_cast<const bf16x8*>(Qw + d0 * 16);
    const int sr = tid >> 4, sc = (tid & 15) * 8, vst0 = v_st_raw(sr, sc), vst1 = v_st_raw(32 + sr, sc);
    const int sck = sc < 96 ? sc : 88;
    const int vb0 = (int)(uintptr_t)V_lds + v_rd_base(lane);
    struct { bf16x8 vs0, vs1, ks0, ks1; } sr_[2];
    const char* Vhb = (const char*)Vh; const char* Khb = (const char*)Kh;
    const unsigned voV = (unsigned)(sr * LDV + sc) * 2u, voK = (unsigned)(sr * LDKK + sck) * 2u;
#define SLOAD(i, k0) do { const char* vt_ = Vhb + (size_t)(k0) * (LDV * 2); const char* kt_ = Khb + (size_t)(k0) * (LDKK * 2); \
    sr_[i].vs0 = *(const bf16x8*)(vt_ + voV); sr_[i].vs1 = *(const bf16x8*)(vt_ + 32 * LDV * 2 + voV); \
    sr_[i].ks0 = *(const bf16x8*)(kt_ + voK); sr_[i].ks1 = *(const bf16x8*)(kt_ + 32 * LDKK * 2 + voK); } while (0)
#define SWRITE(b, i) do {   *(bf16x8*)(V_lds + (b) * SHM_V + vst0) = sr_[i].vs0; *(bf16x8*)(V_lds + (b) * SHM_V + vst1) = sr_[i].vs1; const int kc = sc * 2; \
    *(bf16x8*)(K_lds + (b) * SHM_K + KSWZ(sr, kc)) = sr_[i].ks0; *(bf16x8*)(K_lds + (b) * SHM_K + KSWZ(32 + sr, kc)) = sr_[i].ks1; } while (0)
#define SWAIT() asm volatile("s_waitcnt vmcnt(4)" ::: "memory")
    f32x16 pA0, pA1, pB0, pB1; bf16x8 pa0, pa1, pa2, pa3; const int NT = seq / KVBLK;
    constexpr int SE = 0, SO = 1;
#define ASTEP(PC0, PC1, PP0, PP1, KS, VS, WS, RW, RL, LT, LCOND) do { \
        SBAR(); qkt6(PC0, PC1, K_lds + (KS) * SHM_K, qr, r32, hi); \
        finishSM(PP0, PP1, l_reg, pa0, pa1, pa2, pa3); SBAR(); \
        if (LCOND) SLOAD(RL, (LT) * KVBLK); SBAR(); \
        pv_d0(o, vb0 + (VS) * (int)SHM_V, pa0, pa1, pa2, pa3); partialSM(PC0, PC1); \
        SWRITE(WS, RW); __syncthreads(); } while (0)
    SLOAD(0, 0); SLOAD(1, KVBLK);
    SWRITE(0, 0); __syncthreads();
    SLOAD(0, 2 * KVBLK);
    qkt6(pA0, pA1, K_lds, qr, r32, hi); partialSM(pA0, pA1);
    SWRITE(1, 1); __syncthreads();
    for (int j = 1; j + 5 < NT; j += 6) {
        ASTEP(pB0, pB1, pA0, pA1, 1, 0, 2, 0, 1, j + 2, true);
        ASTEP(pA0, pA1, pB0, pB1, 2, 1, 0, 1, 0, j + 3, true);
        ASTEP(pB0, pB1, pA0, pA1, 0, 2, 1, 0, 1, j + 4, true);
        ASTEP(pA0, pA1, pB0, pB1, 1, 0, 2, 1, 0, j + 5, true);
        ASTEP(pB0, pB1, pA0, pA1, 2, 1, 0, 0, 1, j + 6, true);
        ASTEP(pA0, pA1, pB0, pB1, 0, 2, 1, 1, 0, j + 7, j + 7 < NT);
    }
    SBAR(); qkt6(pB0, pB1, K_lds + 1 * SHM_K, qr, r32, hi);
    finishSM(pA0, pA1, l_reg, pa0, pa1, pa2, pa3); SBAR();
    pv_d0(o, vb0 + 0 * (int)SHM_V, pa0, pa1, pa2, pa3); partialSM(pB0, pB1);
    finishSM(pB0, pB1, l_reg, pa0, pa1, pa2, pa3); SBAR();
    pv_d0(o, vb0 + 1 * (int)SHM_V, pa0, pa1, pa2, pa3);
    __syncthreads();
#undef ASTEP
    { const int t2_ = fresh_tid(), wid = t2_ >> 6, lane = t2_ & 63, r32 = lane & 31, hi = lane >> 5;
      float* li_l = (float*)(lds + 3 * SHM_V + 3 * SHM_K) + wid * 64;
      char* stg = lds + wid * 8192;
      if (hi == 0) li_l[r32] = l_reg; asm volatile("s_waitcnt lgkmcnt(0)" ::: "memory");
      float wv[4];
#pragma unroll
      for (int d0 = 0; d0 < 4; ++d0) wv[d0] = wnh[d0 * 32 + r32];
#pragma unroll
      for (int r = 0; r < 16; ++r) { const int orow = crow(r, hi); const float rl = __builtin_amdgcn_rcpf(li_l[orow]);
          const float a0 = o[0][r] * rl, a1 = o[1][r] * rl, a2 = o[2][r] * rl, a3 = o[3][r] * rl;
          float sq = (a0 * a0 + a1 * a1) + (a2 * a2 + a3 * a3);
#pragma unroll
          for (int ofs = 1; ofs < 32; ofs <<= 1) sq += __shfl_xor(sq, ofs);
          if (r32 == 0) ssb[(size_t)(wid * 32 + orow) * 8] = sq;
          bf16* sp = (bf16*)(stg + orow * 256) + r32;
          sp[0] = (bf16)(cvtpk(a0 * wv[0], 0.f) & 0xffffu); sp[32] = (bf16)(cvtpk(a1 * wv[1], 0.f) & 0xffffu);
          sp[64] = (bf16)(cvtpk(a2 * wv[2], 0.f) & 0xffffu); sp[96] = (bf16)(cvtpk(a3 * wv[3], 0.f) & 0xffffu); }
      const char* gbase = (const char*)(mgb + (size_t)(wid * 32) * PITCH);
      const unsigned goff = (unsigned)((lane >> 4) * PITCH + (lane & 15) * 8) * 2u;
      u32x4 gv[8];
#pragma unroll
      for (int k = 0; k < 8; ++k) gv[k] = *(const u32x4*)(gbase + (size_t)k * (4 * PITCH * 2) + goff);
#pragma unroll
      for (int k = 0; k < 8; ++k) {
          const u32x4 nv = *(const u32x4*)(stg + (4 * k + (lane >> 4)) * 256 + (lane & 15) * 16);
          u32x4 ov;
#pragma unroll
          for (int q = 0; q < 4; ++q) ov[q] = cvtpk(bf_lo(nv[q]) * bf_lo(gv[k][q]), bf_hi(nv[q]) * bf_hi(gv[k][q]));
          *(u32x4*)((char*)gbase + (size_t)k * (4 * PITCH * 2) + goff) = ov;
      } }
#undef SLOAD
#undef SWRITE
#undef SWAIT
}

__device__ __forceinline__ const char* uptr(const char* p) { const unsigned long long a = (unsigned long long)p;
    const unsigned lo = __builtin_amdgcn_readfirstlane((unsigned)a), hi = __builtin_amdgcn_readfirstlane((unsigned)(a >> 32));
    return (const char*)(((unsigned long long)hi << 32) | lo); }

__device__ __forceinline__ void ret_state_phase(const bf16* __restrict__ proj, bf16* __restrict__ kvs, const float* __restrict__ dl_f, const float* __restrict__ dl_b, int bid, int G, char* lds) {
    const int tid = fresh_tid(), wid = tid >> 6, lane = tid & 63, r32 = lane & 31, hi = lane >> 5;
    char* KX = lds;
    char* VT = lds + 32768;
    const unsigned koff = (unsigned)((tid >> 3) * PITCH + (tid & 7) * 8) * 2u, voff = (unsigned)((tid >> 4) * PITCH + (tid & 15) * 8) * 2u;
    const int rb = wid & 3, cg2 = wid >> 2;
    const int kb = (int)(uintptr_t)KX + v_rd_base(lane) + rb * 512;
    const int vb = (int)(uintptr_t)VT + v_rd_base(lane) + cg2 * 1024;
    u32x4 kreg[2], vreg[4];
#define RS_LOAD(U) do { const int bh_ = (U) >> 6, c_ = (U) & 63, b_ = bh_ >> 3, h_ = bh_ & 7; const size_t row0_ = (size_t)b_ * SEQ + (size_t)c_ * 128; \
        const char* kbase_ = (const char*)(proj + row0_ * PITCH + C_RK + h_ * 64); const char* vbase_ = (const char*)(proj + row0_ * PITCH + C_RV + h_ * 128); \
        _Pragma("unroll") for (int i = 0; i < 2; ++i) kreg[i] = *(const u32x4*)(uptr(kbase_ + (size_t)i * (64 * PITCH * 2)) + koff); \
        _Pragma("unroll") for (int i = 0; i < 4; ++i) vreg[i] = *(const u32x4*)(uptr(vbase_ + (size_t)i * (32 * PITCH * 2)) + voff); } while (0)
    int u = bid;
    if (u < BATCH * NH * 64) RS_LOAD(u);
    for (; u < BATCH * NH * 64; u += G) {
        const int bh = u >> 6, c = u & 63, h = bh & 7;
        const float lgf2 = -log1pf(expf(-dl_f[h])) * LOG2E, lgb2 = -log1pf(expf(-dl_b[h])) * LOG2E;
#pragma unroll
        for (int i = 0; i < 2; ++i) {
            const int key = (tid >> 3) + 64 * i, ch = tid & 7;
            const float df = __builtin_amdgcn_exp2f(lgf2 * (float)(127 - key)), db = __builtin_amdgcn_exp2f(lgb2 * (float)key);
            u32x4 wf, wb;
#pragma unroll
            for (int q = 0; q < 4; ++q) { const float x = bf_lo(kreg[i][q]), y = bf_hi(kreg[i][q]); wf[q] = cvtpk(x * df, y * df); wb[q] = cvtpk(x * db, y * db); }
            char* t = KX + (key >> 6) * 16384;
            *(u32x4*)(t + v_st(key & 63, ch * 8)) = wf;
            *(u32x4*)(t + v_st(key & 63, 64 + ch * 8)) = wb;
        }
#pragma unroll
        for (int i = 0; i < 4; ++i) {
            const int key = (tid >> 4) + 32 * i, ch = tid & 15;
            *(u32x4*)(VT + (key >> 6) * 16384 + v_st(key & 63, ch * 8)) = vreg[i];
        }
        __syncthreads();
        if (u + G < BATCH * NH * 64) RS_LOAD(u + G);
        f32x16 acc0 = {}, acc1 = {};
#define RS_STEP(T, KS) do { \
        const s16x4 al = tr_read<(T) * 16384 + (KS) * 4096>(kb), ah = tr_read<(T) * 16384 + (KS) * 4096 + 2048>(kb); \
        const s16x4 bl0 = tr_read<(T) * 16384 + (KS) * 4096>(vb), bh0 = tr_read<(T) * 16384 + (KS) * 4096 + 2048>(vb); \
        const s16x4 bl1 = tr_read<(T) * 16384 + (KS) * 4096 + 512>(vb), bh1 = tr_read<(T) * 16384 + (KS) * 4096 + 2048 + 512>(vb); \
        asm volatile("s_waitcnt lgkmcnt(0)" ::: "memory"); SBAR(); \
        acc0 = __builtin_amdgcn_mfma_f32_32x32x16_bf16(PKF(al, ah), PKF(bl0, bh0), acc0, 0, 0, 0); \
        acc1 = __builtin_amdgcn_mfma_f32_32x32x16_bf16(PKF(al, ah), PKF(bl1, bh1), acc1, 0, 0, 0); } while (0)
        RS_STEP(0, 0); RS_STEP(0, 1); RS_STEP(0, 2); RS_STEP(0, 3); RS_STEP(1, 0); RS_STEP(1, 1); RS_STEP(1, 2); RS_STEP(1, 3);
#undef RS_STEP
        const int dir = rb >> 1;
        bf16* op = kvs + (((size_t)(bh * 64 + c) * 2 + dir) * 64) * 128;
#pragma unroll
        for (int r = 0; r < 16; ++r) { const int dk = 32 * (rb & 1) + crow(r, hi);
            op[dk * 128 + (2 * cg2) * 32 + r32] = (bf16)(cvtpk(acc0[r], 0.f) & 0xffffu);
            op[dk * 128 + (2 * cg2 + 1) * 32 + r32] = (bf16)(cvtpk(acc1[r], 0.f) & 0xffffu); }
        __syncthreads();
    }
#undef RS_LOAD
}

__device__ __forceinline__ void ret_main_phase(bf16* __restrict__ proj, const bf16* __restrict__ kvs, const float* __restrict__ gnw, const float* __restrict__ dl_f, const float* __restrict__ dl_b, int bid, int G, char* lds) {
    const int tid = fresh_tid(), wid = tid >> 6, lane = tid & 63, r32 = lane & 31, hi = lane >> 5;
    char* KT = lds;
    char* VT = lds + 32768;
    const unsigned koff = (unsigned)((tid >> 3) * PITCH + (tid & 7) * 8) * 2u, voff = (unsigned)((tid >> 4) * PITCH + (tid & 15) * 8) * 2u;
    const int c = wid >> 2, iloc = 32 * (wid & 3) + r32;
    const unsigned qoff = (unsigned)((128 * c + iloc) * PITCH + hi * 8) * 2u;
    const int vb0 = (int)(uintptr_t)VT + v_rd_base(lane);
    u32x4 kreg[4], vreg[8]; bf16x8 qr[4];
#define RM_LOAD(U) do { const int bh_ = (U) >> 5, cp_ = (U) & 31, b_ = bh_ >> 3, h_ = bh_ & 7; const size_t row0_ = (size_t)b_ * SEQ + (size_t)cp_ * 256; \
        const char* kbase_ = (const char*)(proj + row0_ * PITCH + C_RK + h_ * 64); const char* vbase_ = (const char*)(proj + row0_ * PITCH + C_RV + h_ * 128); \
        const char* qbase_ = (const char*)(proj + row0_ * PITCH + C_RQ + h_ * 64); \
        _Pragma("unroll") for (int i = 0; i < 4; ++i) kreg[i] = *(const u32x4*)(uptr(kbase_ + (size_t)i * (64 * PITCH * 2)) + koff); \
        _Pragma("unroll") for (int i = 0; i < 8; ++i) vreg[i] = *(const u32x4*)(uptr(vbase_ + (size_t)i * (32 * PITCH * 2)) + voff); \
        _Pragma("unroll") for (int d0 = 0; d0 < 4; ++d0) qr[d0] = *(const bf16x8*)(uptr(qbase_ + d0 * 32) + qoff); } while (0)
    int u = bid;
    if (u < 1024) RM_LOAD(u);
    for (; u < 1024; u += G) {
        const int bh = u >> 5, cp = u & 31, b = bh >> 3, h = bh & 7;
        const float lgf2 = -log1pf(expf(-dl_f[h])) * LOG2E, lgb2 = -log1pf(expf(-dl_b[h])) * LOG2E;
        const size_t row0 = (size_t)b * SEQ + (size_t)cp * 256;
        int iloc_l = iloc, hi_l = hi; asm volatile("" : "+v"(iloc_l), "+v"(hi_l));
#pragma unroll
        for (int i = 0; i < 4; ++i) { const int key = (tid >> 3) + 64 * i, ch = tid & 7; *(u32x4*)(KT + key * 128 + ((ch ^ (key & 7)) << 4)) = kreg[i]; }
#pragma unroll
        for (int i = 0; i < 8; ++i) { const int key = (tid >> 4) + 32 * i, ch = tid & 15; *(u32x4*)(VT + (key >> 6) * 16384 + v_st_raw(key & 63, ch * 8)) = vreg[i]; }
        __syncthreads();
        u32x4 sreg[8];
        { const char* sbase = (const char*)(kvs + (size_t)(bh * 64 + 2 * cp) * (128 * 128));
#pragma unroll
          for (int i = 0; i < 8; ++i) sreg[i] = *(const u32x4*)(uptr(sbase + (size_t)i * 8192) + (unsigned)tid * 16u); }
        f32x16 o[4] = {};
#pragma unroll
        for (int kt = 0; kt < 2; ++kt) {
            const int T = 2 * c + kt;
            f32x16 p0 = {}, p1 = {};
#pragma unroll
            for (int d0 = 0; d0 < 4; ++d0) { const int ch = d0 * 2 + hi; const int k0 = T * 64 + r32, k1 = k0 + 32;
                const bf16x8 b0 = *(const bf16x8*)(KT + k0 * 128 + ((ch ^ (k0 & 7)) << 4));
                const bf16x8 b1 = *(const bf16x8*)(KT + k1 * 128 + ((ch ^ (k1 & 7)) << 4));
                p0 = __builtin_amdgcn_mfma_f32_32x32x16_bf16(b0, qr[d0], p0, 0, 0, 0);
                p1 = __builtin_amdgcn_mfma_f32_32x32x16_bf16(b1, qr[d0], p1, 0, 0, 0); }
#pragma unroll
            for (int r = 0; r < 16; ++r) {
                const int j0 = 64 * kt + crow(r, hi_l), d0_ = iloc_l - j0, d1_ = d0_ - 32;
                const float e0 = (d0_ >= 0 ? lgf2 : -lgb2) * (float)d0_;
                const float e1 = (d1_ >= 0 ? lgf2 : -lgb2) * (float)d1_;
                p0[r] *= __builtin_amdgcn_exp2f(e0); p1[r] *= __builtin_amdgcn_exp2f(e1);
            }
            bf16x8 pa0, pa1, pa2, pa3;
            PK4(p0, 0, pa0); PK4(p0, 8, pa1); PK4(p1, 0, pa2); PK4(p1, 8, pa3);
            pv_d0(o, vb0 + T * 16384, pa0, pa1, pa2, pa3);
        }
        __syncthreads();
#pragma unroll
        for (int i = 0; i < 8; ++i) { const int trow = (tid >> 4) + 32 * i, ch = tid & 15, tile = trow >> 6, dk = trow & 63;
            *(u32x4*)(VT + tile * 16384 + v_st(dk, ch * 8)) = sreg[i]; }
        __syncthreads();
#pragma unroll
        for (int dir = 0; dir < 2; ++dir) {
            const float dec = dir == 0 ? __builtin_amdgcn_exp2f(lgf2 * (float)(iloc_l + 1)) : __builtin_amdgcn_exp2f(lgb2 * (float)(128 - iloc_l));
            bf16x8 pa[4];
#pragma unroll
            for (int k = 0; k < 4; ++k) { const u32x4 w = *reinterpret_cast<const u32x4*>(&qr[k]); u32x4 o4;
#pragma unroll
                for (int q = 0; q < 4; ++q) o4[q] = cvtpk(bf_lo(w[q]) * dec, bf_hi(w[q]) * dec);
                pa[k] = *reinterpret_cast<bf16x8*>(&o4); }
            pv_d0(o, vb0 + (2 * c + dir) * 16384, pa[0], pa[1], pa[2], pa[3]);
        }
        if (u + G < 1024) RM_LOAD(u + G);
        __syncthreads();
        char* stg = VT + wid * 8192;
        float gw[4];
#pragma unroll
        for (int d0 = 0; d0 < 4; ++d0) gw[d0] = gnw[h * 128 + d0 * 32 + r32];
#pragma unroll
        for (int r = 0; r < 16; ++r) {
            float s1 = (o[0][r] + o[1][r]) + (o[2][r] + o[3][r]);
            float s2 = (o[0][r] * o[0][r] + o[1][r] * o[1][r]) + (o[2][r] * o[2][r] + o[3][r] * o[3][r]);
#pragma unroll
            for (int ofs = 1; ofs < 32; ofs <<= 1) { s1 += __shfl_xor(s1, ofs); s2 += __shfl_xor(s2, ofs); }
            const float mu = s1 * (1.f / 128.f), var = fmaxf(s2 * (1.f / 128.f) - mu * mu, 0.f), rs = __builtin_amdgcn_rsqf(var + EPS);
            bf16* sp = (bf16*)(stg + crow(r, hi_l) * 256) + r32;
#pragma unroll
            for (int d0 = 0; d0 < 4; ++d0) sp[d0 * 32] = (bf16)(cvtpk((o[d0][r] - mu) * rs * gw[d0], 0.f) & 0xffffu);
        }
        { const char* gbase = (const char*)(proj + (row0 + 128 * c + 32 * (wid & 3)) * PITCH + C_RG + h * 128);
          const unsigned goff = (unsigned)((lane >> 4) * PITCH + (lane & 15) * 8) * 2u;
          u32x4 gv[8];
#pragma unroll
          for (int k = 0; k < 8; ++k) gv[k] = *(const u32x4*)(uptr(gbase + (size_t)k * (4 * PITCH * 2)) + goff);
#pragma unroll
          for (int k = 0; k < 8; ++k) {
              const u32x4 nv = *(const u32x4*)(stg + (4 * k + (lane >> 4)) * 256 + (lane & 15) * 16);
              u32x4 ov;
#pragma unroll
              for (int q = 0; q < 4; ++q) ov[q] = cvtpk(bf_lo(nv[q]) * bf_lo(gv[k][q]), bf_hi(nv[q]) * bf_hi(gv[k][q]));
              *(u32x4*)((char*)uptr(gbase + (size_t)k * (4 * PITCH * 2)) + goff) = ov;
          } }
        __syncthreads();
    }
#undef RM_LOAD
}

__global__ void __launch_bounds__(NTHREADS) fwd_megakernel(Params p) {
    extern __shared__ __attribute__((aligned(16))) unsigned char lds[];
    cg::grid_group grid = cg::this_grid();
    const int G = gridDim.x, bid = blockIdx.x;
    const int NGW = G * NWAVES; const long NGT = (long)G * NTHREADS;
#define PHASE_IDS() const int tid = fresh_tid(), lane = tid & 63, wave = tid >> 6, gw = bid * NWAVES + wave; const long gt = (long)bid * NTHREADS + tid; (void)lane; (void)gw; (void)gt
    unsigned char* ws = p.ws;
    const float* x = p.in[0]; const float* cvec = p.in[1]; const int* positions = (const int*)p.in[2];
    const float* norm_w = p.in[3]; const float* w_ada = p.in[4]; const float* b_ada = p.in[5]; const float* w_in = p.in[6];
    const float* dl_f = p.in[7]; const float* dl_b = p.in[8]; const float* gn_w = p.in[9];
    const float* q_norm_w = p.in[10]; const float* w_uq = p.in[11]; const float* kv_norm_w = p.in[12]; const float* w_ukv = p.in[13];
    const float* qn_nope_w = p.in[14]; const float* qn_rope_w = p.in[15]; const float* kn_nope_w = p.in[16]; const float* kn_rope_w = p.in[17];
    const float* mla_norm_w = p.in[18]; const float* w_out = p.in[19];
    bf16* PROJ = (bf16*)(ws + WS_PROJ); bf16* KB = (bf16*)(ws + WS_K); bf16* VB = (bf16*)(ws + WS_V);
    bf16* WIN = (bf16*)(ws + WS_WIN); bf16* WQ = (bf16*)(ws + WS_WQ); bf16* WKV = (bf16*)(ws + WS_WKV); bf16* WO = (bf16*)(ws + WS_WO);
    float* CS64 = (float*)(ws + WS_CS64); float* CS32 = (float*)(ws + WS_CS32); float* MOD = (float*)(ws + WS_MOD); f32x2* STAT = (f32x2*)(ws + WS_STAT);
    float* SSB = (float*)(ws + WS_SS);
    bf16* HB = (bf16*)p.out; bf16* QO = (bf16*)((unsigned char*)p.out + OUT_QO); bf16* KVS = (bf16*)((unsigned char*)p.out + OUT_KVS);

    if (threadIdx.x < 4) ((volatile LAS unsigned*)((LAS unsigned char*)lds + LDS_CTL_OFF))[threadIdx.x] = 0u;
    __syncthreads();
    const XcdBarrier xbar = xcd_barrier_post((unsigned*)(ws + WS_BAR), (volatile LAS unsigned*)((LAS unsigned char*)lds + LDS_CTL_OFF));
#define GRID_BAR() xcd_barrier(xbar)
    {
        PHASE_IDS();
        float* sc = (float*)lds; float* red = (float*)(lds + 16384);
        for (int it = bid; it < 192; it += G) {
            for (int i = tid; i < 4096; i += NTHREADS) sc[i] = silu_f(cvec[i]);
            __syncthreads();
            const int ks4 = lane >> 4, col = lane & 15, kb0 = wave * 128 + ks4 * 32;
            const float* wp = w_ada + (size_t)kb0 * 3072 + it * 16 + col;
            float a0 = 0.f, a1 = 0.f, a2 = 0.f, a3 = 0.f;
#pragma unroll 8
            for (int i = 0; i < 32; ++i) { const float wv = wp[(size_t)i * 3072]; const int k = kb0 + i;
                a0 += sc[k] * wv; a1 += sc[1024 + k] * wv; a2 += sc[2048 + k] * wv; a3 += sc[3072 + k] * wv; }
            a0 += __shfl_xor(a0, 16); a0 += __shfl_xor(a0, 32); a1 += __shfl_xor(a1, 16); a1 += __shfl_xor(a1, 32);
            a2 += __shfl_xor(a2, 16); a2 += __shfl_xor(a2, 32); a3 += __shfl_xor(a3, 16); a3 += __shfl_xor(a3, 32);
            if (lane < 16) { red[(wave * 4 + 0) * 16 + lane] = a0; red[(wave * 4 + 1) * 16 + lane] = a1; red[(wave * 4 + 2) * 16 + lane] = a2; red[(wave * 4 + 3) * 16 + lane] = a3; }
            __syncthreads();
            if (tid < 64) { const int bb = tid >> 4, l = tid & 15; float s = b_ada[it * 16 + l];
#pragma unroll
                for (int w = 0; w < 8; ++w) s += red[(w * 4 + bb) * 16 + l];
                MOD[bb * 3072 + it * 16 + l] = s; }
            __syncthreads();
        }
    }
    if (p.ws == nullptr) grid.sync();
    GRID_BAR();
#if PROBE_DUP == 4
    for (int rep_ = 0; rep_ < 2; ++rep_)
#endif
    {
    {
        PHASE_IDS();
        constexpr int I1 = 4864 * 128, I2 = 768 * 48, I3 = 1536 * 32, I4 = 1024 * 256;
        for (int it = (int)gt; it < I1 + I2 + I3 + I4; it += (int)NGT) {
            int r = it; const float* W; const float* ksc = nullptr; int n, kc, Kd, No, oc; bf16* WT;
            if (r < I1) { n = (int)(r % 4864); kc = (int)(r / 4864); W = w_in; Kd = 1024; No = D_IN; oc = win_colmap(n); WT = WIN; }
            else if ((r -= I1) < I2) { n = (int)(r % 768); kc = (int)(r / 768); W = w_uq; Kd = 384; No = 768; oc = wq_colmap(n); WT = WQ; ksc = q_norm_w; }
            else if ((r -= I2) < I3) { n = (int)(r % 1536); kc = (int)(r / 1536); W = w_ukv; Kd = 256; No = 1536; oc = wkv_colmap(n); WT = WKV; ksc = kv_norm_w; }
            else { r -= I3; n = (int)(r % 1024); kc = (int)(r / 1024); W = w_out; Kd = 2048; No = 1024; oc = n; WT = WO; }
            float v[8];
#pragma unroll
            for (int i = 0; i < 8; ++i) { const int k = kc * 8 + i; const int ks_ = (W == w_out) ? (k < 1024 ? k + 1024 : k - 1024) : k;
                float t = oc >= 0 ? W[(size_t)ks_ * No + oc] : 0.f; if (ksc) t *= ksc[k]; v[i] = t; }
            u32x4 w; w.x = cvtpk(v[0], v[1]); w.y = cvtpk(v[2], v[3]); w.z = cvtpk(v[4], v[5]); w.w = cvtpk(v[6], v[7]);
            *(u32x4*)(WT + (size_t)n * Kd + kc * 8) = w;
        }
        for (int it = (int)gt; it < M * 48; it += (int)NGT) {
            const int m = it / 48, i = it - m * 48;
            const float pos = (float)positions[m];
            const float fe = i < 32 ? (float)(2 * i) * (1.f / 64.f) : (float)(2 * (i - 32)) * (1.f / 32.f);
            const float invf = exp2f(-fe * 13.287712379549449f);
            const float ang = pos * invf;
            double rev = (double)ang * 0.15915494309189535; rev -= floor(rev);
            const float rf = (float)rev;
            const float cs = __builtin_amdgcn_cosf(rf), sn = __builtin_amdgcn_sinf(rf);
            float* dst = i < 32 ? CS64 + ((size_t)m * 32 + i) * 2 : CS32 + ((size_t)m * 16 + (i - 32)) * 2;
            *(f32x2*)dst = (f32x2){cs, sn};
        }
    }
    { PHASE_IDS();
    for (int m0 = gw; m0 < M; m0 += 2 * NGW) {
        const int m1 = m0 + NGW; const bool has1 = m1 < M;
        const f32x4* xr0 = (const f32x4*)(x + (size_t)m0 * DM) + lane; const f32x4* xr1 = (const f32x4*)(x + (size_t)(has1 ? m1 : m0) * DM) + lane;
        f32x4 v0[4], v1[4]; float s0 = 0.f, s1 = 0.f;
#pragma unroll
        for (int j = 0; j < 4; ++j) { v0[j] = xr0[64 * j]; v1[j] = xr1[64 * j]; }
#pragma unroll
        for (int j = 0; j < 4; ++j) { s0 += (v0[j].x * v0[j].x + v0[j].y * v0[j].y) + (v0[j].z * v0[j].z + v0[j].w * v0[j].w);
                                      s1 += (v1[j].x * v1[j].x + v1[j].y * v1[j].y) + (v1[j].z * v1[j].z + v1[j].w * v1[j].w); }
        const float rstd0 = __builtin_amdgcn_rsqf(wave_sum(s0) * (1.f / DM) + EPS), rstd1 = __builtin_amdgcn_rsqf(wave_sum(s1) * (1.f / DM) + EPS);
        const int b0 = m0 / SEQ, b1 = (has1 ? m1 : m0) / SEQ;
        u32x2* o80 = (u32x2*)(HB + (size_t)m0 * DM) + lane; u32x2* o81 = (u32x2*)(HB + (size_t)m1 * DM) + lane;
#pragma unroll
        for (int j = 0; j < 4; ++j) {
            const int col = 4 * lane + 256 * j;
            const f32x4 nw = *(const f32x4*)(norm_w + col);
            { const f32x4 sh = *(const f32x4*)(MOD + b0 * 3072 + col), scl = *(const f32x4*)(MOD + b0 * 3072 + 1024 + col);
              const f32x4 hv = v0[j] * rstd0 * nw * (scl + 1.f) + sh; o80[64 * j] = (u32x2){cvtpk(hv.x, hv.y), cvtpk(hv.z, hv.w)}; }
            if (has1) { const f32x4 sh = *(const f32x4*)(MOD + b1 * 3072 + col), scl = *(const f32x4*)(MOD + b1 * 3072 + 1024 + col);
              const f32x4 hv = v1[j] * rstd1 * nw * (scl + 1.f) + sh; o81[64 * j] = (u32x2){cvtpk(hv.x, hv.y), cvtpk(hv.z, hv.w)}; }
        }
    } }
    }
    GRID_BAR();

    {
        pg8::Gemm g{HB, WIN, M, PITCH, DM, DM}; pg8::StaticOrder S; S.init(M, PITCH, G, bid);
        EpiIn E{PROJ, CS64};
        pg8::gemm_phase<EpiIn, pg8::StaticOrder>((LAS unsigned char*)lds, g, S, E);
    }
    GRID_BAR();

#if PROBE_DUP == 1
    for (int rep_ = 0; rep_ < 2; ++rep_)
#endif
    {
    { PHASE_IDS();
    const int sub = lane >> 4, l16 = lane & 15;
    for (int m0 = gw * 4; m0 < M; m0 += NGW * 4) {
        const int m = m0 + sub, b = m / SEQ, s = m - b * SEQ;
        const bf16* pr = PROJ + (size_t)m * PITCH + C_CQ + 8 * l16;
        u32x4 v[6];
#pragma unroll
        for (int i = 0; i < 5; ++i) v[i] = *(const u32x4*)(pr + 128 * i);
        v[5] = (u32x4){0u, 0u, 0u, 0u}; if (l16 < 4) v[5] = *(const u32x4*)(pr + 640);
        float s_cq = sumsq8(v[0]) + sumsq8(v[1]) + sumsq8(v[2]);
        float s_ckv = sumsq8(v[3]) + sumsq8(v[4]);
        float s_kr = sumsq8(v[5]);
#pragma unroll
        for (int ofs = 1; ofs < 16; ofs <<= 1) { s_cq += __shfl_xor(s_cq, ofs); s_ckv += __shfl_xor(s_ckv, ofs); s_kr += __shfl_xor(s_kr, ofs); }
        if (l16 == 0) STAT[m] = (f32x2){s_cq * (1.f / 384.f), s_ckv * (1.f / 256.f)};
        const float rk = __builtin_amdgcn_rsqf(s_kr * (1.f / 32.f) + EPS);
        const u32x4 b2 = v[5];
        u32x4 pw; pw.x = __shfl_xor(b2.x, 2); pw.y = __shfl_xor(b2.y, 2); pw.z = __shfl_xor(b2.z, 2); pw.w = __shfl_xor(b2.w, 2);
        if (l16 < 2) {
            const int pb = 8 * l16;
            unsigned ow[8];
#pragma unroll
            for (int q = 0; q < 4; ++q) {
#pragma unroll
                for (int e = 0; e < 2; ++e) {
                    const int pidx = pb + 2 * q + e;
                    const float x1 = (e ? bf_hi(b2[q]) : bf_lo(b2[q])) * rk * kn_rope_w[pidx];
                    const float x2 = (e ? bf_hi(pw[q]) : bf_lo(pw[q])) * rk * kn_rope_w[pidx + 16];
                    const f32x2 csv = *(const f32x2*)(CS32 + ((size_t)m * 16 + pidx) * 2);
                    ow[2 * q + e] = cvtpk(x1 * csv.x - x2 * csv.y, x2 * csv.x + x1 * csv.y);
                }
            }
            const u32x4 w0 = {ow[0], ow[1], ow[2], ow[3]}, w1 = {ow[4], ow[5], ow[6], ow[7]};
#pragma unroll
            for (int hh = 0; hh < NH; ++hh) { bf16* kp = KB + ((size_t)(b * NH + hh) * SEQ + s) * 96 + 64 + 16 * l16;
                *(u32x4*)kp = w0; *(u32x4*)(kp + 8) = w1; }
        }
    } }
    ret_state_phase(PROJ, KVS, dl_f, dl_b, bid, G, (char*)lds);
    }
    GRID_BAR();

    { PHASE_IDS();
    for (long it = gt; it < 32L * 2 * 2048; it += NGT) {
        const int e4 = (int)(it & 2047), dir = (int)((it >> 11) & 1), bh = (int)(it >> 12), h = bh & 7;
        const float lg2 = -log1pf(expf(-(dir ? dl_b[h] : dl_f[h]))) * LOG2E;
        const float gC = __builtin_amdgcn_exp2f(lg2 * 128.f);
        float s0 = 0.f, s1 = 0.f, s2 = 0.f, s3 = 0.f;
        for (int i = 0; i < 64; ++i) {
            const int c = dir ? 63 - i : i;
            u32x2* ptr = (u32x2*)(KVS + (((size_t)(bh * 64 + c) * 2 + dir) * 8192) + 4 * e4);
            const u32x2 kv = *ptr;
            *ptr = (u32x2){cvtpk(s0, s1), cvtpk(s2, s3)};
            s0 = s0 * gC + bf_lo(kv.x); s1 = s1 * gC + bf_hi(kv.x); s2 = s2 * gC + bf_lo(kv.y); s3 = s3 * gC + bf_hi(kv.y);
        }
    } }
#if PROBE_DUP == 2
    for (int rep_ = 0; rep_ < 2; ++rep_)
#endif
    {
    {
        pg8::Gemm g{PROJ + C_CQ, WQ, M, 768, 384, PITCH}; pg8::StaticOrder S; S.init(M, 768, G, G - 1 - bid);
        EpiUp<3> E{QO, nullptr, STAT, qn_nope_w, qn_rope_w, CS32};
        pg8::gemm_phase<EpiUp<3>, pg8::StaticOrder>((LAS unsigned char*)lds, g, S, E);
    }
    {
        pg8::Gemm g{PROJ + C_CKV, WKV, M, 1536, 256, PITCH}; pg8::StaticOrder S; S.init(M, 1536, G, bid);
        EpiUp<2> E{KB, VB, STAT, kn_nope_w, nullptr, nullptr};
        pg8::gemm_phase<EpiUp<2>, pg8::StaticOrder>((LAS unsigned char*)lds, g, S, E);
    }
    }
    GRID_BAR();

    {
        const int nA = (1024 + G - 1) / G, rslot = (bid & 7) % (nA + 1);
        for (int i = 0; i <= nA; ++i) {
            if (i == rslot) ret_main_phase(PROJ, KVS, gn_w, dl_f, dl_b, bid, G, (char*)lds);
            const int u = i * G + bid;
            if (i < nA && u < 1024) {
                int bh, qb;
                if (G == 256) { bh = (bid & 7) * 4 + i; qb = bid >> 3; } else { bh = u >> 5; qb = u & 31; }
                bf16* qo = QO + ((size_t)bh * SEQ + (size_t)qb * 256) * 128;
                const int b_ = bh >> 3, h_ = bh & 7; const size_t row_ = (size_t)b_ * SEQ + (size_t)qb * 256;
                attn_unit(qo, KB + (size_t)bh * SEQ * 96, VB + (size_t)bh * SEQ * 128, SEQ, (char*)lds,
                          PROJ + row_ * PITCH + C_MG + h_ * 128, SSB + row_ * 8 + h_, mla_norm_w + h_ * 128);
                __syncthreads();
            }
        }
    }
    GRID_BAR();

    {
        pg8::Gemm g{PROJ + C_MG, WO, M, DM, 2048, PITCH}; pg8::StaticOrder S; S.init(M, DM, G, bid);
        EpiOut E{x, p.out, MOD, SSB};
        pg8::gemm_phase<EpiOut, pg8::StaticOrder>((LAS unsigned char*)lds, g, S, E);
    }
}

extern "C" void kernel_launch(void* const* d_in, const int* in_sizes, int n_in, void* d_out, int out_size, void* d_ws, size_t ws_size, hipStream_t stream) {
    static int grid_blocks = 0;
    if (grid_blocks == 0) {
        if (n_in != 20 || out_size != M * DM || ws_size < WS_END) { fprintf(stderr, "kernel_launch: unexpected shapes (n_in %d out %d ws %zu)\n", n_in, out_size, ws_size); grid_blocks = -1; return; }
        int dev = 0, cus = 0, per_cu = 0;
        hipGetDevice(&dev);
        hipDeviceGetAttribute(&cus, hipDeviceAttributeMultiprocessorCount, dev);
        if (hipFuncSetAttribute((const void*)fwd_megakernel, hipFuncAttributeMaxDynamicSharedMemorySize, LDS_BYTES) != hipSuccess) { fprintf(stderr, "kernel_launch: hipFuncSetAttribute failed\n"); grid_blocks = -1; return; }
        if (hipOccupancyMaxActiveBlocksPerMultiprocessor(&per_cu, (const void*)fwd_megakernel, NTHREADS, LDS_BYTES) != hipSuccess || per_cu < 1) { fprintf(stderr, "kernel_launch: occupancy query failed (%d)\n", per_cu); per_cu = 1; }
        (void)hipGetLastError();
        grid_blocks = cus * per_cu;
    }
    if (grid_blocks < 0) return;
    if (hipMemsetAsync((char*)d_ws + WS_BAR, 0, XCD_BAR_WORDS * 4, stream) != hipSuccess) { fprintf(stderr, "kernel_launch: memset failed\n"); return; }
    Params p{};
    for (int i = 0; i < 20; ++i) p.in[i] = (const float*)d_in[i];
    p.out = (float*)d_out; p.ws = (unsigned char*)d_ws;
    void* args[] = {&p};
    hipError_t e = hipLaunchCooperativeKernel((const void*)fwd_megakernel, dim3(grid_blocks), dim3(NTHREADS), args, LDS_BYTES, stream);
    if (e != hipSuccess) fprintf(stderr, "cooperative launch failed: %s (grid %d)\n", hipGetErrorString(e), grid_blocks);
}
```
